# Optimizing an MI355X kernel written in HIP

```python
import jax
import jax.numpy as jnp
from jax import lax
import numpy as np

D_MODEL = 1024
BATCH = 16
SEQ = 2048
DEPTH = 4

GRID_W = 64
CTX_LEN = 256
N_MIXERS = 3
NORM_EPS = 1e-6
ROPE_THETA = 10000.0
Q_BLOCK = 128

NA_HEADS = 16
NA_HEAD_DIM = D_MODEL // NA_HEADS
NA_WIN_ROWS = 8
NA_WIN_COLS = 16

SW_Q_HEADS = 16
SW_KV_HEADS = 4
SW_HEAD_DIM = D_MODEL // SW_Q_HEADS
SW_WINDOW = 128

GA_Q_HEADS = 8
GA_KV_HEADS = 4
GA_HEAD_DIM = D_MODEL // GA_Q_HEADS

MIXER_HEADS = ((NA_HEADS, NA_HEADS, NA_HEAD_DIM),
               (SW_Q_HEADS, SW_KV_HEADS, SW_HEAD_DIM),
               (GA_Q_HEADS, GA_KV_HEADS, GA_HEAD_DIM))

D_FF = 3584
N_EXPERTS = 8
TOP_K = 2
D_FF_EXPERT = 3584

kernel_name = 'hybrid_natten_swa_axial_moe_dit'


def rms_norm(x, gain):
    xf = x.astype(jnp.float32)
    y = xf * lax.rsqrt(jnp.mean(xf * xf, axis=-1, keepdims=True) + NORM_EPS)
    return (y * gain.astype(jnp.float32)).astype(x.dtype)


def ada_ln(cond, w_mod, b_mod):
    return jnp.split(jax.nn.silu(cond) @ w_mod + b_mod, 6, axis=-1)


def project_q(h, w_q, n_heads, head_dim, q_gain):
    b, t, _ = h.shape
    return rms_norm((h @ w_q).reshape(b, t, n_heads, head_dim), q_gain)


def project_kv(h, w_kv, n_kv, head_dim, k_gain):
    b, t, _ = h.shape
    kv = (h @ w_kv).reshape(b, t, 2, n_kv, head_dim)
    return rms_norm(kv[:, :, 0], k_gain), kv[:, :, 1]


def axial_rope_tables(n_tokens, head_dim):
    n_freq = head_dim // 4
    inv_freq = ROPE_THETA ** (-jnp.arange(n_freq, dtype=jnp.float32) / n_freq)
    t = jnp.arange(n_tokens)
    row = (t // GRID_W).astype(jnp.float32)
    col = (t % GRID_W).astype(jnp.float32)
    ang = jnp.concatenate([row[:, None] * inv_freq, col[:, None] * inv_freq], axis=-1)
    return jnp.cos(ang), jnp.sin(ang)


def apply_rope(x, cos, sin):
    half = x.shape[-1] // 2
    xf = x.astype(jnp.float32)
    x1, x2 = xf[..., :half], xf[..., half:]
    cs, sn = cos[:, None, :], sin[:, None, :]
    return jnp.concatenate([x1 * cs - x2 * sn, x1 * sn + x2 * cs], axis=-1).astype(x.dtype)


def context_attention(qc, kc, vc, sink):
    b, l, hq, dh = qc.shape
    hkv = kc.shape[2]
    g = hq // hkv
    q = qc.reshape(b, l, hkv, g, dh)
    logits = jnp.einsum('bqkgd,bckd->bkgqc', q, kc).astype(jnp.float32) * dh ** -0.5
    if sink is None:
        p = jax.nn.softmax(logits, axis=-1)
    else:
        sink_col = jnp.broadcast_to(sink.reshape(hkv, g)[None, :, :, None, None].astype(jnp.float32),
                                    logits.shape[:-1] + (1,))
        p = jax.nn.softmax(jnp.concatenate([logits, sink_col], axis=-1), axis=-1)[..., :-1]
    o = jnp.einsum('bkgqc,bckd->bqkgd', p.astype(vc.dtype), vc)
    return o.reshape(b, l, hq * dh)


def neighbourhood_attention(q, k, v, kc, vc, rel_bias):
    b, s, h, dh = q.shape
    rows = s // GRID_W
    win_r = min(NA_WIN_ROWS, rows)
    scale = dh ** -0.5
    qg = q.reshape(b, rows, GRID_W, h, dh)
    kg = k.reshape(b, rows, GRID_W, h, dh)
    vg = v.reshape(b, rows, GRID_W, h, dh)
    col = jnp.arange(GRID_W)
    col_start = jnp.clip(col - NA_WIN_COLS // 2, 0, GRID_W - NA_WIN_COLS)
    in_win = (col[None, :] >= col_start[:, None]) & (col[None, :] < col_start[:, None] + NA_WIN_COLS)
    col_idx = jnp.clip(col[None, :] - col[:, None] + NA_WIN_COLS - 1, 0, 2 * NA_WIN_COLS - 2)
    col_bias = rel_bias[:, :, col_idx]

    def row_block(r):
        r0 = jnp.clip(r - win_r // 2, 0, rows - win_r)
        q_r = lax.dynamic_index_in_dim(qg, r, axis=1, keepdims=False)
        k_band = lax.dynamic_slice_in_dim(kg, r0, win_r, axis=1)
        v_band = lax.dynamic_slice_in_dim(vg, r0, win_r, axis=1)
        bias = jnp.take(col_bias, r0 + jnp.arange(win_r) - r + NA_WIN_ROWS - 1, axis=1)
        s_lat = jnp.einsum('bqhd,brkhd->bhqrk', q_r, k_band).astype(jnp.float32) * scale
        s_lat = jnp.where(in_win[:, None, :], s_lat + bias.transpose(0, 2, 1, 3).astype(jnp.float32), -jnp.inf)
        s_ctx = jnp.einsum('bqhd,bchd->bhqc', q_r, kc).astype(jnp.float32) * scale
        n_lat = win_r * GRID_W
        p = jax.nn.softmax(jnp.concatenate([s_lat.reshape(b, h, GRID_W, n_lat), s_ctx], axis=-1), axis=-1)
        p = p.astype(v.dtype)
        p_lat = p[..., :n_lat].reshape(b, h, GRID_W, win_r, GRID_W)
        return (jnp.einsum('bhqrk,brkhd->bqhd', p_lat, v_band)
                + jnp.einsum('bhqc,bchd->bqhd', p[..., n_lat:], vc))

    out = lax.map(row_block, jnp.arange(rows))
    return out.transpose(1, 0, 2, 3, 4).reshape(b, s, h * dh)


def sliding_window_attention(q, k, v, kc, vc, sink):
    b, s, hq, dh = q.shape
    hkv = k.shape[2]
    g = hq // hkv
    nb = s // Q_BLOCK
    span = Q_BLOCK + 2 * SW_WINDOW
    scale = dh ** -0.5
    kp = jnp.pad(k, ((0, 0), (SW_WINDOW, SW_WINDOW), (0, 0), (0, 0)))
    vp = jnp.pad(v, ((0, 0), (SW_WINDOW, SW_WINDOW), (0, 0), (0, 0)))
    qb = q.reshape(b, nb, Q_BLOCK, hkv, g, dh)
    rel = jnp.arange(span)[None, :] - SW_WINDOW - jnp.arange(Q_BLOCK)[:, None]
    in_band = jnp.abs(rel) <= SW_WINDOW
    sink_col = sink.reshape(hkv, g)[None, :, :, None, None].astype(jnp.float32)

    def block(i):
        q_i = lax.dynamic_index_in_dim(qb, i, axis=1, keepdims=False)
        k_i = lax.dynamic_slice_in_dim(kp, i * Q_BLOCK, span, axis=1)
        v_i = lax.dynamic_slice_in_dim(vp, i * Q_BLOCK, span, axis=1)
        key_pos = i * Q_BLOCK - SW_WINDOW + jnp.arange(span)
        valid = in_band & ((key_pos >= 0) & (key_pos < s))[None, :]
        s_lat = jnp.einsum('bqkgd,bskd->bkgqs', q_i, k_i).astype(jnp.float32) * scale
        s_lat = jnp.where(valid, s_lat, -jnp.inf)
        s_ctx = jnp.einsum('bqkgd,bckd->bkgqc', q_i, kc).astype(jnp.float32) * scale
        logits = jnp.concatenate([s_lat, s_ctx, jnp.broadcast_to(sink_col, s_lat.shape[:-1] + (1,))], axis=-1)
        p = jax.nn.softmax(logits, axis=-1).astype(v.dtype)
        o = (jnp.einsum('bkgqs,bskd->bqkgd', p[..., :span], v_i)
             + jnp.einsum('bkgqc,bckd->bqkgd', p[..., span:-1], vc))
        return o.reshape(b, Q_BLOCK, hq * dh)

    out = lax.map(block, jnp.arange(nb))
    return out.transpose(1, 0, 2, 3).reshape(b, s, hq * dh)


def blocked_global_attention(q, k, v, kc, vc):
    b, s, hq, dh = q.shape
    hkv = k.shape[2]
    g = hq // hkv
    nb = s // Q_BLOCK
    scale = dh ** -0.5
    k_all = jnp.concatenate([k, kc], axis=1)
    v_all = jnp.concatenate([v, vc], axis=1)
    qb = q.reshape(b, nb, Q_BLOCK, hkv, g, dh).swapaxes(0, 1)

    def block(q_i):
        logits = jnp.einsum('bqkgd,bskd->bkgqs', q_i, k_all).astype(jnp.float32) * scale
        p = jax.nn.softmax(logits, axis=-1).astype(v.dtype)
        return jnp.einsum('bkgqs,bskd->bqkgd', p, v_all).reshape(b, Q_BLOCK, hq * dh)

    out = lax.map(block, qb)
    return out.transpose(1, 0, 2, 3).reshape(b, s, hq * dh)


def swiglu(h, w_in, w_out):
    gate, up = jnp.split(h @ w_in, 2, axis=-1)
    return (jax.nn.silu(gate) * up) @ w_out


def moe_swiglu(h, w_router, b_router, w_exp_in, w_exp_out):
    logits = (h @ w_router).astype(jnp.float32) + b_router.astype(jnp.float32)
    top_val, top_idx = lax.top_k(logits, TOP_K)
    top_w = jax.nn.softmax(top_val, axis=-1)
    gates = jnp.sum(jax.nn.one_hot(top_idx, N_EXPERTS, dtype=jnp.float32) * top_w[..., None], axis=-2)
    gates = gates.astype(h.dtype)
    out = jnp.zeros_like(h)
    for e in range(N_EXPERTS):
        out = out + gates[..., e:e + 1] * swiglu(h, w_exp_in[e], w_exp_out[e])
    return out


def channel_mixer(h, ffn):
    return swiglu(h, *ffn) if len(ffn) == 2 else moe_swiglu(h, *ffn)


def hybrid_layer(x, ctx, c, c_ctx, w_mod, b_mod, norm1, norm2, w_qkv, q_norm, k_norm,
                 mixer_param, w_o, ffn, mixer, last):
    s = x.shape[1]
    n_q, n_kv, dh = MIXER_HEADS[mixer]
    w_q, w_kv = w_qkv[:, :n_q * dh], w_qkv[:, n_q * dh:]
    sh1, sc1, g1, sh2, sc2, g2 = (m[:, None, :] for m in ada_ln(c, w_mod, b_mod))
    csh1, csc1, cg1, csh2, csc2, cg2 = ada_ln(c_ctx, w_mod, b_mod)
    h = rms_norm(x, norm1) * (1 + sc1) + sh1
    hc = rms_norm(ctx, norm1) * (1 + csc1) + csh1
    q = project_q(h, w_q, n_q, dh, q_norm)
    k, v = project_kv(h, w_kv, n_kv, dh, k_norm)
    kc, vc = project_kv(hc, w_kv, n_kv, dh, k_norm)
    if mixer == 0:
        y = neighbourhood_attention(q, k, v, kc, vc, mixer_param)
    else:
        cos, sin = axial_rope_tables(s, dh)
        q, k = apply_rope(q, cos, sin), apply_rope(k, cos, sin)
        if mixer == 1:
            y = sliding_window_attention(q, k, v, kc, vc, mixer_param)
        else:
            y = blocked_global_attention(q, k, v, kc, vc)
    x = x + g1 * (y @ w_o)
    x = x + g2 * channel_mixer(rms_norm(x, norm2) * (1 + sc2) + sh2, ffn)
    if last:
        return x, ctx
    qc = project_q(hc, w_q, n_q, dh, q_norm)
    yc = context_attention(qc, kc, vc, mixer_param if mixer == 1 else None)
    ctx = ctx + cg1 * (yc @ w_o)
    ctx = ctx + cg2 * channel_mixer(rms_norm(ctx, norm2) * (1 + csc2) + csh2, ffn)
    return x, ctx


def setup_inputs(seed: int = 0) -> dict:
    key = jax.random.key(seed)
    k_x, k_c, k_ctx, k_cctx, k_layers = jax.random.split(key, 5)
    normal = jax.random.normal
    f32 = jnp.float32
    inputs = {
        'x': normal(k_x, (BATCH, SEQ, D_MODEL), f32),
        'c': normal(k_c, (BATCH, D_MODEL), f32),
        'ctx': normal(k_ctx, (BATCH, CTX_LEN, D_MODEL), f32),
        'c_ctx': normal(k_cctx, (D_MODEL,), f32),
    }
    layer_keys = jax.random.split(k_layers, DEPTH)
    for i in range(DEPTH):
        mixer = i % N_MIXERS
        n_q, n_kv, dh = MIXER_HEADS[mixer]
        ks = jax.random.split(layer_keys[i], 14)
        p = 'l%d_' % i
        inputs[p + 'w_mod'] = normal(ks[0], (D_MODEL, 6 * D_MODEL), f32) * (0.5 * D_MODEL ** -0.5)
        inputs[p + 'b_mod'] = 0.01 * normal(ks[1], (6 * D_MODEL,), f32)
        inputs[p + 'norm1'] = 1.0 + 0.02 * normal(ks[2], (D_MODEL,), f32)
        inputs[p + 'norm2'] = 1.0 + 0.02 * normal(ks[3], (D_MODEL,), f32)
        inputs[p + 'w_qkv'] = normal(ks[4], (D_MODEL, (n_q + 2 * n_kv) * dh), f32) * D_MODEL ** -0.5
        inputs[p + 'q_norm'] = 1.0 + 0.02 * normal(ks[5], (dh,), f32)
        inputs[p + 'k_norm'] = 1.0 + 0.02 * normal(ks[6], (dh,), f32)
        if mixer == 0:
            inputs[p + 'rel_bias'] = 0.1 * normal(ks[7], (NA_HEADS, 2 * NA_WIN_ROWS - 1, 2 * NA_WIN_COLS - 1), f32)
        elif mixer == 1:
            inputs[p + 'sink'] = 0.5 * normal(ks[7], (SW_Q_HEADS,), f32)
        inputs[p + 'w_o'] = normal(ks[8], (n_q * dh, D_MODEL), f32) * (n_q * dh) ** -0.5
        if i % 2 == 0:
            inputs[p + 'w_ffn_in'] = normal(ks[9], (D_MODEL, 2 * D_FF), f32) * D_MODEL ** -0.5
            inputs[p + 'w_ffn_out'] = normal(ks[10], (D_FF, D_MODEL), f32) * D_FF ** -0.5
        else:
            inputs[p + 'w_router'] = normal(ks[9], (D_MODEL, N_EXPERTS), f32) * D_MODEL ** -0.5
            inputs[p + 'b_router'] = 0.01 * normal(ks[10], (N_EXPERTS,), f32)
            inputs[p + 'w_exp_in'] = normal(ks[11], (N_EXPERTS, D_MODEL, 2 * D_FF_EXPERT), f32) * D_MODEL ** -0.5
            inputs[p + 'w_exp_out'] = normal(ks[12], (N_EXPERTS, D_FF_EXPERT, D_MODEL), f32) * D_FF_EXPERT ** -0.5
    return inputs


def reference(x, c, ctx, c_ctx,
              l0_w_mod, l0_b_mod, l0_norm1, l0_norm2, l0_w_qkv, l0_q_norm, l0_k_norm, l0_rel_bias, l0_w_o,
              l0_w_ffn_in, l0_w_ffn_out,
              l1_w_mod, l1_b_mod, l1_norm1, l1_norm2, l1_w_qkv, l1_q_norm, l1_k_norm, l1_sink, l1_w_o,
              l1_w_router, l1_b_router, l1_w_exp_in, l1_w_exp_out,
              l2_w_mod, l2_b_mod, l2_norm1, l2_norm2, l2_w_qkv, l2_q_norm, l2_k_norm, l2_w_o,
              l2_w_ffn_in, l2_w_ffn_out,
              l3_w_mod, l3_b_mod, l3_norm1, l3_norm2, l3_w_qkv, l3_q_norm, l3_k_norm, l3_rel_bias, l3_w_o,
              l3_w_router, l3_b_router, l3_w_exp_in, l3_w_exp_out):
    layers = (
        (l0_w_mod, l0_b_mod, l0_norm1, l0_norm2, l0_w_qkv, l0_q_norm, l0_k_norm, l0_rel_bias, l0_w_o,
         (l0_w_ffn_in, l0_w_ffn_out)),
        (l1_w_mod, l1_b_mod, l1_norm1, l1_norm2, l1_w_qkv, l1_q_norm, l1_k_norm, l1_sink, l1_w_o,
         (l1_w_router, l1_b_router, l1_w_exp_in, l1_w_exp_out)),
        (l2_w_mod, l2_b_mod, l2_norm1, l2_norm2, l2_w_qkv, l2_q_norm, l2_k_norm, None, l2_w_o,
         (l2_w_ffn_in, l2_w_ffn_out)),
        (l3_w_mod, l3_b_mod, l3_norm1, l3_norm2, l3_w_qkv, l3_q_norm, l3_k_norm, l3_rel_bias, l3_w_o,
         (l3_w_router, l3_b_router, l3_w_exp_in, l3_w_exp_out)),
    )
    for i in range(DEPTH):
        x, ctx = hybrid_layer(x, ctx, c, c_ctx, *layers[i], mixer=i % N_MIXERS, last=(i == DEPTH - 1))
    return x
```

```cpp
#include <hip/hip_runtime.h>
#include <cstdio>
#include <cstdint>

#ifndef MK_PER_PHASE
#define MK_PER_PHASE 0
#endif

#define LAS __attribute__((address_space(3)))
#define GAS __attribute__((address_space(1)))
typedef unsigned short bf16_t;
typedef short bf16x8 __attribute__((ext_vector_type(8)));
typedef short s16x4 __attribute__((ext_vector_type(4)));
typedef float f32x4 __attribute__((ext_vector_type(4)));
typedef float f32x2 __attribute__((ext_vector_type(2)));
typedef float f32x16 __attribute__((ext_vector_type(16)));
typedef unsigned u32x4 __attribute__((ext_vector_type(4)));
typedef unsigned u32x2 __attribute__((ext_vector_type(2)));
typedef __bf16 bf16x2_t __attribute__((ext_vector_type(2)));
typedef GAS unsigned gu32;

__device__ __forceinline__ int lane_now0() { int l; asm volatile("v_mbcnt_lo_u32_b32 %0, -1, 0\n\tv_mbcnt_hi_u32_b32 %0, -1, %0" : "=v"(l)); return l; }
#ifndef WT_STORES
#define WT_STORES 0
#endif
__device__ __forceinline__ void st16(void* p, u32x4 v) { if (WT_STORES) asm volatile("global_store_dwordx4 %0, %1, off sc1\n\ts_nop 1" :: "v"(p), "v"(v) : "memory"); else *(u32x4*)p = v; }
__device__ __forceinline__ void st8(void* p, u32x2 v) { if (WT_STORES) asm volatile("global_store_dwordx2 %0, %1, off sc1" :: "v"(p), "v"(v) : "memory"); else *(u32x2*)p = v; }
__device__ __forceinline__ void st4(void* p, unsigned v) { if (WT_STORES) asm volatile("global_store_dword %0, %1, off sc1" :: "v"(p), "v"(v) : "memory"); else *(unsigned*)p = v; }
__device__ __forceinline__ void st16f(void* p, f32x4 v) { st16(p, __builtin_bit_cast(u32x4, v)); }
__device__ __forceinline__ unsigned cvtpk(float lo, float hi) { f32x2 v = {lo, hi}; bf16x2_t b = __builtin_convertvector(v, bf16x2_t); return __builtin_bit_cast(unsigned, b); }
__device__ __forceinline__ unsigned pk4_fp8(float a, float b, float c, float d) {
    a = __builtin_amdgcn_fmed3f(a, -448.f, 448.f); b = __builtin_amdgcn_fmed3f(b, -448.f, 448.f); c = __builtin_amdgcn_fmed3f(c, -448.f, 448.f); d = __builtin_amdgcn_fmed3f(d, -448.f, 448.f);
    int w = 0; w = __builtin_amdgcn_cvt_pk_fp8_f32(a, b, w, false); w = __builtin_amdgcn_cvt_pk_fp8_f32(c, d, w, true); return (unsigned)w; }
__device__ __forceinline__ float bf_lo(unsigned w) { return __builtin_bit_cast(float, w << 16); }
__device__ __forceinline__ float bf_hi(unsigned w) { return __builtin_bit_cast(float, w & 0xffff0000u); }

constexpr int NB = 16, SEQ = 2048, DM = 1024, CTXL = 256;
constexpr int TL = NB * SEQ, TC = NB * CTXL, TT = TL + TC;
constexpr int DFF = 3584, NEXP = 8, MODW = 6 * DM, NCOND = 17;
constexpr float NORM_EPS = 1e-6f;
constexpr float LOG2E = 1.4426950408889634f, LN2 = 0.6931471805599453f;
#ifndef FP8_MOE_IN
#define FP8_MOE_IN 1
#endif
#ifndef FP8_MOE_OUT
#define FP8_MOE_OUT 1
#endif
#ifndef FP8_QKV
#define FP8_QKV 1
#endif
#ifndef FP8_WO
#define FP8_WO 1
#endif
#ifndef FP8_DENSE_IN
#define FP8_DENSE_IN 0
#endif
#ifndef FP8_DENSE_OUT
#define FP8_DENSE_OUT 1
#endif
#ifndef I8_QKV
#define I8_QKV 1
#endif
#ifndef I8_DENSE_IN
#define I8_DENSE_IN 1
#endif
#ifndef I8_MOE_IN
#define I8_MOE_IN 1
#endif
__host__ __device__ constexpr int qkv_dt() { return I8_QKV ? 2 : (FP8_QKV ? 1 : 0); }
__host__ __device__ constexpr int ffn_in_dt(int L) { return (L & 1) ? (I8_MOE_IN ? 2 : (FP8_MOE_IN ? 1 : 0)) : (I8_DENSE_IN ? 2 : (FP8_DENSE_IN ? 1 : 0)); }
__host__ __device__ constexpr bool ffn_out8(int L) { return (L & 1) ? (FP8_MOE_OUT != 0) : (FP8_DENSE_OUT != 0); }
constexpr float H8_SCALE = 4.0f, WIN8_SCALE = 64.0f, ACT8_SCALE = 8.0f, WOUT8_SCALE = 128.0f;
constexpr float WQKV8_SCALE = 64.0f, Y8_SCALE = 64.0f, WO8_SCALE = 64.0f;
constexpr float QKV_DESCALE = 1.0f / (H8_SCALE * WQKV8_SCALE), WO_DESCALE = 1.0f / (Y8_SCALE * WO8_SCALE);
constexpr int E8_1 = 0x7f7f7f7f, E8_2M2 = 0x7d7d7d7d, E8_2M3 = 0x7c7c7c7c, E8_2M6 = 0x79797979, E8_2M7 = 0x78787878;
constexpr float FFN_IN_DESCALE = 1.0f / (H8_SCALE * WIN8_SCALE), FFN_OUT_DESCALE = 1.0f / (ACT8_SCALE * WOUT8_SCALE);

namespace pg8 {
constexpr int BM = 256, BK = 64, HALF = 128, HTB = HALF * BK * 2, STAGE_BYTES = 8 * HTB, NXCD = 8, WGM = 8;
constexpr int XL_OFF_ = 131072;
constexpr int PARK_OFF_ = 140288;
__host__ __device__ __forceinline__ int lds_byte(int r, int c) { const int st = (r >> 4) * 2 + (c >> 5), rr = r & 15, cc = c & 31, ob = rr * 64 + cc * 2; return st * 1024 + (ob ^ (((ob >> 9) & 1) << 5)); }
__host__ __device__ __forceinline__ void stage_rc(int b, int& R, int& C) { const int st = b / 1024, sb = b % 1024, swz = sb ^ (((sb >> 9) & 1) << 5); R = (st >> 1) * 16 + swz / 64; C = (st & 1) * 32 + (swz % 64) / 2; }

struct Unit { int pm, pn, pb, e, r0; };
struct Gemm { const void* A; const void* Bt; int Kb; int sw0, sw1, sa; };

template <int MODE> struct Order {
    static constexpr bool GATHER = (MODE == 1);
    int nM, nN, nwg, G, c; const LAS int* moe; const int* listTok; int cap;
    __device__ __forceinline__ void init(int nM_, int nN_, int G_, int c_) { nM = nM_; nN = nN_; nwg = nM * nN; G = G_; c = c_; }
    __device__ __forceinline__ bool next(int i, Unit& u) const {
        const long L = (long)i * G + c; if (L >= nwg) return false;
        int wgid = (int)L; { const int q = nwg / NXCD, r = nwg % NXCD, xcd = wgid % NXCD, off = wgid / NXCD; wgid = (xcd < r ? xcd * (q + 1) : r * (q + 1) + (xcd - r) * q) + off; }
        if (MODE == 2) wgid = nwg - 1 - wgid;
        const int nig = WGM * nN, gid = wgid / nig, fm = gid * WGM, gsz = (nM - fm) < WGM ? (nM - fm) : WGM;
        u.pm = fm + ((wgid % nig) % gsz); u.pn = (wgid % nig) / gsz; u.pb = u.pn; u.e = 0; u.r0 = 0;
        if (MODE != 0) { int e = 0;
#pragma unroll
            for (int k = 1; k < 8; ++k) e += (u.pm >= moe[8 + k]) ? 1 : 0;
            e = __builtin_amdgcn_readfirstlane(e);
            u.e = e; u.r0 = __builtin_amdgcn_readfirstlane((u.pm - moe[8 + e]) * 256); u.pb = e * nN + u.pn; }
        return true;
    }
    __device__ __forceinline__ void a_offsets(const Unit& u, int Kb, const int (&R)[2], const int (&C)[2], unsigned (&va)[2][2]) const {
#pragma unroll
        for (int h = 0; h < 2; ++h)
#pragma unroll
            for (int i = 0; i < 2; ++i) {
                int row;
                if (MODE == 1) { const int pos = u.r0 + h * 128 + R[i]; const int idx = pos < moe[u.e] ? pos : 0; row = listTok[u.e * cap + idx] >> 1; }
                else row = u.pm * 256 + h * 128 + R[i];
                va[h][i] = (unsigned)row * (unsigned)Kb + (unsigned)C[i] * 2u;
            }
    }
};

typedef int v8i __attribute__((ext_vector_type(8)));
typedef int v4i_t __attribute__((ext_vector_type(4)));
__device__ __forceinline__ void glds_s(const void* sbase, unsigned voff, unsigned lds_dst) { unsigned keep;
    asm volatile("s_mov_b32 %0, m0\n\ts_mov_b32 m0, %3\n\ts_nop 0\n\tglobal_load_lds_dwordx4 %1, %2\n\ts_mov_b32 m0, %0" : "=&s"(keep) : "v"(voff), "s"(sbase), "s"(lds_dst) : "memory"); }
__device__ __forceinline__ void glds_s_nt(const void* sbase, unsigned voff, unsigned lds_dst) { unsigned keep;
    asm volatile("s_mov_b32 %0, m0\n\ts_mov_b32 m0, %3\n\ts_nop 0\n\tglobal_load_lds_dwordx4 %1, %2 nt\n\ts_mov_b32 m0, %0" : "=&s"(keep) : "v"(voff), "s"(sbase), "s"(lds_dst) : "memory"); }
template <int DT, bool NTA = false, class Epi, class Sched>
__device__ __forceinline__ void gemm_phase(LAS unsigned char* lds, const int tid, const Gemm g, const Sched& S, const Epi& E) {
    const int wid = __builtin_amdgcn_readfirstlane(tid >> 6), lane = tid & 63, wr = wid >> 2, wc = wid & 3, fr = lane & 15, fq = lane >> 4;
    const int K = g.Kb, nt = K / 128;
    int R[2], C[2]; unsigned voffB[2];
#pragma unroll
    for (int i = 0; i < 2; ++i) { stage_rc(tid * 16 + i * 8192, R[i], C[i]); voffB[i] = (unsigned)(R[i] * K + C[i] * 2); }
    const size_t kstep = 128;
    const size_t hstep = (size_t)HALF * K;
    const size_t tstep = 2 * hstep;
    const unsigned ldsb = (unsigned)(uintptr_t)lds + (unsigned)wid * 1024u;
    const int aoff = lds_byte(wr * 64 + fr, fq * 8), boff = lds_byte(wc * 32 + fr, fq * 8);
#define PG8_SA(b, h) (((b) * 2 + (h)) * HTB)
#define PG8_SB(b, h) ((4 + (b) * 2 + (h)) * HTB)
#ifndef STAGE_BUILTIN_NONFP8
#define STAGE_BUILTIN_NONFP8 1
#endif
#define PG8_STAGE(bufoff, gbase, voff) do { _Pragma("unroll") for (int _i = 0; _i < 2; ++_i) { \
        if constexpr (DT != 1 && STAGE_BUILTIN_NONFP8) __builtin_amdgcn_global_load_lds((const unsigned*)((const char*)(gbase) + (voff)[_i]), (LAS unsigned*)(lds + (bufoff) + wid * 1024 + _i * 8192), 16, 0, 0); \
        else glds_s((const void*)(gbase), (voff)[_i], ldsb + (unsigned)((bufoff) + _i * 8192)); } } while (0)
#define PG8_STAGEA(bufoff, gbase, voff) do { if constexpr (DT == 1 && NTA) { _Pragma("unroll") for (int _i = 0; _i < 2; ++_i) glds_s_nt((const void*)(gbase), (voff)[_i], ldsb + (unsigned)((bufoff) + _i * 8192)); } else PG8_STAGE(bufoff, gbase, voff); } while (0)
#define PG8_LDA(dst, b, h) do { _Pragma("unroll") for (int m = 0; m < 4; ++m) _Pragma("unroll") for (int k = 0; k < 2; ++k) dst[m][k] = *(const LAS bf16x8*)(lds + PG8_SA(b, h) + aoff + m * 2048 + k * 1024); } while (0)
#define PG8_LDB(dst, b, h) do { _Pragma("unroll") for (int n = 0; n < 2; ++n) _Pragma("unroll") for (int k = 0; k < 2; ++k) dst[n][k] = *(const LAS bf16x8*)(lds + PG8_SB(b, h) + boff + n * 2048 + k * 1024); } while (0)
#define PG8_CAT(x) __builtin_bit_cast(v8i, __builtin_shufflevector((x)[0], (x)[1], 0, 1, 2, 3, 4, 5, 6, 7, 8, 9, 10, 11, 12, 13, 14, 15))
#define PG8_MMA(ai, bj, At, Bt) do { __builtin_amdgcn_s_setprio(1); _Pragma("unroll") for (int m = 0; m < 4; ++m) _Pragma("unroll") for (int n = 0; n < 2; ++n) { \
        if constexpr (DT == 1) acc[ai][bj][m][n] = __builtin_amdgcn_mfma_scale_f32_16x16x128_f8f6f4(PG8_CAT(Bt[n]), PG8_CAT(At[m]), acc[ai][bj][m][n], 0, 0, 0, (bj) ? g.sw1 : g.sw0, 0, g.sa); \
        else if constexpr (DT == 2) { _Pragma("unroll") for (int k = 0; k < 2; ++k) acc[ai][bj][m][n] = __builtin_bit_cast(f32x4, __builtin_amdgcn_mfma_i32_16x16x64_i8(__builtin_bit_cast(v4i_t, Bt[n][k]), __builtin_bit_cast(v4i_t, At[m][k]), __builtin_bit_cast(v4i_t, acc[ai][bj][m][n]), 0, 0, 0)); } \
        else { _Pragma("unroll") for (int k = 0; k < 2; ++k) acc[ai][bj][m][n] = __builtin_amdgcn_mfma_f32_16x16x32_bf16(Bt[n][k], At[m][k], acc[ai][bj][m][n], 0, 0, 0); } } \
        __builtin_amdgcn_s_setprio(0); } while (0)
#define PG8_WAIT_V(n) asm volatile("s_waitcnt vmcnt(" #n ")" ::: "memory")
#define PG8_WAIT_L(n) asm volatile("s_waitcnt lgkmcnt(" #n ")" ::: "memory")
#define PG8_BAR __builtin_amdgcn_s_barrier()
#define PG8_SCHED __builtin_amdgcn_sched_barrier(0)
    Unit cur, nxt; int ui = 0;
    if (!S.next(0, cur)) return;
    f32x4 acc[2][2][4][2];
#pragma unroll
    for (int a = 0; a < 2; ++a)
#pragma unroll
        for (int b = 0; b < 2; ++b)
#pragma unroll
            for (int m = 0; m < 4; ++m)
#pragma unroll
                for (int n = 0; n < 2; ++n) acc[a][b][m][n] = (f32x4){0.f, 0.f, 0.f, 0.f};
    bf16x8 At[4][2], B0[2][2], B1[2][2];
    constexpr bool GATHER = Sched::GATHER;
    unsigned vc[2][2];
    LAS unsigned* park = (LAS unsigned*)(lds + PARK_OFF_) + tid * 4;
    const char* cA = (const char*)g.A;
    if constexpr (GATHER) S.a_offsets(cur, K, R, C, vc);
    else {
#pragma unroll
        for (int h = 0; h < 2; ++h)
#pragma unroll
            for (int i = 0; i < 2; ++i) vc[h][i] = (unsigned)((h * HALF + R[i]) * K + C[i] * 2);
        cA += (size_t)cur.pm * tstep; }
    const char* cB = (const char*)g.Bt + (size_t)cur.pb * tstep;
    PG8_STAGE(PG8_SB(0, 0), cB, voffB); PG8_STAGE(PG8_SB(0, 1), cB + hstep, voffB); PG8_STAGEA(PG8_SA(0, 0), cA, vc[0]); PG8_STAGEA(PG8_SA(0, 1), cA, vc[1]);
    if (wr == 1) PG8_BAR;
    PG8_WAIT_V(2); PG8_BAR;
    PG8_STAGE(PG8_SB(1, 0), cB + kstep, voffB); PG8_STAGEA(PG8_SA(1, 0), cA + kstep, vc[0]); PG8_STAGE(PG8_SB(1, 1), cB + hstep + kstep, voffB);
    PG8_WAIT_V(6); PG8_BAR;
    for (;;) {
        const bool has_next = S.next(ui + 1, nxt);
        if constexpr (!GATHER) { *(LAS u32x4*)park = (u32x4){vc[0][0], vc[0][1], vc[1][0], vc[1][1]}; }
        if constexpr (GATHER) { unsigned vn[2][2];
            if (has_next) S.a_offsets(nxt, K, R, C, vn);
            else {
#pragma unroll
                for (int h = 0; h < 2; ++h)
#pragma unroll
                    for (int i = 0; i < 2; ++i) vn[h][i] = vc[h][i]; }
            *(LAS u32x4*)park = (u32x4){vn[0][0], vn[0][1], vn[1][0], vn[1][1]}; }
        const char* nA = GATHER ? (const char*)g.A : (has_next ? (const char*)g.A + (size_t)nxt.pm * tstep : cA);
        const char* nB = has_next ? (const char*)g.Bt + (size_t)nxt.pb * tstep : cB;
        for (int t = 0; t < nt; t += 2) {
            const bool last = (t == nt - 2);
            const char* a1 = cA + (size_t)(t + 1) * kstep;
            const char* a2 = last ? nA : cA + (size_t)(t + 2) * kstep; const char* b2 = last ? nB : cB + (size_t)(t + 2) * kstep;
            const char* a3 = a2 + kstep; const char* b3 = b2 + kstep;
            PG8_LDB(B0, 0, 0); PG8_LDB(B1, 0, 1); PG8_SCHED; PG8_LDA(At, 0, 0); PG8_STAGEA(PG8_SA(1, 1), a1, vc[1]);
            { if (last) { const u32x4 pv = *(const LAS u32x4*)park; vc[0][0] = pv.x; vc[0][1] = pv.y; vc[1][0] = pv.z; vc[1][1] = pv.w; } }
            PG8_WAIT_V(8); PG8_WAIT_L(0); PG8_BAR; PG8_SCHED; PG8_MMA(0, 0, At, B0); PG8_MMA(0, 1, At, B1); PG8_SCHED; PG8_BAR; PG8_SCHED;
            PG8_LDA(At, 0, 1); PG8_STAGE(PG8_SB(0, 0), b2, voffB); PG8_STAGE(PG8_SB(0, 1), b2 + hstep, voffB); PG8_STAGEA(PG8_SA(0, 0), a2, vc[0]);
            PG8_WAIT_V(8); PG8_WAIT_L(0); PG8_BAR; PG8_SCHED; PG8_MMA(1, 0, At, B0); PG8_MMA(1, 1, At, B1); PG8_SCHED; PG8_BAR; PG8_SCHED;
            PG8_LDB(B0, 1, 0); PG8_LDB(B1, 1, 1); PG8_SCHED; PG8_LDA(At, 1, 0); PG8_STAGEA(PG8_SA(0, 1), a2, vc[1]);
            PG8_WAIT_V(8); PG8_WAIT_L(0); PG8_BAR; PG8_SCHED; PG8_MMA(0, 0, At, B0); PG8_MMA(0, 1, At, B1); PG8_SCHED; PG8_BAR; PG8_SCHED;
            PG8_LDA(At, 1, 1); PG8_STAGE(PG8_SB(1, 0), b3, voffB); PG8_STAGE(PG8_SB(1, 1), b3 + hstep, voffB); PG8_STAGEA(PG8_SA(1, 0), a3, vc[0]);
            PG8_WAIT_V(8); PG8_WAIT_L(0); PG8_BAR; PG8_SCHED; PG8_MMA(1, 0, At, B0); PG8_MMA(1, 1, At, B1); PG8_SCHED; PG8_BAR; PG8_SCHED;
        }
        if (wr == 0) PG8_BAR;
        E(acc, cur, wr, wc, fr, fq);
        if (!has_next) break;
#pragma unroll
        for (int a = 0; a < 2; ++a)
#pragma unroll
            for (int b = 0; b < 2; ++b)
#pragma unroll
                for (int m = 0; m < 4; ++m)
#pragma unroll
                    for (int n = 0; n < 2; ++n) acc[a][b][m][n] = (f32x4){0.f, 0.f, 0.f, 0.f};
        cur = nxt; cA = nA; cB = nB; ++ui;
        if (wr == 1) PG8_BAR;
    }
    PG8_WAIT_V(0);
    PG8_BAR;
#undef PG8_SA
#undef PG8_SB
#undef PG8_STAGE
#undef PG8_STAGEA
#undef PG8_LDA
#undef PG8_LDB
#undef PG8_MMA
#undef PG8_CAT
#undef PG8_WAIT_V
#undef PG8_WAIT_L
#undef PG8_BAR
#undef PG8_SCHED
}

__device__ __forceinline__ int opq(int x) { asm volatile("" : "+v"(x)); return x; }
template <bool BASEF32> struct EpiResid {
    const void* bl; const void* bc; bf16_t* ol; bf16_t* oc; const float* gate; float sc;
    __device__ __forceinline__ void operator()(f32x4 (&acc)[2][2][4][2], const Unit& u, int wr, int wc, int fr_, int fq_) const {
        const int ln_ = lane_now0(); const int fr = ln_ & 15, fq = ln_ >> 4; (void)fr_; (void)fq_;
        const bool lat = u.pm < 128; const int rb = (lat ? u.pm : u.pm - 128) * 256 + wr * 64 + fr;
        const void* b = lat ? bl : bc; bf16_t* o = lat ? ol : oc; const int ci = lat ? (u.pm >> 3) : 16;
        const int col0 = u.pn * 256 + wc * 32 + 4 * fq; const float* gp = gate + (size_t)ci * MODW + col0;
        f32x4 gv[2][2];
#pragma unroll
        for (int bj = 0; bj < 2; ++bj)
#pragma unroll
            for (int n = 0; n < 2; ++n) gv[bj][n] = *(const f32x4*)(gp + bj * 128 + n * 16) * sc;
#pragma unroll
        for (int ai = 0; ai < 2; ++ai) {
            f32x4 bs[4][2][2];
#pragma unroll
            for (int m = 0; m < 4; ++m) { const size_t off = (size_t)(rb + ai * 128 + m * 16) * DM + col0;
#pragma unroll
                for (int bj = 0; bj < 2; ++bj)
#pragma unroll
                    for (int n = 0; n < 2; ++n) {
                        if (BASEF32) bs[m][bj][n] = __builtin_nontemporal_load((const f32x4*)((const float*)b + off + bj * 128 + n * 16));
                        else { const u32x2 w = *(const u32x2*)((const bf16_t*)b + off + bj * 128 + n * 16); bs[m][bj][n] = (f32x4){bf_lo(w.x), bf_hi(w.x), bf_lo(w.y), bf_hi(w.y)}; } } }
#pragma unroll
            for (int m = 0; m < 4; ++m) { const size_t off = (size_t)(rb + ai * 128 + m * 16) * DM + col0;
#pragma unroll
                for (int bj = 0; bj < 2; ++bj)
#pragma unroll
                    for (int n = 0; n < 2; ++n) { const f32x4 v = bs[m][bj][n] + gv[bj][n] * acc[ai][bj][m][n]; u32x2 w; w.x = cvtpk(v[0], v[1]); w.y = cvtpk(v[2], v[3]); st8(o + off + bj * 128 + n * 16, w); } }
            asm volatile("" ::: "memory"); }
    }
};
__device__ __forceinline__ f32x4 i2f(const f32x4& a) { const v4i_t q = __builtin_bit_cast(v4i_t, a); return (f32x4){(float)q[0], (float)q[1], (float)q[2], (float)q[3]}; }
template <bool OUT8, bool INT, bool MOEROWS, bool UPX8> struct EpiSwiGLU {
    unsigned char* act; const float* sa; const float* sw; const int* listTok; const LAS int* moe; int cap;
    static constexpr float usc = UPX8 ? ACT8_SCALE : 1.0f;
    __device__ __forceinline__ void operator()(f32x4 (&acc)[2][2][4][2], const Unit& u, int wr, int wc, int fr_, int fq_) const {
        const int ln_ = lane_now0(); const int fr = ln_ & 15, fq = ln_ >> 4; (void)fr_; (void)fq_;
        const int row0 = u.pm * 256 + wr * 64 + fr, col0 = u.pn * 128 + wc * 32 + 8 * fq;
        f32x4 swg[2], swu[2];
        if (INT) { const float* sp = sw + (size_t)u.pb * 256 + 32 * wc + 4 * fq;
#pragma unroll
            for (int n = 0; n < 2; ++n) { swg[n] = *(const f32x4*)(sp + 16 * n); swu[n] = *(const f32x4*)(sp + 128 + 16 * n) * usc; } }
        float rsv[2][4];
        if (INT) { int arow[2][4];
#pragma unroll
            for (int ai = 0; ai < 2; ++ai)
#pragma unroll
                for (int m = 0; m < 4; ++m) { arow[ai][m] = row0 + ai * 128 + m * 16;
                    if (MOEROWS) { const int pos = u.r0 + ai * 128 + wr * 64 + m * 16 + fr; const int idx = pos < moe[u.e] ? pos : 0; arow[ai][m] = listTok[u.e * cap + idx] >> 1; } }
#pragma unroll
            for (int ai = 0; ai < 2; ++ai)
#pragma unroll
                for (int m = 0; m < 4; ++m) rsv[ai][m] = sa[arow[ai][m]]; }
#pragma unroll
        for (int ai = 0; ai < 2; ++ai)
#pragma unroll
            for (int m = 0; m < 4; ++m) { float v[8]; const float rs = INT ? rsv[ai][m] : 1.0f;
#pragma unroll
                for (int n = 0; n < 2; ++n) { f32x4 g4, u4;
                    if (INT) { g4 = i2f(acc[ai][0][m][n]) * (swg[n] * rs); u4 = i2f(acc[ai][1][m][n]) * (swu[n] * rs); }
                    else { g4 = acc[ai][0][m][n]; u4 = acc[ai][1][m][n] * usc; }
#pragma unroll
                    for (int i = 0; i < 4; ++i) v[4 * n + i] = (g4[i] * __builtin_amdgcn_rcpf(1.0f + __builtin_amdgcn_exp2f(-g4[i]))) * u4[i]; }
                if (OUT8) { u32x2 w; w.x = pk4_fp8(v[0], v[1], v[2], v[3]); w.y = pk4_fp8(v[4], v[5], v[6], v[7]);
                    st8(act + (size_t)(row0 + ai * 128 + m * 16) * DFF + col0, w); }
                else { u32x4 w; w.x = cvtpk(v[0], v[1]); w.y = cvtpk(v[2], v[3]); w.z = cvtpk(v[4], v[5]); w.w = cvtpk(v[6], v[7]);
                    st16(act + ((size_t)(row0 + ai * 128 + m * 16) * DFF + col0) * 2, w); } }
    }
};
struct EpiMoeOut {
    bf16_t* slots; const int* listTok; const float* listW; const LAS int* moe; int cap; float sc;
    __device__ __forceinline__ void operator()(f32x4 (&acc)[2][2][4][2], const Unit& u, int wr, int wc, int fr_, int fq_) const {
        const int ln_ = lane_now0(); const int fr = ln_ & 15, fq = ln_ >> 4; (void)fr_; (void)fq_;
        const int cnt = moe[u.e]; const int col0 = u.pn * 256 + wc * 32 + 4 * fq;
        int ents[2][4]; float ws_[2][4];
#pragma unroll
        for (int ai = 0; ai < 2; ++ai)
#pragma unroll
            for (int m = 0; m < 4; ++m) { const int pos = u.r0 + ai * 128 + wr * 64 + m * 16 + fr; const int idx = pos < cnt ? pos : 0;
                ents[ai][m] = listTok[u.e * cap + idx]; ws_[ai][m] = listW[u.e * cap + idx]; }
#pragma unroll
        for (int ai = 0; ai < 2; ++ai)
#pragma unroll
            for (int m = 0; m < 4; ++m) { const int pos = u.r0 + ai * 128 + wr * 64 + m * 16 + fr;
                if (pos < cnt) { const int ent = ents[ai][m]; const float w = ws_[ai][m] * sc; bf16_t* rp = slots + (size_t)ent * DM + col0;
#pragma unroll
                    for (int bj = 0; bj < 2; ++bj)
#pragma unroll
                        for (int n = 0; n < 2; ++n) { const f32x4 v = acc[ai][bj][m][n] * w; u32x2 o; o.x = cvtpk(v[0], v[1]); o.y = cvtpk(v[2], v[3]); st8(rp + bj * 128 + n * 16, o); } } }
    }
};
template <bool INT> struct EpiQKV64 {
    bf16_t *Q, *K, *V; int nkvt, ldk; const float *qg, *kg; const float *rcos, *rsin; bool dorope; float vsc;
    const float* sa; const float* sw;
    __device__ __forceinline__ void operator()(f32x4 (&acc)[2][2][4][2], const Unit& u, int wr, int wc, int fr_, int fq_) const {
        const int ln_ = lane_now0(); const int fr = ln_ & 15, fq = ln_ >> 4; (void)fr_; (void)fq_;
        if (INT) { const float* sp = sw + (size_t)u.pn * 256 + 32 * wc + 4 * fq;
#pragma unroll
            for (int bj = 0; bj < 2; ++bj)
#pragma unroll
                for (int n = 0; n < 2; ++n) { const f32x4 cs = *(const f32x4*)(sp + 128 * bj + 16 * n);
#pragma unroll
                    for (int ai = 0; ai < 2; ++ai)
#pragma unroll
                        for (int m = 0; m < 4; ++m) acc[ai][bj][m][n] = i2f(acc[ai][bj][m][n]) * cs; } }
        const int type = u.pn < 4 ? 0 : (u.pn < 4 + nkvt ? 1 : 2);
        bf16_t* O; int ld, head;
        if (type == 0) { O = Q; ld = DM; head = 4 * u.pn + wc; } else if (type == 1) { O = K; ld = ldk; head = 4 * (u.pn - 4) + wc; } else { O = V; ld = ldk; head = 4 * (u.pn - 4 - nkvt) + wc; }
        const bool lat = u.pm < 128; const int row0 = u.pm * 256 + wr * 64 + fr;
        bf16_t* ob = O + (size_t)row0 * ld + head * 64 + 8 * fq;
        float sar[2][4];
#pragma unroll
        for (int ai = 0; ai < 2; ++ai)
#pragma unroll
            for (int m = 0; m < 4; ++m) sar[ai][m] = INT ? sa[row0 + ai * 128 + m * 16] : vsc;
        if (type == 2) {
#pragma unroll
            for (int ai = 0; ai < 2; ++ai)
#pragma unroll
                for (int m = 0; m < 4; ++m) { bf16_t* rp = ob + (size_t)(ai * 128 + m * 16) * ld; const float rsv = sar[ai][m];
#pragma unroll
                    for (int bj = 0; bj < 2; ++bj) { const f32x4 v0 = acc[ai][bj][m][0] * rsv, v1 = acc[ai][bj][m][1] * rsv;
                        u32x4 w; w.x = cvtpk(v0[0], v0[1]); w.y = cvtpk(v0[2], v0[3]); w.z = cvtpk(v1[0], v1[1]); w.w = cvtpk(v1[2], v1[3]);
                        st16(rp + 32 * bj, w); } }
            return;
        }
        const float* gp = (type == 0 ? qg : kg) + 8 * fq;
        f32x4 gv[2][2];
#pragma unroll
        for (int bj = 0; bj < 2; ++bj)
#pragma unroll
            for (int n = 0; n < 2; ++n) gv[bj][n] = *(const f32x4*)(gp + 32 * bj + 4 * n) * (type == 0 ? 0.125f * LOG2E : 1.0f);
        const bool rope = dorope && lat; const float epsv = NORM_EPS / (vsc * vsc);
        const int f0 = (fq & 1) * 8;
        f32x4 rc[2], rsn[2];
#define QKV64_ROPE_LOAD(G_) do { const int _ai = (G_) >> 2, _m = (G_) & 3; const int _grow = (4 * u.pm + 2 * _ai + wr) & 31, _gcol = 16 * _m + fr; const int _pos = rope ? (fq < 2 ? _grow : _gcol) : 64; \
        _Pragma("unroll") for (int n = 0; n < 2; ++n) { rc[n] = *(const f32x4*)(rcos + _pos * 16 + f0 + 4 * n); rsn[n] = *(const f32x4*)(rsin + _pos * 16 + f0 + 4 * n); } } while (0)
        if (dorope) QKV64_ROPE_LOAD(0);
#pragma unroll
        for (int gi = 0; gi < 8; ++gi) { const int ai = gi >> 2, m = gi & 3;
            float ss = 0.f;
#pragma unroll
            for (int bj = 0; bj < 2; ++bj)
#pragma unroll
                for (int n = 0; n < 2; ++n) { const f32x4 x = acc[ai][bj][m][n]; ss += (x[0] * x[0] + x[1] * x[1]) + (x[2] * x[2] + x[3] * x[3]); }
            ss += __shfl_xor(ss, 16); ss += __shfl_xor(ss, 32);
            float epsr = epsv; if (INT) { const float rs = sar[ai][m]; epsr = NORM_EPS / (rs * rs); }
            const float rstd = __builtin_amdgcn_rsqf(ss * (1.0f / 64.0f) + epsr);
            f32x4 y[2][2];
            if (dorope) { f32x4 c0[2], s0[2];
#pragma unroll
                for (int n = 0; n < 2; ++n) { c0[n] = rc[n]; s0[n] = rsn[n]; }
                if (gi < 7) QKV64_ROPE_LOAD(gi + 1);
#pragma unroll
                for (int n = 0; n < 2; ++n) { const f32x4 x1 = acc[ai][0][m][n] * rstd * gv[0][n], x2 = acc[ai][1][m][n] * rstd * gv[1][n];
                    y[0][n] = x1 * c0[n] - x2 * s0[n]; y[1][n] = x1 * s0[n] + x2 * c0[n]; } }
            else {
#pragma unroll
                for (int n = 0; n < 2; ++n) { y[0][n] = acc[ai][0][m][n] * rstd * gv[0][n]; y[1][n] = acc[ai][1][m][n] * rstd * gv[1][n]; } }
            bf16_t* rp = ob + (size_t)(ai * 128 + m * 16) * ld;
#pragma unroll
            for (int bj = 0; bj < 2; ++bj) { u32x4 w; w.x = cvtpk(y[bj][0][0], y[bj][0][1]); w.y = cvtpk(y[bj][0][2], y[bj][0][3]); w.z = cvtpk(y[bj][1][0], y[bj][1][1]); w.w = cvtpk(y[bj][1][2], y[bj][1][3]);
                st16(rp + 32 * bj, w); }
        }
#undef QKV64_ROPE_LOAD
    }
};
template <bool INT> struct EpiQKV128 {
    bf16_t *Q, *K, *V; const float *qg, *kg; const float *rcos, *rsin; LAS float* xl; float vsc;
    const float* sa; const float* sw;
    __device__ __forceinline__ void operator()(f32x4 (&acc)[2][2][4][2], const Unit& u, int wr, int wc, int fr_, int fq_) const {
        const int ln_ = lane_now0(); const int fr = ln_ & 15, fq = ln_ >> 4; (void)fr_; (void)fq_;
        if (INT) { const float* sp = sw + (size_t)u.pn * 256 + 32 * wc + 4 * fq;
#pragma unroll
            for (int bj = 0; bj < 2; ++bj)
#pragma unroll
                for (int n = 0; n < 2; ++n) { const f32x4 cs = *(const f32x4*)(sp + 128 * bj + 16 * n);
#pragma unroll
                    for (int ai = 0; ai < 2; ++ai)
#pragma unroll
                        for (int m = 0; m < 4; ++m) acc[ai][bj][m][n] = i2f(acc[ai][bj][m][n]) * cs; } }
        const int type = u.pn < 4 ? 0 : (u.pn < 6 ? 1 : 2);
        bf16_t* O; int ld, head0;
        if (type == 0) { O = Q; ld = DM; head0 = 2 * u.pn; } else if (type == 1) { O = K; ld = 512; head0 = 2 * (u.pn - 4); } else { O = V; ld = 512; head0 = 2 * (u.pn - 6); }
        const bool lat = u.pm < 128; const int row0 = u.pm * 256 + wr * 64 + fr;
        bf16_t* ob = O + (size_t)row0 * ld + head0 * 128 + 16 * wc + 4 * fq;
        float sar[2][4];
#pragma unroll
        for (int ai = 0; ai < 2; ++ai)
#pragma unroll
            for (int m = 0; m < 4; ++m) sar[ai][m] = INT ? sa[row0 + ai * 128 + m * 16] : vsc;
        if (type == 2) {
#pragma unroll
            for (int ai = 0; ai < 2; ++ai)
#pragma unroll
                for (int m = 0; m < 4; ++m) { const float rsv = sar[ai][m];
#pragma unroll
                    for (int bj = 0; bj < 2; ++bj) { bf16_t* rp = ob + (size_t)(ai * 128 + m * 16) * ld + bj * 128;
#pragma unroll
                        for (int n = 0; n < 2; ++n) { const f32x4 v = acc[ai][bj][m][n] * rsv; u32x2 o; o.x = cvtpk(v[0], v[1]); o.y = cvtpk(v[2], v[3]); st8(rp + 64 * n, o); } } }
            return;
        }
        const float* gp = (type == 0 ? qg : kg) + 16 * wc + 4 * fq;
        const float qsc = type == 0 ? 0.08838834764831845f * LOG2E : 1.0f;
        const f32x4 g0 = *(const f32x4*)(gp) * qsc, g1 = *(const f32x4*)(gp + 64) * qsc;
#pragma unroll
        for (int ai = 0; ai < 2; ++ai)
#pragma unroll
            for (int m = 0; m < 4; ++m)
#pragma unroll
                for (int bj = 0; bj < 2; ++bj) { const f32x4 x = acc[ai][bj][m][0], y = acc[ai][bj][m][1];
                    float ss = ((x[0] * x[0] + x[1] * x[1]) + (x[2] * x[2] + x[3] * x[3])) + ((y[0] * y[0] + y[1] * y[1]) + (y[2] * y[2] + y[3] * y[3]));
                    ss += __shfl_xor(ss, 16); ss += __shfl_xor(ss, 32);
                    if (fq == 0) xl[((ai * 128 + wr * 64 + m * 16 + fr) * 2 + bj) * 4 + wc] = ss; }
        asm volatile("s_waitcnt lgkmcnt(0)" ::: "memory"); __builtin_amdgcn_s_barrier(); asm volatile("" ::: "memory");
        const float epsv = NORM_EPS / (vsc * vsc);
        const int f0 = (wc & 1) * 16 + 4 * fq;
        f32x4 rc, rsn;
#define QKV128_ROPE_LOAD(G_) do { const int _ai = (G_) >> 2, _m = (G_) & 3; const int _grow = (4 * u.pm + 2 * _ai + wr) & 31, _gcol = 16 * _m + fr; const int _pos = lat ? (wc < 2 ? _grow : _gcol) : 64; \
        rc = *(const f32x4*)(rcos + _pos * 32 + f0); rsn = *(const f32x4*)(rsin + _pos * 32 + f0); } while (0)
        QKV128_ROPE_LOAD(0);
#pragma unroll
        for (int gi = 0; gi < 8; ++gi) { const int ai = gi >> 2, m = gi & 3;
            const f32x4 cs = rc, sn = rsn;
            if (gi < 7) QKV128_ROPE_LOAD(gi + 1);
            float epsr = epsv; if (INT) { const float rs = sar[ai][m]; epsr = NORM_EPS / (rs * rs); }
#pragma unroll
            for (int bj = 0; bj < 2; ++bj) { const f32x4 p = *(const LAS f32x4*)(xl + ((ai * 128 + wr * 64 + m * 16 + fr) * 2 + bj) * 4);
                const float rstd = __builtin_amdgcn_rsqf(((p[0] + p[1]) + (p[2] + p[3])) * (1.0f / 128.0f) + epsr);
                const f32x4 x1 = acc[ai][bj][m][0] * rstd * g0, x2 = acc[ai][bj][m][1] * rstd * g1;
                const f32x4 y1 = x1 * cs - x2 * sn, y2 = x1 * sn + x2 * cs;
                bf16_t* rp = ob + (size_t)(ai * 128 + m * 16) * ld + bj * 128;
                u32x2 o1, o2; o1.x = cvtpk(y1[0], y1[1]); o1.y = cvtpk(y1[2], y1[3]); o2.x = cvtpk(y2[0], y2[1]); o2.y = cvtpk(y2[2], y2[3]);
                st8(rp, o1); st8(rp + 64, o2); }
        }
#undef QKV128_ROPE_LOAD
    }
};
}

namespace att {
struct AUnit { int qrow0, qcol, kvcol, klat0, nlat, kctx0, a0, a1; };
#ifndef ATT_NSLOT64
#define ATT_NSLOT64 4
#endif
template <int DH> struct Geo { static constexpr int RB = DH * 2, KB = 64 * RB, SLOT = 2 * KB, NSLOT = DH == 64 ? ATT_NSLOT64 : 4, PD = NSLOT - 1, NQ = DH / 16, ND = DH / 32, CPR = RB / 16, RPPC = 1024 / RB, NPW = KB / 8192, NI = 2 * NPW;
                              static constexpr int TAB_OFF = 131072 + 512; };
__device__ __forceinline__ s16x4 trd(const LAS unsigned char* p) { return __builtin_bit_cast(s16x4, __builtin_amdgcn_ds_read_tr16_b64_v4i16((LAS s16x4*)p)); }
__device__ __forceinline__ float max3f(float a, float b, float c) { float r; asm("v_max3_f32 %0, %1, %2, %3" : "=v"(r) : "v"(a), "v"(b), "v"(c)); return r; }
__device__ __forceinline__ float swapmax(float v) { auto rr = __builtin_amdgcn_permlane32_swap(__float_as_uint(v), __float_as_uint(v), false, false); return fmaxf(__uint_as_float(rr[0]), __uint_as_float(rr[1])); }
__device__ __forceinline__ float swapsum(float v) { auto rr = __builtin_amdgcn_permlane32_swap(__float_as_uint(v), __float_as_uint(v), false, false); return __uint_as_float(rr[0]) + __uint_as_float(rr[1]); }

template <int DH, int MODE, bool Y8>
__device__ __forceinline__ void attn_unit(LAS unsigned char* lds, const int tid, const bf16_t* Q, const bf16_t* K, const bf16_t* V, bf16_t* Y, int ldk, const AUnit& u, const float* bias_h, float sink_l2, bool has_sink) {
    typedef Geo<DH> G;
    const int wid = __builtin_amdgcn_readfirstlane(tid >> 6), lane = tid & 63, r32 = lane & 31, hi = lane >> 5;
    constexpr float THR = 8.0f;
    const int NT = u.nlat + 4;
    const unsigned ldsa = (unsigned)(uintptr_t)lds;
    __builtin_amdgcn_s_barrier(); asm volatile("" ::: "memory");
    const int qoff = (MODE == 1) ? (2 * (wid >> 2) + (r32 >> 4)) * 64 + 16 * (wid & 3) + (r32 & 15) : wid * 32 + r32;
    bf16x8 qr[G::NQ];
    { const bf16_t* Qw = Q + (size_t)(u.qrow0 + qoff) * DM + u.qcol + hi * 8;
#pragma unroll
      for (int d0 = 0; d0 < G::NQ; ++d0) qr[d0] = *(const bf16x8*)(Qw + d0 * 16); }
    unsigned voffK[G::NPW], voffV[G::NPW];
#pragma unroll
    for (int i = 0; i < G::NPW; ++i) { const int pc = wid * G::NPW + i, row = pc * G::RPPC + lane / G::CPR, cp = lane % G::CPR;
        const int kf = DH == 64 ? ((row >> 1) & 7) : (row & 15), vf = DH == 64 ? (((row >> 1) & 1) << 2) : ((row & 3) << 2);
        voffK[i] = (unsigned)((row * ldk + u.kvcol) * 2 + ((cp ^ kf) << 4)); voffV[i] = (unsigned)((row * ldk + u.kvcol) * 2 + ((cp ^ vf) << 4)); }
#define ATT_T0(j) (((j) < u.nlat) ? u.klat0 + 64 * (j) : u.kctx0 + 64 * ((j) - u.nlat))
#define ATT_DMA(j) do { const size_t _tb = (size_t)ATT_T0(j) * ldk * 2; const unsigned _sl = ldsa + ((j) & (G::NSLOT - 1)) * G::SLOT + wid * G::NPW * 1024; \
        _Pragma("unroll") for (int i = 0; i < G::NPW; ++i) { pg8::glds_s((const char*)K + _tb, voffK[i], _sl + i * 1024); pg8::glds_s((const char*)V + _tb, voffV[i], _sl + G::KB + i * 1024); } } while (0)
    LAS float* tab = (LAS float*)(lds + G::TAB_OFF);
    if (MODE == 1) {
        for (int i = tid; i < 608; i += 512) { const int t = i - 64; float v = 0.f; if (t >= 0 && t < 480) { const int ri = t >> 5, ci = t & 31; if (ci < 31) v = bias_h[ri * 31 + ci] * LOG2E; } tab[t] = v; } }
#pragma unroll
    for (int t = 0; t < G::PD; ++t) if (t < NT) ATT_DMA(t);
    float m_run = -1e30f, l_run = 0.f;
    f32x16 o[G::ND];
#pragma unroll
    for (int d = 0; d < G::ND; ++d)
#pragma unroll
        for (int r = 0; r < 16; ++r) o[d][r] = 0.f;
    int w_lo = 0, w_hi = 0, l_lo = 0, l_hi = 0, tb_off = 0, m_lo = 0, m_hi = 0;
    float maddL[16];
    int cw = 0, jl_lo = 0, jl_hi = 0;
    if (MODE == 1) { const int R0 = 4 * u.a0 + 2 * (wid >> 2), cg = wid & 3, rq = R0 + (r32 >> 4), c = 16 * cg + (r32 & 15);
        int ra = R0 - 4; ra = ra < 0 ? 0 : (ra > 24 ? 24 : ra); int rb = R0 - 3; rb = rb < 0 ? 0 : (rb > 24 ? 24 : rb);
        w_lo = ra - u.a1; w_hi = rb - u.a1 + 8;
        const int r0l = (r32 >> 4) ? rb : ra; jl_lo = r0l - u.a1; jl_hi = jl_lo + 8;
        int c0 = c - 8; c0 = c0 < 0 ? 0 : (c0 > 48 ? 48 : c0);
        cw = 16 * cg - 8; cw = cw < 0 ? 0 : (cw > 32 ? 32 : cw);
        tb_off = (u.a1 - rq + 7) * 32 + cw + 4 * hi - c + 15;
#pragma unroll
        for (int r = 0; r < 16; ++r) { const int kc = cw + (r & 3) + 8 * (r >> 2) + 4 * hi; maddL[r] = (kc >= c0 && kc < c0 + 16) ? 0.f : -INFINITY; } }
    if (MODE == 2) { const int qw = u.a0 + 32 * wid;
        const int lo_pos = qw - 128 - u.a1 - 63, hi_pos = qw + 159 - u.a1;
        w_lo = lo_pos <= 0 ? 0 : (lo_pos + 63) >> 6; w_hi = hi_pos < 0 ? 0 : (hi_pos >> 6) + 1;
        const int f_lo = qw - 97 - u.a1, f_hi = qw + 65 - u.a1;
        m_lo = f_lo <= 0 ? 0 : (f_lo + 63) >> 6; m_hi = f_hi < 0 ? 0 : (f_hi >> 6) + 1;
        const int base = u.a1 - (qw + r32) + 4 * hi; l_lo = -128 - base; l_hi = 128 - base; }
    const int i16 = lane & 15, tq = i16 >> 2, tp4 = i16 & 3, blk = (lane >> 4) & 1;
    const int kfr = DH == 64 ? ((r32 >> 1) & 7) : (r32 & 15), xv = DH == 64 ? (tq >> 1) : tq;
    int koff[G::NQ], vo[G::ND];
#pragma unroll
    for (int d0 = 0; d0 < G::NQ; ++d0) koff[d0] = r32 * G::RB + (((2 * d0 + hi) ^ kfr) << 4);
#pragma unroll
    for (int d0 = 0; d0 < G::ND; ++d0) vo[d0] = G::KB + (4 * hi + tq) * G::RB + 64 * (d0 ^ xv) + 32 * blk + 8 * tp4;
    int koffL[G::NQ], voL[G::ND];
#pragma unroll
    for (int d0 = 0; d0 < G::NQ; ++d0) { const int row = cw + r32; koffL[d0] = row * G::RB + (((2 * d0 + hi) ^ ((row >> 1) & 7)) << 4); }
#pragma unroll
    for (int d0 = 0; d0 < G::ND; ++d0) voL[d0] = vo[d0] + cw * G::RB;
#define ATT_ACTIVE(j) ((MODE == 0) || (j) >= u.nlat || ((j) >= w_lo && (j) < w_hi))
#define ATT_MSUB() (m_run < -1e29f ? 0.f : m_run)
#define ATT_QKL(P0, MS, sl) do { const LAS unsigned char* _Kb = lds + (sl) * G::SLOT; MS = ATT_MSUB(); \
        _Pragma("unroll") for (int r = 0; r < 16; ++r) P0[r] = maddL[r] - MS; \
        bf16x8 _a0 = *(const LAS bf16x8*)(_Kb + koffL[0]); \
        _Pragma("unroll") for (int d0 = 0; d0 < G::NQ; ++d0) { bf16x8 _n0 = _a0; if (d0 + 1 < G::NQ) _n0 = *(const LAS bf16x8*)(_Kb + koffL[d0 + 1]); \
            __builtin_amdgcn_sched_barrier(0); P0 = __builtin_amdgcn_mfma_f32_32x32x16_bf16(_a0, qr[d0], P0, 0, 0, 0); __builtin_amdgcn_sched_barrier(0); _a0 = _n0; } } while (0)
#define ATT_SMPVL(P0, MS, j, sl) do { const LAS float* tp = tab + tb_off + 32 * (j); \
        _Pragma("unroll") for (int r = 0; r < 16; ++r) P0[r] += tp[(r & 3) + 8 * (r >> 2)]; \
        if ((j) == w_lo || (j) == w_hi - 1) { const bool rowok = (j) >= jl_lo && (j) < jl_hi;          \
            _Pragma("unroll") for (int r = 0; r < 16; ++r) P0[r] = rowok ? P0[r] : -INFINITY; } \
        float pm = P0[0]; \
        _Pragma("unroll") for (int r = 1; r < 15; r += 2) pm = max3f(pm, P0[r], P0[r + 1]); \
        pm = fmaxf(pm, P0[15]); pm = swapmax(pm); \
        if (__any(pm > (m_run - MS) + THR)) { const float mn = fmaxf(m_run, pm + MS); const float alpha = __builtin_amdgcn_exp2f(m_run - mn); m_run = mn; l_run *= alpha; \
            _Pragma("unroll") for (int d = 0; d < G::ND; ++d) _Pragma("unroll") for (int r = 0; r < 16; ++r) o[d][r] *= alpha; } \
        { const float dl = m_run - MS; if (__any(dl != 0.f)) { _Pragma("unroll") for (int r = 0; r < 16; ++r) P0[r] -= dl; } }        \
        float ps = 0.f; \
        _Pragma("unroll") for (int r = 0; r < 16; ++r) { P0[r] = __builtin_amdgcn_exp2f(P0[r]); ps += P0[r]; } \
        l_run += swapsum(ps); \
        bf16x8 pbl[2]; \
        _Pragma("unroll") for (int s = 0; s < 2; ++s) { u32x4 w0; \
            w0.x = cvtpk(P0[8 * s + 0], P0[8 * s + 1]); w0.y = cvtpk(P0[8 * s + 2], P0[8 * s + 3]); w0.z = cvtpk(P0[8 * s + 4], P0[8 * s + 5]); w0.w = cvtpk(P0[8 * s + 6], P0[8 * s + 7]); \
            pbl[s] = __builtin_bit_cast(bf16x8, w0); } \
        const LAS unsigned char* _Vb = lds + (sl) * G::SLOT; \
        { s16x4 lo_ = trd(_Vb + voL[0]), hh_ = trd(_Vb + voL[0] + 8 * G::RB); \
        _Pragma("unroll") for (int i_ = 0; i_ < 2 * G::ND; ++i_) { const int s = i_ / G::ND, d0 = i_ % G::ND; s16x4 nl_ = lo_, nh_ = hh_; \
            if (i_ + 1 < 2 * G::ND) { const int s1 = (i_ + 1) / G::ND, d1 = (i_ + 1) % G::ND; nl_ = trd(_Vb + voL[d1] + (16 * s1) * G::RB); nh_ = trd(_Vb + voL[d1] + (16 * s1 + 8) * G::RB); } \
            __builtin_amdgcn_sched_barrier(0); \
            const bf16x8 va = __builtin_shufflevector(lo_, hh_, 0, 1, 2, 3, 4, 5, 6, 7); \
            o[d0] = __builtin_amdgcn_mfma_f32_32x32x16_bf16(va, pbl[s], o[d0], 0, 0, 0); \
            __builtin_amdgcn_sched_barrier(0); \
            lo_ = nl_; hh_ = nh_; } } } while (0)
#define ATT_QK(P0, P1, MS, sl) do { const LAS unsigned char* _Kb = lds + (sl) * G::SLOT; MS = ATT_MSUB(); \
        _Pragma("unroll") for (int r = 0; r < 16; ++r) { P0[r] = -MS; P1[r] = -MS; } \
        __builtin_amdgcn_s_setprio(1); \
        bf16x8 _a0 = *(const LAS bf16x8*)(_Kb + koff[0]), _a1 = *(const LAS bf16x8*)(_Kb + koff[0] + 32 * G::RB); \
        _Pragma("unroll") for (int d0 = 0; d0 < G::NQ; ++d0) { bf16x8 _n0 = _a0, _n1 = _a1;        \
            if (d0 + 1 < G::NQ) { _n0 = *(const LAS bf16x8*)(_Kb + koff[d0 + 1]); _n1 = *(const LAS bf16x8*)(_Kb + koff[d0 + 1] + 32 * G::RB); } \
            __builtin_amdgcn_sched_barrier(0); \
            P0 = __builtin_amdgcn_mfma_f32_32x32x16_bf16(_a0, qr[d0], P0, 0, 0, 0); \
            P1 = __builtin_amdgcn_mfma_f32_32x32x16_bf16(_a1, qr[d0], P1, 0, 0, 0); \
            __builtin_amdgcn_sched_barrier(0); \
            _a0 = _n0; _a1 = _n1; } \
        __builtin_amdgcn_s_setprio(0); } while (0)
#define ATT_SMPV(P0, P1, MS, j, sl) do { \
        const bool _lat = (j) < u.nlat; float pm; \
        if (MODE == 2 && _lat && !((j) >= m_lo && (j) < m_hi)) { const int lo = l_lo - 64 * (j), hh = l_hi - 64 * (j); \
            _Pragma("unroll") for (int r = 0; r < 16; ++r) { const int e0 = (r & 3) + 8 * (r >> 2), e1 = e0 + 32; \
                P0[r] = (e0 >= lo && e0 <= hh) ? P0[r] : -INFINITY; P1[r] = (e1 >= lo && e1 <= hh) ? P1[r] : -INFINITY; } } \
        pm = fmaxf(P0[0], P1[0]); \
        _Pragma("unroll") for (int r = 1; r < 16; ++r) pm = max3f(pm, P0[r], P1[r]); \
        pm = swapmax(pm); \
        if (__any(pm > (m_run - MS) + THR)) { const float mn = fmaxf(m_run, pm + MS); const float alpha = __builtin_amdgcn_exp2f(m_run - mn); m_run = mn; l_run *= alpha; \
            _Pragma("unroll") for (int d = 0; d < G::ND; ++d) _Pragma("unroll") for (int r = 0; r < 16; ++r) o[d][r] *= alpha; } \
        { const float dl = m_run - MS; if (__any(dl != 0.f)) { _Pragma("unroll") for (int r = 0; r < 16; ++r) { P0[r] -= dl; P1[r] -= dl; } } }        \
        float ps = 0.f; \
        _Pragma("unroll") for (int r = 0; r < 16; ++r) { P0[r] = __builtin_amdgcn_exp2f(P0[r]); P1[r] = __builtin_amdgcn_exp2f(P1[r]); ps += P0[r] + P1[r]; } \
        l_run += swapsum(ps); \
        bf16x8 pb[2][2]; \
        _Pragma("unroll") for (int s = 0; s < 2; ++s) { u32x4 w0, w1; \
            w0.x = cvtpk(P0[8 * s + 0], P0[8 * s + 1]); w0.y = cvtpk(P0[8 * s + 2], P0[8 * s + 3]); w0.z = cvtpk(P0[8 * s + 4], P0[8 * s + 5]); w0.w = cvtpk(P0[8 * s + 6], P0[8 * s + 7]); \
            w1.x = cvtpk(P1[8 * s + 0], P1[8 * s + 1]); w1.y = cvtpk(P1[8 * s + 2], P1[8 * s + 3]); w1.z = cvtpk(P1[8 * s + 4], P1[8 * s + 5]); w1.w = cvtpk(P1[8 * s + 6], P1[8 * s + 7]); \
            pb[0][s] = __builtin_bit_cast(bf16x8, w0); pb[1][s] = __builtin_bit_cast(bf16x8, w1); } \
        const LAS unsigned char* _Vb = lds + (sl) * G::SLOT; \
        __builtin_amdgcn_s_setprio(1); \
        { s16x4 lo_ = trd(_Vb + vo[0]), hh_ = trd(_Vb + vo[0] + 8 * G::RB);        \
        _Pragma("unroll") for (int i_ = 0; i_ < 4 * G::ND; ++i_) { const int kt = i_ / (2 * G::ND), s = (i_ / G::ND) & 1, d0 = i_ % G::ND; s16x4 nl_ = lo_, nh_ = hh_; \
            if (i_ + 1 < 4 * G::ND) { const int kt1 = (i_ + 1) / (2 * G::ND), s1 = ((i_ + 1) / G::ND) & 1, d1 = (i_ + 1) % G::ND; \
                nl_ = trd(_Vb + vo[d1] + (32 * kt1 + 16 * s1) * G::RB); nh_ = trd(_Vb + vo[d1] + (32 * kt1 + 16 * s1 + 8) * G::RB); } \
            __builtin_amdgcn_sched_barrier(0); \
            const bf16x8 va = __builtin_shufflevector(lo_, hh_, 0, 1, 2, 3, 4, 5, 6, 7); \
            o[d0] = __builtin_amdgcn_mfma_f32_32x32x16_bf16(va, pb[kt][s], o[d0], 0, 0, 0); \
            __builtin_amdgcn_sched_barrier(0); \
            lo_ = nl_; hh_ = nh_; } } \
        __builtin_amdgcn_s_setprio(0); } while (0)
#define ATT_WAIT(c) do { const int _c = (c); if (_c <= 0) asm volatile("s_waitcnt vmcnt(0)" ::: "memory"); else if (_c == 1) asm volatile("s_waitcnt vmcnt(%0)" :: "n"(G::NI) : "memory"); \
        else if (_c == 2) asm volatile("s_waitcnt vmcnt(%0)" :: "n"(2 * G::NI) : "memory"); else if (_c == 3) asm volatile("s_waitcnt vmcnt(%0)" :: "n"(3 * G::NI) : "memory"); \
        else if (_c == 4) asm volatile("s_waitcnt vmcnt(%0)" :: "n"(4 * G::NI) : "memory"); else asm volatile("s_waitcnt vmcnt(%0)" :: "n"(5 * G::NI) : "memory"); } while (0)
#define ATT_STEP(C0, C1, CM, N0, N1, NM, j) do { \
        { const int _last = ((j) + G::PD - 1 < NT - 1) ? (j) + G::PD - 1 : NT - 1; ATT_WAIT(_last - ((j) + 1)); } \
        __builtin_amdgcn_s_barrier(); asm volatile("" ::: "memory"); \
        if ((j) + G::PD < NT) ATT_DMA((j) + G::PD); \
        if ((j) + 1 < NT && ATT_ACTIVE((j) + 1)) ATT_QK(N0, N1, NM, ((j) + 1) & (G::NSLOT - 1)); \
        if (ATT_ACTIVE(j)) ATT_SMPV(C0, C1, CM, j, (j) & (G::NSLOT - 1)); } while (0)
    if constexpr (DH == 128) {
    f32x16 sA0, sA1, sB0, sB1; float msA = 0.f, msB = 0.f;
    { const int _iss = G::PD < NT ? G::PD : NT; ATT_WAIT(_iss - 2); }
    asm volatile("s_waitcnt lgkmcnt(0)" ::: "memory");
    __builtin_amdgcn_s_barrier(); asm volatile("" ::: "memory");
    if (ATT_ACTIVE(0)) ATT_QK(sA0, sA1, msA, 0);
    for (int j = 0; j < NT; j += 2) {
        ATT_STEP(sA0, sA1, msA, sB0, sB1, msB, j);
        if (j + 1 < NT) ATT_STEP(sB0, sB1, msB, sA0, sA1, msA, j + 1);
    }
    } else {
#define ATT_STEP1(C0, C1, j) do { \
        { const int _last = ((j) + G::PD - 1 < NT - 1) ? (j) + G::PD - 1 : NT - 1; ATT_WAIT(_last - (j)); } \
        __builtin_amdgcn_s_barrier(); asm volatile("" ::: "memory"); \
        if ((j) + G::PD < NT) ATT_DMA((j) + G::PD); \
        if (ATT_ACTIVE(j)) { if (MODE == 1 && (j) < u.nlat) { ATT_QKL(C0, msA, (j) & (G::NSLOT - 1)); ATT_SMPVL(C0, msA, j, (j) & (G::NSLOT - 1)); } \
                             else { ATT_QK(C0, C1, msA, (j) & (G::NSLOT - 1)); ATT_SMPV(C0, C1, msA, j, (j) & (G::NSLOT - 1)); } } } while (0)
    f32x16 sA0, sA1; float msA = 0.f;
    asm volatile("s_waitcnt lgkmcnt(0)" ::: "memory");
    for (int j = 0; j < NT; ++j) ATT_STEP1(sA0, sA1, j);
#undef ATT_STEP1
    }
    if (has_sink) l_run += __builtin_amdgcn_exp2f(sink_l2 - m_run);
    const float inv = 1.0f / l_run;
    if (Y8) { unsigned char* Yb = (unsigned char*)Y + (size_t)(u.qrow0 + qoff) * DM + u.qcol + 4 * hi; const float sc8 = inv * Y8_SCALE;
#pragma unroll
        for (int d0 = 0; d0 < G::ND; ++d0)
#pragma unroll
            for (int g4 = 0; g4 < 4; ++g4) st4(Yb + 32 * d0 + 8 * g4, pk4_fp8(o[d0][4 * g4] * sc8, o[d0][4 * g4 + 1] * sc8, o[d0][4 * g4 + 2] * sc8, o[d0][4 * g4 + 3] * sc8));
    } else {
    bf16_t* Yw = Y + (size_t)(u.qrow0 + qoff) * DM + u.qcol + 4 * hi;
#pragma unroll
    for (int d0 = 0; d0 < G::ND; ++d0)
#pragma unroll
        for (int g4 = 0; g4 < 4; ++g4) { u32x2 w; w.x = cvtpk(o[d0][4 * g4] * inv, o[d0][4 * g4 + 1] * inv); w.y = cvtpk(o[d0][4 * g4 + 2] * inv, o[d0][4 * g4 + 3] * inv);
            st8(Yw + 32 * d0 + 8 * g4, w); } }
#undef ATT_T0
#undef ATT_DMA
#undef ATT_ACTIVE
#undef ATT_QK
#undef ATT_QKL
#undef ATT_MSUB
#undef ATT_SMPVL
#undef ATT_SMPV
#undef ATT_STEP
#undef ATT_WAIT
}
}

constexpr size_t MiB = 1u << 20;
constexpr size_t WS_CTL = 0, CTL_ZERO_BYTES = 1 * MiB;
constexpr size_t WS_MOD = 1 * MiB;
constexpr size_t WS_ROPE = 3 * MiB - 64 * 1024;
constexpr size_t WS_LIST = 3 * MiB;
constexpr size_t WS_SA = 5 * MiB + 256 * 1024;
constexpr size_t WS_SWQKV = WS_SA + 160 * 1024;
constexpr size_t WS_SWD = WS_SWQKV + 40 * 1024;
constexpr size_t WS_SWM = WS_SWD + 56 * 1024;
static_assert(WS_SWM + 8 * 7168 * 4 <= 6 * MiB, "scale arrays");
constexpr size_t WS_XC = 6 * MiB;
constexpr size_t WS_H = 22 * MiB;
constexpr size_t WS_SLOTS = 94 * MiB;
constexpr size_t WS_WQKV = 238 * MiB;
constexpr size_t WS_WO = 257 * MiB;
constexpr size_t WS_WDENSE = 265 * MiB;
constexpr size_t WS_WMOE = 307 * MiB;
constexpr size_t WS_ARENA = 475 * MiB;
constexpr size_t WS_Q = WS_ARENA, WS_K = WS_ARENA + 72 * MiB, WS_V = WS_ARENA + 144 * MiB, WS_ACT = WS_ARENA;
constexpr int MOE_ROWS_MAX = 2 * TT + 2048;
constexpr size_t ACT_MOE_BYTES = (size_t)MOE_ROWS_MAX * DFF * (FP8_MOE_OUT ? 1 : 2), ACT_DENSE_BYTES = (size_t)TT * DFF * (FP8_DENSE_OUT ? 1 : 2);
constexpr size_t ARENA_BYTES = ((ACT_MOE_BYTES > ACT_DENSE_BYTES ? (ACT_MOE_BYTES > 216 * MiB ? ACT_MOE_BYTES : 216 * MiB) : (ACT_DENSE_BYTES > 216 * MiB ? ACT_DENSE_BYTES : 216 * MiB)) + MiB - 1) / MiB * MiB;
constexpr size_t WS_XBL = WS_ARENA + ARENA_BYTES;
constexpr size_t WS_END = WS_XBL + (size_t)TL * DM * 2;
static_assert(WS_END <= 1040 * MiB, "ws map: d_ws is >= sum of the inputs = 1050 MiB");
constexpr size_t WDENSE_SLOT = (size_t)(2 * DFF * DM + DM * DFF) * 2;
constexpr size_t WMOE_IN_BYTES = (size_t)NEXP * 2 * DFF * DM * 2;
constexpr int CW_TMO = 0, CW_BAR = 4096, CW_MOECNT = 8192;

constexpr int RING_BYTES = 131072, XL_OFF = RING_BYTES, MOE_OFF = XL_OFF + 8192, MISC_OFF = MOE_OFF + 256, PARK_OFF = 140288, LDS_BYTES = PARK_OFF + 8192;
static_assert(XL_OFF == pg8::XL_OFF_ && PARK_OFF == pg8::PARK_OFF_ && MISC_OFF + 256 <= PARK_OFF && LDS_BYTES <= 160 * 1024, "LDS map");

#define XB_TMO      128
#define XB_XCNT(j)  (256  + 64 * (j))
#define XB_XSUB(j)  (1280 + 64 * (j))
#define XB_XGEN(j)  (2304 + 64 * (j))
#define XB_TOP      3328
#define XB_TOPGEN   3392
#define XCD_BAR_WORDS 3456
#define XB_SPIN_CAP (1u << 18)
__device__ __forceinline__ unsigned xb_ld(unsigned* p)              { return __hip_atomic_load(p, __ATOMIC_RELAXED, __HIP_MEMORY_SCOPE_AGENT); }
__device__ __forceinline__ unsigned xb_add(unsigned* p, unsigned v) { return __hip_atomic_fetch_add(p, v, __ATOMIC_RELAXED, __HIP_MEMORY_SCOPE_AGENT); }
__device__ __forceinline__ unsigned xb_xcc_id() { return (unsigned)__builtin_amdgcn_s_getreg((3 << 11) | 20) & 0xFu; }
#define XB_SPIN(cond, bar) do { unsigned _sp = 0; while (cond) { __builtin_amdgcn_s_sleep(1); \
    if ((++_sp & 255u) == 0u) { if (xb_ld(&(bar)[XB_TMO])) break; if (_sp > XB_SPIN_CAP) { atomicAdd(&(bar)[XB_TMO], 1u); break; } } } } while (0)
struct XcdBarrier { unsigned* bar; unsigned x; volatile LAS unsigned* st; int wave; };
__device__ __forceinline__ XcdBarrier xcd_barrier_post(unsigned* bar, volatile LAS unsigned* st, int wave) {
    XcdBarrier b; b.bar = bar; b.x = xb_xcc_id(); b.st = st; b.wave = wave;
    if (wave == 0 && lane_now0() == 0) (void)xb_add(&bar[XB_XCNT(b.x)], 1u);
    return b;
}
__device__ __forceinline__ void xcd_barrier_complete(unsigned* bar, unsigned x, unsigned& nloc, unsigned& nx) {
    const unsigned G = gridDim.x * gridDim.y * gridDim.z;
    unsigned sum, cnt, mine, sp = 0u;
    for (;;) {
        sum = 0u; cnt = 0u; mine = 0u;
#pragma unroll
        for (unsigned j = 0; j < 16; ++j) { const unsigned c = xb_ld(&bar[XB_XCNT(j)]); sum += c; cnt += (c > 0u) ? 1u : 0u; mine = (j == x) ? c : mine; }
        if (sum == G) break;
        __builtin_amdgcn_s_sleep(1);
        if ((++sp & 255u) == 0u) { if (xb_ld(&bar[XB_TMO])) break; if (sp > XB_SPIN_CAP) { atomicAdd(&bar[XB_TMO], 1u); break; } }
    }
    nloc = mine > 0u ? mine : 1u; nx = cnt > 0u ? cnt : 1u;
}
__device__ __forceinline__ void xcd_barrier(const XcdBarrier& b) {
    asm volatile("s_waitcnt vmcnt(0)" ::: "memory");
    __syncthreads();
    if (b.wave == 0 && lane_now0() == 0) {
        unsigned* bar = b.bar;
        __builtin_amdgcn_s_waitcnt(0);
        unsigned nloc = b.st[0], nx = b.st[1];
        if (nloc == 0u) { xcd_barrier_complete(bar, b.x, nloc, nx); b.st[0] = nloc; b.st[1] = nx; }
        const unsigned old = xb_add(&bar[XB_XSUB(b.x)], 1u);
        const unsigned gen = old / nloc;
        if (old + 1u == (gen + 1u) * nloc) {
            __builtin_amdgcn_fence(__ATOMIC_RELEASE, "agent");
            asm volatile("s_waitcnt vmcnt(0)" ::: "memory");
            const unsigned og = xb_add(&bar[XB_TOP], 1u);
            const unsigned tg = og / nx;
            if (og + 1u == (tg + 1u) * nx) xb_add(&bar[XB_TOPGEN], 1u);
            else XB_SPIN(xb_ld(&bar[XB_TOPGEN]) == tg, bar);
            __builtin_amdgcn_fence(__ATOMIC_ACQUIRE, "agent");
            xb_add(&bar[XB_XGEN(b.x)], 1u);
            asm volatile("s_waitcnt vmcnt(0)" ::: "memory");
        } else {
            XB_SPIN(xb_ld(&bar[XB_XGEN(b.x)]) == gen, bar);
            __builtin_amdgcn_fence(__ATOMIC_ACQUIRE, "agent");
            asm volatile("s_waitcnt vmcnt(0)" ::: "memory");
        }
    }
    __syncthreads();
}

constexpr int N_IN = 51;
struct Args { const float* in[N_IN]; float* out; unsigned char* ws; int ph_lo, ph_hi; };
struct Frame { LAS unsigned char* lds; int tid, lane, wave, vcu, G, gw, NGW; const Args* a; unsigned char* ws; float* out; bf16_t* xl16; bf16_t* xc16; const float* mod; };

#define LDS_WAIT() asm volatile("s_waitcnt lgkmcnt(0)" ::: "memory")
__device__ __forceinline__ int lane_now() { int l; asm volatile("v_mbcnt_lo_u32_b32 %0, -1, 0\n\tv_mbcnt_hi_u32_b32 %0, -1, %0" : "=v"(l)); return l; }
__device__ __forceinline__ float wave_sum(float v) {
#pragma unroll
    for (int o = 1; o < 64; o <<= 1) v += __shfl_xor(v, o);
    return v;
}
__host__ __device__ constexpr int layer_base(int L) { return L == 0 ? 4 : (L == 1 ? 15 : (L == 2 ? 28 : 38)); }
__host__ __device__ constexpr int layer_mixer(int L) { return L % 3; }
__host__ __device__ constexpr bool layer_moe(int L) { return (L & 1) != 0; }
__host__ __device__ constexpr int layer_nqkv(int L) { return L == 1 ? 1536 : (L == 2 ? 2048 : 3072); }
__host__ __device__ constexpr int layer_wqkv_row(int L) { return L == 0 ? 0 : (L == 1 ? 3072 : (L == 2 ? 4608 : 6656)); }
__host__ __device__ constexpr int layer_wo_idx(int L) { return layer_base(L) + (L == 2 ? 7 : 8); }
__host__ __device__ constexpr int layer_ffn_idx(int L) { return layer_base(L) + (L == 2 ? 8 : 9); }

__device__ __forceinline__ int conv_map(int mt, int rd) {
    if (mt == 0) return rd;
    const int pn = rd >> 8, s = rd & 255, bj = s >> 7, wc = (s >> 5) & 3, n = (s >> 4) & 1, fq = (s >> 2) & 3, i = s & 3;
    if (mt == 1) return (4 * pn + wc) * 64 + 32 * bj + 8 * fq + 4 * n + i;
    if (mt == 2) return (2 * pn + bj) * 128 + 64 * n + 16 * wc + 4 * fq + i;
    return bj * DFF + 128 * pn + 32 * wc + 8 * fq + 4 * n + i;
}
__device__ __forceinline__ void conv_item8(const float* W, int K, int N, unsigned char* WT, int mt, float scale, int item, int lane, LAS float* scr) {
    const int nblk = N / 32, kb = item / nblk, nb = item % nblk, k0 = 64 * kb, rd0 = 32 * nb;
    const float sc2 = mt == 3 ? scale * (((rd0 >> 7) & 1) ? LN2 : LOG2E) : scale;
    const int kq = lane >> 3, gq = lane & 7;
    const float* wp = W + (size_t)(k0 + kq) * N + conv_map(mt, rd0 + 4 * gq);
#pragma unroll
    for (int i = 0; i < 8; ++i) { const f32x4 v = __builtin_nontemporal_load((const f32x4*)(wp + (size_t)(8 * i) * N));        LAS float* d = scr + (8 * i + kq) * 33 + 4 * gq; d[0] = v[0]; d[1] = v[1]; d[2] = v[2]; d[3] = v[3]; }
    LDS_WAIT(); asm volatile("" ::: "memory");
    const int c = lane & 7;
#pragma unroll
    for (int j = 0; j < 4; ++j) { const int n = (lane >> 3) + 8 * j; const LAS float* s = scr + (8 * c) * 33 + n;
        u32x2 o; o.x = pk4_fp8(s[0 * 33] * sc2, s[1 * 33] * sc2, s[2 * 33] * sc2, s[3 * 33] * sc2); o.y = pk4_fp8(s[4 * 33] * sc2, s[5 * 33] * sc2, s[6 * 33] * sc2, s[7 * 33] * sc2);
        __builtin_nontemporal_store(o, (u32x2*)(WT + (size_t)(rd0 + n) * K + k0 + 8 * c)); }
    LDS_WAIT(); asm volatile("" ::: "memory");
}
__device__ __forceinline__ unsigned pk4_i8(float a, float b, float c, float d) {
    const unsigned ya = __float_as_uint(a + 12582912.0f), yb = __float_as_uint(b + 12582912.0f), yc = __float_as_uint(c + 12582912.0f), yd = __float_as_uint(d + 12582912.0f);
    return __builtin_amdgcn_perm(yb, ya, 0x0c0c0400u) | __builtin_amdgcn_perm(yd, yc, 0x04000c0cu); }
__device__ __forceinline__ void conv_cols_i8(const float* W, int K, int N, unsigned char* WT, int mt, float* swout, int nb, int lane, LAS float* scr) {
    const int rd0 = 32 * nb, kq = lane >> 3, gq = lane & 7;
    const float fac = mt == 3 ? (((rd0 >> 7) & 1) ? LN2 : LOG2E) : 1.0f;
    const float* wp = W + (size_t)kq * N + conv_map(mt, rd0 + 4 * gq);
    f32x4 mx = {0.f, 0.f, 0.f, 0.f};
    for (int kb = 0; kb < K / 64; ++kb) {
#pragma unroll
        for (int i = 0; i < 8; ++i) { const f32x4 v = *(const f32x4*)(wp + (size_t)(64 * kb + 8 * i) * N);
            mx[0] = fmaxf(mx[0], fabsf(v[0])); mx[1] = fmaxf(mx[1], fabsf(v[1])); mx[2] = fmaxf(mx[2], fabsf(v[2])); mx[3] = fmaxf(mx[3], fabsf(v[3])); } }
#pragma unroll
    for (int c = 0; c < 4; ++c) { mx[c] = fmaxf(mx[c], __shfl_xor(mx[c], 8)); mx[c] = fmaxf(mx[c], __shfl_xor(mx[c], 16)); mx[c] = fmaxf(mx[c], __shfl_xor(mx[c], 32)); }
    LAS float* invs = scr + 64 * 33;
    if (kq == 0) {
#pragma unroll
        for (int c = 0; c < 4; ++c) { const float m = mx[c]; invs[4 * gq + c] = m > 0.f ? 127.0f / m : 0.f; swout[rd0 + 4 * gq + c] = m > 0.f ? m * fac * (1.0f / 127.0f) : 1.0f; } }
    LDS_WAIT(); asm volatile("" ::: "memory");
    const int c4 = lane & 3, nn = lane >> 2;
    for (int kb = 0; kb < K / 64; ++kb) {
#pragma unroll
        for (int i = 0; i < 8; ++i) { const f32x4 v = *(const f32x4*)(wp + (size_t)(64 * kb + 8 * i) * N); LAS float* d = scr + (8 * i + kq) * 33 + 4 * gq; d[0] = v[0]; d[1] = v[1]; d[2] = v[2]; d[3] = v[3]; }
        LDS_WAIT(); asm volatile("" ::: "memory");
#pragma unroll
        for (int j = 0; j < 2; ++j) { const int n = nn + 16 * j; const float inv = invs[n]; const LAS float* sp = scr + (16 * c4) * 33 + n;
            u32x4 o; o.x = pk4_i8(sp[0 * 33] * inv, sp[1 * 33] * inv, sp[2 * 33] * inv, sp[3 * 33] * inv); o.y = pk4_i8(sp[4 * 33] * inv, sp[5 * 33] * inv, sp[6 * 33] * inv, sp[7 * 33] * inv);
            o.z = pk4_i8(sp[8 * 33] * inv, sp[9 * 33] * inv, sp[10 * 33] * inv, sp[11 * 33] * inv); o.w = pk4_i8(sp[12 * 33] * inv, sp[13 * 33] * inv, sp[14 * 33] * inv, sp[15 * 33] * inv);
            *(u32x4*)(WT + (size_t)(rd0 + n) * K + 64 * kb + 16 * c4) = o; }
        LDS_WAIT(); asm volatile("" ::: "memory");
    }
}
__device__ __forceinline__ void conv_block_i8(Frame& F, const float* W, int N, unsigned char* WT, int mt, float* swout, int nb) {
    constexpr int K = DM;
    const int lane = F.lane, w = F.wave, rd0 = 32 * nb, kq = lane >> 3, gq = lane & 7;
    const float fac = mt == 3 ? (((rd0 >> 7) & 1) ? LN2 : LOG2E) : 1.0f;
    LAS float* T = (LAS float*)F.lds; LAS float* xm = (LAS float*)(F.lds + pg8::XL_OFF_);
    const float* wp = W + (size_t)(128 * w + kq) * N + conv_map(mt, rd0 + 4 * gq);
    f32x4 mx = {0.f, 0.f, 0.f, 0.f};
#pragma unroll
    for (int i = 0; i < 16; ++i) { const f32x4 v = __builtin_nontemporal_load((const f32x4*)(wp + (size_t)(8 * i) * N));        const int k = 128 * w + 8 * i + kq, rot = 8 * ((k >> 4) & 3);
        LAS float* d = T + k * 32;
        d[(4 * gq + 0 + rot) & 31] = v[0]; d[(4 * gq + 1 + rot) & 31] = v[1]; d[(4 * gq + 2 + rot) & 31] = v[2]; d[(4 * gq + 3 + rot) & 31] = v[3];
        mx[0] = fmaxf(mx[0], fabsf(v[0])); mx[1] = fmaxf(mx[1], fabsf(v[1])); mx[2] = fmaxf(mx[2], fabsf(v[2])); mx[3] = fmaxf(mx[3], fabsf(v[3])); }
#pragma unroll
    for (int c = 0; c < 4; ++c) { mx[c] = fmaxf(mx[c], __shfl_xor(mx[c], 8)); mx[c] = fmaxf(mx[c], __shfl_xor(mx[c], 16)); mx[c] = fmaxf(mx[c], __shfl_xor(mx[c], 32)); }
    if (kq == 0) {
#pragma unroll
        for (int c = 0; c < 4; ++c) xm[w * 32 + 4 * gq + c] = mx[c]; }
    __syncthreads();
    const int c8 = lane & 7, n8 = lane >> 3;
#pragma unroll
    for (int j = 0; j < 4; ++j) { const int n = n8 + 8 * j;
        float m = xm[n];
#pragma unroll
        for (int ww = 1; ww < 8; ++ww) m = fmaxf(m, xm[ww * 32 + n]);
        const float inv = m > 0.f ? 127.0f / m : 0.f;
        if (w == 0 && c8 == 0) swout[rd0 + n] = m > 0.f ? m * fac * (1.0f / 127.0f) : 1.0f;
        const int k0 = 128 * w + 16 * c8, rot = 8 * ((k0 >> 4) & 3); const LAS float* sp = T + k0 * 32 + ((n + rot) & 31);
        u32x4 o; o.x = pk4_i8(sp[0 * 32] * inv, sp[1 * 32] * inv, sp[2 * 32] * inv, sp[3 * 32] * inv); o.y = pk4_i8(sp[4 * 32] * inv, sp[5 * 32] * inv, sp[6 * 32] * inv, sp[7 * 32] * inv);
        o.z = pk4_i8(sp[8 * 32] * inv, sp[9 * 32] * inv, sp[10 * 32] * inv, sp[11 * 32] * inv); o.w = pk4_i8(sp[12 * 32] * inv, sp[13 * 32] * inv, sp[14 * 32] * inv, sp[15 * 32] * inv);
        __builtin_nontemporal_store(o, (u32x4*)(WT + (size_t)(rd0 + n) * K + k0)); }
    __syncthreads();
}
__device__ __forceinline__ void conv_item(const float* W, int K, int N, bf16_t* WT, int mt, int item, int lane, LAS float* scr) {
    const int nblk = N / 32, kb = item / nblk, nb = item % nblk, k0 = 64 * kb, rd0 = 32 * nb;
    const float sc2 = mt == 3 ? (((rd0 >> 7) & 1) ? LN2 : LOG2E) : 1.0f;
    const int kq = lane >> 3, gq = lane & 7;
    const float* wp = W + (size_t)(k0 + kq) * N + conv_map(mt, rd0 + 4 * gq);
#pragma unroll
    for (int i = 0; i < 8; ++i) { const f32x4 v = __builtin_nontemporal_load((const f32x4*)(wp + (size_t)(8 * i) * N));        LAS float* d = scr + (8 * i + kq) * 33 + 4 * gq; d[0] = v[0]; d[1] = v[1]; d[2] = v[2]; d[3] = v[3]; }
    LDS_WAIT(); asm volatile("" ::: "memory");
    const int c = lane & 7;
#pragma unroll
    for (int j = 0; j < 4; ++j) { const int n = (lane >> 3) + 8 * j; const LAS float* s = scr + (8 * c) * 33 + n;
        u32x4 o; o.x = cvtpk(s[0 * 33] * sc2, s[1 * 33] * sc2); o.y = cvtpk(s[2 * 33] * sc2, s[3 * 33] * sc2); o.z = cvtpk(s[4 * 33] * sc2, s[5 * 33] * sc2); o.w = cvtpk(s[6 * 33] * sc2, s[7 * 33] * sc2);
        __builtin_nontemporal_store(o, (u32x4*)(WT + (size_t)(rd0 + n) * K + k0 + 8 * c)); }
    LDS_WAIT(); asm volatile("" ::: "memory");
}
template <int L>
__device__ __forceinline__ void conv_layer(Frame& F, int bi, int nb, int b0 = 0, int b1 = 1 << 30, int w0 = 0, int w1 = 1 << 30) {
    constexpr int NQ = layer_nqkv(L), MTQ = (layer_mixer(L) == 2) ? 2 : 1;
    constexpr int QDT = qkv_dt(), IDT = ffn_in_dt(L); constexpr bool OUT8 = ffn_out8(L), MOE = layer_moe(L);
    const float* wq = F.a->in[layer_base(L) + 4]; const float* wo = F.a->in[layer_wo_idx(L)];
    const float* win = F.a->in[layer_ffn_idx(L) + (MOE ? 2 : 0)]; const float* wout = F.a->in[layer_ffn_idx(L) + (MOE ? 3 : 1)];
    unsigned char* dq = F.ws + WS_WQKV + (size_t)layer_wqkv_row(L) * DM * (QDT ? 1 : 2);
    unsigned char* din = MOE ? F.ws + WS_WMOE : F.ws + WS_WDENSE + (L >> 1) * WDENSE_SLOT;
    unsigned char* dout = MOE ? F.ws + WS_WMOE + WMOE_IN_BYTES : din + (size_t)2 * DFF * DM * 2;
    constexpr int NEX = MOE ? NEXP : 1;
    constexpr size_t EB_IN = (size_t)2 * DFF * DM * (IDT ? 1 : 2), EB_OUT = (size_t)DM * DFF * (OUT8 ? 1 : 2);
    float* swin = MOE ? (float*)(F.ws + WS_SWM) : (float*)(F.ws + WS_SWD) + (L >> 1) * 2 * DFF;
    constexpr int B_Q = QDT == 2 ? NQ / 32 : 0, B_I = IDT == 2 ? NEX * (2 * DFF / 32) : 0;
    for (int g = b0 + bi; g < (b1 < B_Q + B_I ? b1 : B_Q + B_I); g += nb) {
        if (g < B_Q) conv_block_i8(F, wq, NQ, dq, MTQ, (float*)(F.ws + WS_SWQKV) + layer_wqkv_row(L), g);
        else { const int r = g - B_Q, e = r / (2 * DFF / 32), rr = r % (2 * DFF / 32); conv_block_i8(F, win + (size_t)e * DM * 2 * DFF, 2 * DFF, din + e * EB_IN, 3, swin + e * 2 * DFF, rr); }
    }
    LAS float* scr = (LAS float*)(F.lds + F.wave * 16384);
    constexpr int I_Q = QDT == 2 ? 0 : 16 * (NQ / 32), I_O = 16 * 32, I_DI = IDT == 2 ? 0 : 16 * (2 * DFF / 32), I_DO = (DFF / 64) * 32;
    constexpr int NIT = I_Q + I_O + NEX * (I_DI + I_DO);
    for (int g = w0 + bi * 8 + F.wave; g < (w1 < NIT ? w1 : NIT); g += nb * 8) {
        int r = g;
        if (r < I_Q) { if (QDT == 1) conv_item8(wq, DM, NQ, dq, MTQ, WQKV8_SCALE, r, F.lane, scr); else conv_item(wq, DM, NQ, (bf16_t*)dq, MTQ, r, F.lane, scr); continue; } r -= I_Q;
        if (r < I_O) { if (FP8_WO) conv_item8(wo, DM, DM, F.ws + WS_WO + (size_t)L * DM * DM, 0, WO8_SCALE, r, F.lane, scr);
                       else conv_item(wo, DM, DM, (bf16_t*)(F.ws + WS_WO) + (size_t)L * DM * DM, 0, r, F.lane, scr); continue; } r -= I_O;
        if (r < NEX * I_DI) { const int e = r / (I_DI > 0 ? I_DI : 1), rr = r % (I_DI > 0 ? I_DI : 1); const float* we = win + (size_t)e * DM * 2 * DFF;
            if (IDT == 1) conv_item8(we, DM, 2 * DFF, din + e * EB_IN, 3, WIN8_SCALE, rr, F.lane, scr); else conv_item(we, DM, 2 * DFF, (bf16_t*)(din + e * EB_IN), 3, rr, F.lane, scr); continue; } r -= NEX * I_DI;
        { const int e = r / I_DO, rr = r % I_DO; const float* we = wout + (size_t)e * DFF * DM;
            if (OUT8) conv_item8(we, DFF, DM, dout + e * EB_OUT, 0, WOUT8_SCALE, rr, F.lane, scr); else conv_item(we, DFF, DM, (bf16_t*)(dout + e * EB_OUT), 0, rr, F.lane, scr); }
    }
}
template <int LN>
__device__ __forceinline__ void tail_convert(Frame& F, int nunits, int b0 = 0, int b1 = 1 << 30, int w0 = 0, int w1 = 1 << 30) {
    const int rem = nunits % F.G; const int c = (int)blockIdx.x;
    if (rem == 0) conv_layer<LN>(F, c, F.G, b0, b1, w0, w1);
    else if (c >= rem) conv_layer<LN>(F, c - rem, F.G - rem, b0, b1, w0, w1);
}
#ifndef CV1_Q
#define CV1_Q 0
#endif
#ifndef CV1_A
#define CV1_A 370
#endif
#ifndef CV1_D
#define CV1_D 0
#endif
#ifndef CV3_M
#define CV3_M 250
#endif
#ifndef CV3_A
#define CV3_A 250
#endif
#ifndef CV3_B
#define CV3_B 370
#endif
#ifndef CV3_C
#define CV3_C 150
#endif
#ifndef CV3_W
#define CV3_W 0
#endif
constexpr int CVQ1 = 1536 / 32, CVQ3 = 3072 / 32, CVW_O = 512, CVW_HALF = 512 + 4 * 1792, CVW_ALL = 512 + 8 * 1792;
constexpr int CV1_0 = CVQ1 + CV1_Q, CV1_1 = CV1_0 + CV1_A, CV1_2 = CV1_1 + CV1_D;
constexpr int CV3_0 = CVQ3 + CV3_M, CV3_1 = CV3_0 + CV3_A, CV3_2 = CV3_1 + CV3_B, CV3_3 = CV3_2 + CV3_C;

__device__ __forceinline__ void phase_prologue(Frame& F) {
    LAS float* scond = (LAS float*)F.lds;
    LAS float* part = (LAS float*)(F.lds + 17 * 1024 * 4);
    for (int i = F.tid; i < NCOND * DM; i += 512) { const int ci = i >> 10, k = i & 1023; const float v = ci < 16 ? F.a->in[1][ci * DM + k] : F.a->in[3][k];
        scond[i] = v / (1.0f + __expf(-v)); }
    __syncthreads();
    for (int item = blockIdx.x; item < 4 * 96; item += F.G) {
        const int l = item / 96, nc = item % 96;
        const float* wm = F.a->in[layer_base(0)]; if (l == 1) wm = F.a->in[layer_base(1)]; if (l == 2) wm = F.a->in[layer_base(2)]; if (l == 3) wm = F.a->in[layer_base(3)];
        const float* bm = F.a->in[layer_base(0) + 1]; if (l == 1) bm = F.a->in[layer_base(1) + 1]; if (l == 2) bm = F.a->in[layer_base(2) + 1]; if (l == 3) bm = F.a->in[layer_base(3) + 1];
        f32x4 acc[NCOND];
#pragma unroll
        for (int ci = 0; ci < NCOND; ++ci) acc[ci] = (f32x4){0.f, 0.f, 0.f, 0.f};
        const int kq = F.lane >> 4, cq = F.lane & 15;
        const float* wp = wm + (size_t)(128 * F.wave + kq) * MODW + 64 * nc + 4 * cq;
        for (int i0 = 0; i0 < 32; i0 += 8) { f32x4 wv[8];
#pragma unroll
            for (int j = 0; j < 8; ++j) wv[j] = __builtin_nontemporal_load((const f32x4*)(wp + (size_t)(4 * (i0 + j)) * MODW));
#pragma unroll
            for (int j = 0; j < 8; ++j) { const LAS float* sc = scond + 128 * F.wave + 4 * (i0 + j) + kq;
#pragma unroll
                for (int ci = 0; ci < NCOND; ++ci) acc[ci] += wv[j] * sc[ci * DM];
                __builtin_amdgcn_sched_barrier(0); } }
#pragma unroll
        for (int ci = 0; ci < NCOND; ++ci)
#pragma unroll
            for (int c = 0; c < 4; ++c) { float v = acc[ci][c]; v += __shfl_xor(v, 16); v += __shfl_xor(v, 32); acc[ci][c] = v; }
        if (kq == 0) {
#pragma unroll
            for (int ci = 0; ci < NCOND; ++ci) *(LAS f32x4*)(part + (F.wave * NCOND + ci) * 64 + 4 * cq) = acc[ci]; }
        __syncthreads();
        for (int i = F.tid; i < NCOND * 64; i += 512) { const int ci = i >> 6, n = i & 63; float s = 0.f;
#pragma unroll
            for (int w = 0; w < 8; ++w) s += part[(w * NCOND + ci) * 64 + n];
            ((float*)(F.ws + WS_MOD))[(size_t)(l * NCOND + ci) * MODW + 64 * nc + n] = s + bm[64 * nc + n]; }
        __syncthreads();
    }
    { float* rt = (float*)(F.ws + WS_ROPE); const int gt = blockIdx.x * 512 + F.tid;
      if (gt < 65 * 16) { const int pos = gt >> 4, f = gt & 15; const float ang = (float)pos * powf(10000.0f, -(float)f / 16.0f); rt[gt] = pos < 64 ? cosf(ang) : 1.0f; rt[1040 + gt] = pos < 64 ? sinf(ang) : 0.0f; }
      else if (gt < 65 * 16 + 65 * 32) { const int g2 = gt - 1040, pos = g2 >> 5, f = g2 & 31; const float ang = (float)pos * powf(10000.0f, -(float)f / 32.0f); rt[2080 + g2] = pos < 64 ? cosf(ang) : 1.0f; rt[4160 + g2] = pos < 64 ? sinf(ang) : 0.0f; } }
    __syncthreads();
    conv_layer<0>(F, F.vcu, F.G);
}

__device__ __forceinline__ void reduce8(float (&lg)[8], int lane) {
    const bool o1 = lane & 1; float a[4];
#pragma unroll
    for (int i = 0; i < 4; ++i) { const float mine = o1 ? lg[4 + i] : lg[i], give = o1 ? lg[i] : lg[4 + i]; a[i] = mine + __shfl_xor(give, 1); }
    const bool o2 = lane & 2; float b2[2];
#pragma unroll
    for (int i = 0; i < 2; ++i) { const float mine = o2 ? a[2 + i] : a[i], give = o2 ? a[i] : a[2 + i]; b2[i] = mine + __shfl_xor(give, 2); }
    const bool o4 = lane & 4; float c1;
    { const float mine = o4 ? b2[1] : b2[0], give = o4 ? b2[0] : b2[1]; c1 = mine + __shfl_xor(give, 4); }
    c1 += __shfl_xor(c1, 8); c1 += __shfl_xor(c1, 16); c1 += __shfl_xor(c1, 32);
#pragma unroll
    for (int e = 0; e < 8; ++e) { const int src = ((e >> 2) & 1) | (((e >> 1) & 1) << 1) | ((e & 1) << 2); lg[e] = __shfl(c1, src); }
}
template <bool COMBINE, bool ROUTE, int OUTF, bool XIN32>
__device__ __forceinline__ void phase_norm(Frame& F, const float* g2prev, const float* gain, const float* modl, int psh, int psc, int nrows,
                                           const float* wrt, const float* brt, int moe_slot) {
    bf16_t* H = (bf16_t*)(F.ws + WS_H); const bf16_t* slots = (const bf16_t*)(F.ws + WS_SLOTS);
    LAS float* wr_l = (LAS float*)F.lds;
    LAS int* lcnt = (LAS int*)(F.lds + 32768);
    LAS int* ent_i = (LAS int*)(F.lds + 32768 + 64);
    LAS float* ent_w = (LAS float*)(F.lds + 32768 + 64 + 8 * 24 * 16);
    if (ROUTE) {
        for (int t = F.tid; t < DM * 8 / 4; t += 512) { const int d = t >> 1, half = t & 1, ln = (d & 255) >> 2, ii = d & 3, jj = d >> 8; ((LAS f32x4*)wr_l)[half * 1024 + (jj * 4 + ii) * 64 + ln] = ((const f32x4*)wrt)[t]; }
        if (F.tid < 16) lcnt[F.tid] = 0;
        __syncthreads();
    }
    const int rpw = nrows / F.NGW;
    const int row_b = F.gw * rpw;
    int ci_cur = -1; f32x4 ma[4], mb[4], mg[4];
#pragma unroll
    for (int j = 0; j < 4; ++j) { ma[j] = (f32x4){0.f, 0.f, 0.f, 0.f}; mb[j] = ma[j]; mg[j] = ma[j]; }
    f32x4 vnxA[2][4], vnxB[2][4]; u32x2 vnhA[2][4], vnhB[2][4]; u32x2 nsA[2][2][4], nsB[2][2][4];
    const float* xl32 = F.a->in[0]; const float* xc32 = F.a->in[2];
#define NORM_LOAD(NX, NH, NS, R0) do { _Pragma("unroll") for (int q = 0; q < 2; ++q) { const int _row = (R0) + q; const bool _lat = _row < TL; const size_t _ro = _lat ? (size_t)_row * DM : (size_t)(_row - TL) * DM; \
        if (XIN32) { const float* _x = (_lat ? xl32 : xc32) + _ro; _Pragma("unroll") for (int j = 0; j < 4; ++j) NX[q][j] = __builtin_nontemporal_load((const f32x4*)(_x + 4 * F.lane + 256 * j)); } \
        else { const bf16_t* _x = (_lat ? F.xl16 : F.xc16) + _ro; _Pragma("unroll") for (int j = 0; j < 4; ++j) NH[q][j] = *(const u32x2*)(_x + 4 * F.lane + 256 * j); } \
        if (COMBINE) { _Pragma("unroll") for (int k = 0; k < 2; ++k) _Pragma("unroll") for (int j = 0; j < 4; ++j) NS[q][k][j] = __builtin_nontemporal_load((const u32x2*)(slots + (size_t)(2 * _row + k) * DM + 4 * F.lane + 256 * j)); } } } while (0)
    auto pair = [&](f32x4 (&NX)[2][4], u32x2 (&NH)[2][4], u32x2 (&NS)[2][2][4], const int it, const int nxt) __attribute__((always_inline)) {
        const int row0 = row_b + it;
        f32x4 v[2][4]; u32x2 sl[2][2][4];
        bool lat[2]; size_t ro[2];
#pragma unroll
        for (int q = 0; q < 2; ++q) { const int row = row0 + q; lat[q] = row < TL; ro[q] = lat[q] ? (size_t)row * DM : (size_t)(row - TL) * DM;
#pragma unroll
            for (int j = 0; j < 4; ++j) { if (XIN32) v[q][j] = NX[q][j]; else v[q][j] = (f32x4){bf_lo(NH[q][j].x), bf_hi(NH[q][j].x), bf_lo(NH[q][j].y), bf_hi(NH[q][j].y)};
                if (COMBINE) { sl[q][0][j] = NS[q][0][j]; sl[q][1][j] = NS[q][1][j]; } } }
        if (nxt < rpw) NORM_LOAD(NX, NH, NS, row_b + nxt);
#pragma unroll
        for (int q = 0; q < 2; ++q) {
            const int row = row0 + q; const int ci = lat[q] ? (row >> 11) : 16;
            if (ci != ci_cur) { ci_cur = ci;
                if (gain != nullptr) { const float* mp = modl + (size_t)ci * MODW;
#pragma unroll
                    for (int j = 0; j < 4; ++j) { const int c0 = 4 * F.lane + 256 * j; const f32x4 gn = *(const f32x4*)(gain + c0), sc = *(const f32x4*)(mp + psc * DM + c0); ma[j] = gn * (1.0f + sc); mb[j] = *(const f32x4*)(mp + psh * DM + c0); } }
                if (COMBINE) {
#pragma unroll
                    for (int j = 0; j < 4; ++j) mg[j] = *(const f32x4*)(g2prev + (size_t)ci * MODW + 4 * F.lane + 256 * j); } }
            if (COMBINE) {
#pragma unroll
                for (int j = 0; j < 4; ++j) { const u32x2 s0 = sl[q][0][j], s1 = sl[q][1][j];
                    f32x4 sv; sv[0] = bf_lo(s0.x) + bf_lo(s1.x); sv[1] = bf_hi(s0.x) + bf_hi(s1.x); sv[2] = bf_lo(s0.y) + bf_lo(s1.y); sv[3] = bf_hi(s0.y) + bf_hi(s1.y);
                    v[q][j] = v[q][j] + mg[j] * sv;
                    if (gain == nullptr) __builtin_nontemporal_store(v[q][j], (f32x4*)(F.out + ro[q] + 4 * F.lane + 256 * j));
                    else { u32x2 o; o.x = cvtpk(v[q][j][0], v[q][j][1]); o.y = cvtpk(v[q][j][2], v[q][j][3]); st8((lat[q] ? F.xl16 : F.xc16) + ro[q] + 4 * F.lane + 256 * j, o); } }
            }
            if (gain == nullptr) continue;
            float ss = 0.f;
#pragma unroll
            for (int j = 0; j < 4; ++j) ss += (v[q][j][0] * v[q][j][0] + v[q][j][1] * v[q][j][1]) + (v[q][j][2] * v[q][j][2] + v[q][j][3] * v[q][j][3]);
            const float rstd = __builtin_amdgcn_rsqf(wave_sum(ss) * (1.0f / DM) + NORM_EPS);
#pragma unroll
            for (int j = 0; j < 4; ++j) v[q][j] = (v[q][j] * rstd) * ma[j] + mb[j];
            if (OUTF == 2) {
                float am = 0.f;
#pragma unroll
                for (int j = 0; j < 4; ++j) am = fmaxf(fmaxf(am, fmaxf(fabsf(v[q][j][0]), fabsf(v[q][j][1]))), fmaxf(fabsf(v[q][j][2]), fabsf(v[q][j][3])));
#pragma unroll
                for (int o = 1; o < 64; o <<= 1) am = fmaxf(am, __shfl_xor(am, o));
                const float inv = am > 0.f ? 127.0f / am : 0.f;
                if (F.lane == 0) ((float*)(F.ws + WS_SA))[row] = am > 0.f ? am * (1.0f / 127.0f) : 1.0f;
#pragma unroll
                for (int j = 0; j < 4; ++j) st4((unsigned char*)H + (size_t)row * DM + 4 * F.lane + 256 * j, pk4_i8(v[q][j][0] * inv, v[q][j][1] * inv, v[q][j][2] * inv, v[q][j][3] * inv));
            } else {
#pragma unroll
            for (int j = 0; j < 4; ++j) { const int c0 = 4 * F.lane + 256 * j;
                if (OUTF == 1) st4((unsigned char*)H + (size_t)row * DM + c0, pk4_fp8(v[q][j][0] * H8_SCALE, v[q][j][1] * H8_SCALE, v[q][j][2] * H8_SCALE, v[q][j][3] * H8_SCALE));
                else { u32x2 o; o.x = cvtpk(v[q][j][0], v[q][j][1]); o.y = cvtpk(v[q][j][2], v[q][j][3]); st8(H + (size_t)row * DM + c0, o); } } }
            if (ROUTE) {
                float lg[8];
#pragma unroll
                for (int e = 0; e < 8; ++e) lg[e] = 0.f;
#pragma unroll
                for (int j = 0; j < 4; ++j)
#pragma unroll
                    for (int i = 0; i < 4; ++i) { const f32x4 w0 = ((const LAS f32x4*)wr_l)[(j * 4 + i) * 64 + F.lane], w1 = ((const LAS f32x4*)wr_l)[1024 + (j * 4 + i) * 64 + F.lane]; const float hv = v[q][j][i];
                        lg[0] += hv * w0[0]; lg[1] += hv * w0[1]; lg[2] += hv * w0[2]; lg[3] += hv * w0[3]; lg[4] += hv * w1[0]; lg[5] += hv * w1[1]; lg[6] += hv * w1[2]; lg[7] += hv * w1[3]; }
                reduce8(lg, F.lane);
#pragma unroll
                for (int e = 0; e < 8; ++e) lg[e] += brt[e];
                int e0 = 0; float v0 = lg[0];
#pragma unroll
                for (int e = 1; e < 8; ++e) if (lg[e] > v0) { v0 = lg[e]; e0 = e; }
                int e1 = -1; float v1 = -INFINITY;
#pragma unroll
                for (int e = 0; e < 8; ++e) if (e != e0 && lg[e] > v1) { v1 = lg[e]; e1 = e; }
                if (e1 < 0) { e1 = (e0 + 1) & 7; v1 = v0; }
                const float w0 = 1.0f / (1.0f + __expf(v1 - v0)), w1 = 1.0f - w0;
                if (F.lane == 0) { const int p0 = atomicAdd((int*)&lcnt[e0], 1), p1 = atomicAdd((int*)&lcnt[e1], 1);
                    LAS int* ei = ent_i + (F.wave * 24 + it + q) * 4; ei[0] = e0; ei[1] = e1; ei[2] = p0; ei[3] = p1;
                    LAS float* ew = ent_w + (F.wave * 24 + it + q) * 2; ew[0] = w0; ew[1] = w1; }
            }
        }
    };
    NORM_LOAD(vnxA, vnhA, nsA, row_b);
    if (rpw > 2) NORM_LOAD(vnxB, vnhB, nsB, row_b + 2);
    for (int it = 0; it < rpw; it += 4) {
        pair(vnxA, vnhA, nsA, it, it + 4);
        if (it + 2 < rpw) pair(vnxB, vnhB, nsB, it + 2, it + 6);
    }
#undef NORM_LOAD
    if (ROUTE) {
        __syncthreads();
        unsigned* gcnt = (unsigned*)(F.ws + WS_CTL) + CW_MOECNT + moe_slot * 64;
        if (F.tid < 8) lcnt[8 + F.tid] = (int)__hip_atomic_fetch_add(gcnt + F.tid, (unsigned)lcnt[F.tid], __ATOMIC_RELAXED, __HIP_MEMORY_SCOPE_AGENT);
        __syncthreads();
        int* listTok = (int*)(F.ws + WS_LIST); float* listW = (float*)(F.ws + WS_LIST + (size_t)NEXP * TT * 4);
        for (int i = F.tid; i < 8 * 24 * 2; i += 512) { const int w = i / 48, r = (i % 48) >> 1, k = i & 1; const int row = (F.vcu * 8 + w) * rpw + r;
            if (r < rpw) { const int e = ent_i[(w * 24 + r) * 4 + k], p = ent_i[(w * 24 + r) * 4 + 2 + k] + lcnt[8 + e];
                listTok[e * TT + p] = row * 2 + k; listW[e * TT + p] = ent_w[(w * 24 + r) * 2 + k]; } }
    }
}

template <int MIXER, bool LAST>
__device__ __forceinline__ void phase_attention(Frame& F, const float* mparam) {
    constexpr int DH = MIXER == 2 ? 128 : 64, NQH = MIXER == 2 ? 8 : 16, NKV = MIXER == 0 ? 16 : 4, GQ = NQH / NKV, LDK = NKV * DH;
    const bf16_t* Q = (const bf16_t*)(F.ws + WS_Q); const bf16_t* K = (const bf16_t*)(F.ws + WS_K); const bf16_t* V = (const bf16_t*)(F.ws + WS_V); bf16_t* Y = (bf16_t*)(F.ws + WS_H);
    constexpr int UL = NB * NQH * 8;
    for (int ui = F.vcu; ui < UL; ui += F.G) {
        const int qblk = (ui + ui / F.G) & 7, h = (ui >> 3) % NQH, b = ui / (8 * NQH);
        att::AUnit u; u.qrow0 = b * SEQ + 256 * qblk; u.qcol = h * DH; u.kvcol = (h / GQ) * DH; u.kctx0 = TL + b * CTXL;
        if (MIXER == 0) { int lo = 4 * qblk - 4; lo = lo < 0 ? 0 : lo; int hi = 4 * qblk + 3 - 4; hi = hi < 0 ? 0 : (hi > 24 ? 24 : hi); hi += 8; if (lo > 24) lo = 24;
            u.klat0 = b * SEQ + 64 * lo; u.nlat = hi - lo; u.a0 = qblk; u.a1 = lo;
            att::attn_unit<64, 1, FP8_WO != 0>(F.lds, F.tid, Q, K, V, Y, LDK, u, mparam + h * 465, 0.f, false); }
        else if (MIXER == 1) { int tlo = 4 * qblk - 2; tlo = tlo < 0 ? 0 : tlo; int thi = 4 * qblk + 6; thi = thi > 32 ? 32 : thi;
            u.klat0 = b * SEQ + 64 * tlo; u.nlat = thi - tlo; u.a0 = 256 * qblk; u.a1 = 64 * tlo;
            att::attn_unit<64, 2, FP8_WO != 0>(F.lds, F.tid, Q, K, V, Y, LDK, u, nullptr, mparam[h] * LOG2E, true); }
        else { u.klat0 = b * SEQ; u.nlat = 32; u.a0 = 0; u.a1 = 0;
            att::attn_unit<128, 0, FP8_WO != 0>(F.lds, F.tid, Q, K, V, Y, LDK, u, nullptr, 0.f, false); }
    }
    if (!LAST) {
        constexpr int UC = NB * NQH;
        for (int ui = F.vcu; ui < UC; ui += F.G) {
            const int h = ui % NQH, b = ui / NQH;
            att::AUnit u; u.qrow0 = TL + b * CTXL; u.qcol = h * DH; u.kvcol = (h / GQ) * DH; u.kctx0 = TL + b * CTXL; u.klat0 = 0; u.nlat = 0; u.a0 = 0; u.a1 = 0;
            if (MIXER == 1) att::attn_unit<64, 0, FP8_WO != 0>(F.lds, F.tid, Q, K, V, Y, LDK, u, nullptr, mparam[h] * LOG2E, true);
            else if (MIXER == 0) att::attn_unit<64, 0, FP8_WO != 0>(F.lds, F.tid, Q, K, V, Y, LDK, u, nullptr, 0.f, false);
            else att::attn_unit<128, 0, FP8_WO != 0>(F.lds, F.tid, Q, K, V, Y, LDK, u, nullptr, 0.f, false);
        }
    }
}

__device__ __forceinline__ int moe_table(Frame& F, int moe_slot) {
    LAS int* mt = (LAS int*)(F.lds + MOE_OFF);
    unsigned* gcnt = (unsigned*)(F.ws + WS_CTL) + CW_MOECNT + moe_slot * 64;
    __syncthreads();
    if (F.tid == 0) { int tb = 0;
        for (int e = 0; e < 8; ++e) { const int c = (int)__hip_atomic_load(gcnt + e, __ATOMIC_RELAXED, __HIP_MEMORY_SCOPE_AGENT); mt[e] = c; mt[8 + e] = tb; tb += (c + 255) >> 8; }
        mt[16] = tb; }
    __syncthreads();
    return mt[16];
}

#define IN_(k) (lo <= (k) && (k) < hi)
#define REFRESH_() do { F.lane = lane_now(); F.tid = F.wave * 64 + F.lane; } while (0)
#define SEAM_(k) do { if (IN_(k) && IN_((k) + 1)) xcd_barrier(bar); } while (0)
template <int L>
__device__ __forceinline__ void run_layer(Frame& F, const XcdBarrier& bar, int lo, int hi) {
    constexpr int LB = layer_base(L), MIX = layer_mixer(L); constexpr bool MOE = layer_moe(L), LAST = (L == 3), PREV_MOE = (L > 0) && layer_moe(L - 1);
    constexpr int P = 1 + 7 * L;
    constexpr int NROWS = LAST ? TL : TT;
    constexpr int QDT = qkv_dt(), IDT = ffn_in_dt(L); constexpr bool OUT8 = ffn_out8(L);
    const float* modl = F.mod + (size_t)L * NCOND * MODW;
    bf16_t* H = (bf16_t*)(F.ws + WS_H);
    const float* SA = (const float*)(F.ws + WS_SA);
    if (IN_(P + 0)) { REFRESH_();
        phase_norm<PREV_MOE, false, QDT, L == 0>(F, F.mod + (size_t)(L > 0 ? L - 1 : 0) * NCOND * MODW + 5 * DM, F.a->in[LB + 2], modl, 0, 1, TT, nullptr, nullptr, 0);
    }
    SEAM_(P + 0);
    if (IN_(P + 1)) { REFRESH_();
        pg8::Gemm g{H, F.ws + WS_WQKV + (size_t)layer_wqkv_row(L) * DM * (QDT ? 1 : 2), QDT ? DM : 2 * DM, E8_2M6, E8_2M6, E8_2M2};
        pg8::Order<0> S; S.init(TT / 256, layer_nqkv(L) / 256, F.G, (int)blockIdx.x);
        const float* rt = (const float*)(F.ws + WS_ROPE); const float* swq = (const float*)(F.ws + WS_SWQKV) + layer_wqkv_row(L);
        if (MIX == 2) { pg8::EpiQKV128<QDT == 2> E{(bf16_t*)(F.ws + WS_Q), (bf16_t*)(F.ws + WS_K), (bf16_t*)(F.ws + WS_V), F.a->in[LB + 5], F.a->in[LB + 6], rt + 2080, rt + 4160, (LAS float*)(F.lds + XL_OFF), 1.0f, SA, swq};
            pg8::gemm_phase<QDT>(F.lds, F.tid, g, S, E); }
        else { pg8::EpiQKV64<QDT == 2> E{(bf16_t*)(F.ws + WS_Q), (bf16_t*)(F.ws + WS_K), (bf16_t*)(F.ws + WS_V), MIX == 0 ? 4 : 1, MIX == 0 ? 1024 : 256, F.a->in[LB + 5], F.a->in[LB + 6], rt, rt + 1040, MIX == 1, 1.0f, SA, swq};
            pg8::gemm_phase<QDT>(F.lds, F.tid, g, S, E); }
        if (L == 0) { REFRESH_(); tail_convert<1>(F, (TT / 256) * (layer_nqkv(L) / 256), 0, CV1_0, 0, 0); }
        if (L == 1) { REFRESH_(); tail_convert<1>(F, (TT / 256) * (layer_nqkv(L) / 256), 0, 0, CVW_O, CVW_HALF); }
        if (L == 2) { REFRESH_(); tail_convert<3>(F, (TT / 256) * (layer_nqkv(L) / 256), CV3_0, CV3_1, 0, 0); }
        if (L == 3) { REFRESH_(); tail_convert<3>(F, (TT / 256) * (layer_nqkv(L) / 256), 0, 0, CVW_ALL - CV3_W, CVW_ALL); }
    }
    SEAM_(P + 1);
    if (IN_(P + 2)) { REFRESH_(); phase_attention<MIX, LAST>(F, MIX == 2 ? nullptr : F.a->in[LB + 7]); }
    SEAM_(P + 2);
    if (IN_(P + 3)) { REFRESH_();
        pg8::Gemm g{F.ws + WS_H, F.ws + WS_WO + (size_t)L * DM * DM * (FP8_WO ? 1 : 2), FP8_WO ? DM : 2 * DM, E8_2M6, E8_2M6, E8_2M6};
        pg8::Order<0> S; S.init(NROWS / 256, 4, F.G, (int)blockIdx.x);
        pg8::EpiResid<L == 0> E{L == 0 ? (const void*)F.a->in[0] : (const void*)F.xl16, L == 0 ? (const void*)F.a->in[2] : (const void*)F.xc16, F.xl16, F.xc16, modl + 2 * DM, 1.0f};
        pg8::gemm_phase<FP8_WO ? 1 : 0>(F.lds, F.tid, g, S, E);
        if (L == 0) { REFRESH_(); tail_convert<1>(F, (NROWS / 256) * 4, CV1_0, CV1_1, 0, 0); }
        if (L == 1) { REFRESH_(); tail_convert<1>(F, (NROWS / 256) * 4, 0, 0, CVW_HALF, 1 << 30); }
        if (L == 2) { REFRESH_(); tail_convert<3>(F, (NROWS / 256) * 4, CV3_1, CV3_2, 0, 0); }
    }
    SEAM_(P + 3);
    if (IN_(P + 4)) { REFRESH_();
        if (MOE) phase_norm<false, true, IDT, false>(F, nullptr, F.a->in[LB + 3], modl, 3, 4, NROWS, F.a->in[layer_ffn_idx(L)], F.a->in[layer_ffn_idx(L) + 1], L >> 1);
        else phase_norm<false, false, IDT, false>(F, nullptr, F.a->in[LB + 3], modl, 3, 4, NROWS, nullptr, nullptr, 0);
    }
    SEAM_(P + 4);
    if (IN_(P + 5)) { REFRESH_();
        constexpr bool UPX8 = (IDT != 1 && OUT8);
        if (MOE) { const int ntile = moe_table(F, L >> 1);
            pg8::EpiSwiGLU<OUT8, IDT == 2, true, UPX8> E{F.ws + WS_ACT, SA, (const float*)(F.ws + WS_SWM), (const int*)(F.ws + WS_LIST), (const LAS int*)(F.lds + MOE_OFF), TT};
            pg8::Gemm g{H, F.ws + WS_WMOE, IDT ? DM : 2 * DM, E8_2M6, OUT8 ? E8_2M3 : E8_2M6, E8_2M2};
            pg8::Order<1> S; S.init(ntile, 2 * DFF / 256, F.G, (int)blockIdx.x); S.moe = (const LAS int*)(F.lds + MOE_OFF); S.listTok = (const int*)(F.ws + WS_LIST); S.cap = TT;
            pg8::gemm_phase<IDT>(F.lds, F.tid, g, S, E); }
        else { pg8::EpiSwiGLU<OUT8, IDT == 2, false, UPX8> E{F.ws + WS_ACT, SA, (const float*)(F.ws + WS_SWD) + (L >> 1) * 2 * DFF, nullptr, nullptr, 0};
            pg8::Gemm g{H, F.ws + WS_WDENSE + (L >> 1) * WDENSE_SLOT, IDT ? DM : 2 * DM, E8_2M6, OUT8 ? E8_2M3 : E8_2M6, E8_2M2};
            pg8::Order<0> S; S.init(NROWS / 256, 2 * DFF / 256, F.G, (int)blockIdx.x);
            pg8::gemm_phase<IDT>(F.lds, F.tid, g, S, E);
            if (L == 0) { REFRESH_(); tail_convert<1>(F, (NROWS / 256) * (2 * DFF / 256), CV1_1, CV1_2, 0, 0); }
            if (L == 2) { REFRESH_(); tail_convert<3>(F, (NROWS / 256) * (2 * DFF / 256), CV3_2, CV3_3, 0, 0); } }
    }
    SEAM_(P + 5);
    if (IN_(P + 6)) { REFRESH_();
        if (MOE) { const int ntile = moe_table(F, L >> 1);
            pg8::Gemm g{F.ws + WS_ACT, F.ws + WS_WMOE + WMOE_IN_BYTES, OUT8 ? DFF : 2 * DFF, E8_2M7, E8_2M7, E8_2M3};
            pg8::Order<2> S; S.init(ntile, 4, F.G, (int)blockIdx.x); S.moe = (const LAS int*)(F.lds + MOE_OFF); S.listTok = nullptr; S.cap = TT;
            pg8::EpiMoeOut E{(bf16_t*)(F.ws + WS_SLOTS), (const int*)(F.ws + WS_LIST), (const float*)(F.ws + WS_LIST + (size_t)NEXP * TT * 4), (const LAS int*)(F.lds + MOE_OFF), TT, 1.0f};
            pg8::gemm_phase<OUT8 ? 1 : 0, true>(F.lds, F.tid, g, S, E);
            if (L == 1) { REFRESH_(); tail_convert<2>(F, ntile * 4); REFRESH_(); tail_convert<3>(F, ntile * 4, 0, CV3_0, 0, 0); } }
        else { pg8::Gemm g{F.ws + WS_ACT, F.ws + WS_WDENSE + (L >> 1) * WDENSE_SLOT + (size_t)2 * DFF * DM * 2, OUT8 ? DFF : 2 * DFF, E8_2M7, E8_2M7, E8_2M3};
            pg8::Order<0> S; S.init(NROWS / 256, 4, F.G, (int)blockIdx.x);
            pg8::EpiResid<false> E{F.xl16, F.xc16, F.xl16, F.xc16, modl + 5 * DM, 1.0f};
            pg8::gemm_phase<OUT8 ? 1 : 0>(F.lds, F.tid, g, S, E);
            if (L == 0) { REFRESH_(); tail_convert<1>(F, (NROWS / 256) * 4, CV1_2, 1 << 30, 0, CVW_O); }
            if (L == 2) { REFRESH_(); tail_convert<3>(F, (NROWS / 256) * 4, CV3_3, 1 << 30, 0, CVW_ALL - CV3_W); } }
    }
    SEAM_(P + 6);
}

constexpr int N_PHASES = 30;
__global__ void __launch_bounds__(512, 2) mk_fwd(Args args) {
    extern __shared__ __attribute__((aligned(16))) unsigned char lds_raw[];
    Frame F;
    F.lds = (LAS unsigned char*)lds_raw;
    F.wave = __builtin_amdgcn_readfirstlane((int)threadIdx.x >> 6); F.lane = lane_now(); F.tid = F.wave * 64 + F.lane;
    F.G = gridDim.x; { const int bx = blockIdx.x; F.vcu = (F.G % 8 == 0) ? (bx % 8) * (F.G / 8) + bx / 8 : bx; }
    F.gw = F.vcu * 8 + F.wave; F.NGW = F.G * 8;
    F.a = &args; F.ws = args.ws; F.out = args.out; F.xl16 = (bf16_t*)(args.ws + WS_XBL); F.xc16 = (bf16_t*)(args.ws + WS_XC); F.mod = (const float*)(args.ws + WS_MOD);
    volatile LAS unsigned* MISC = (volatile LAS unsigned*)(F.lds + MISC_OFF);
    for (int u = F.tid; u < (PARK_OFF - MOE_OFF) / 4; u += 512) ((LAS unsigned*)(F.lds + MOE_OFF))[u] = 0u;
    __syncthreads();
    const int lo = args.ph_lo, hi = args.ph_hi;
    XcdBarrier bar; bar.bar = (unsigned*)(F.ws + WS_CTL) + CW_BAR; bar.x = 0; bar.st = nullptr; bar.wave = F.wave;
    if (hi - lo > 1) bar = xcd_barrier_post((unsigned*)(F.ws + WS_CTL) + CW_BAR, MISC + 8, F.wave);

    if (IN_(0)) { REFRESH_(); phase_prologue(F); }
    SEAM_(0);
    run_layer<0>(F, bar, lo, hi);
    run_layer<1>(F, bar, lo, hi);
    run_layer<2>(F, bar, lo, hi);
    run_layer<3>(F, bar, lo, hi);
    if (IN_(29)) { REFRESH_(); phase_norm<true, false, 0, false>(F, F.mod + (size_t)3 * NCOND * MODW + 5 * DM, nullptr, nullptr, 0, 0, TL, nullptr, nullptr, 0); }
}

extern "C" void kernel_launch(void* const* d_in, const int* in_sizes, int n_in, void* d_out, int out_size, void* d_ws, size_t ws_size, hipStream_t stream) {
    static int grid = 0;
    if (grid == 0) {
        if (n_in != N_IN || out_size != TL * DM || ws_size < WS_END) { fprintf(stderr, "kernel_launch: unexpected shapes: n_in %d out %d ws %zu (need %zu)\n", n_in, out_size, ws_size, (size_t)WS_END); grid = -1; return; }
        int dev = 0, cus = 0, per_cu = 0;
        if (hipGetDevice(&dev) != hipSuccess || hipDeviceGetAttribute(&cus, hipDeviceAttributeMultiprocessorCount, dev) != hipSuccess) { grid = -1; return; }
        if (hipFuncSetAttribute((const void*)mk_fwd, hipFuncAttributeMaxDynamicSharedMemorySize, LDS_BYTES) != hipSuccess) { fprintf(stderr, "kernel_launch: hipFuncSetAttribute failed\n"); grid = -1; return; }
        if (hipOccupancyMaxActiveBlocksPerMultiprocessor(&per_cu, (const void*)mk_fwd, 512, LDS_BYTES) != hipSuccess || per_cu < 1) fprintf(stderr, "kernel_launch: occupancy query says %d\n", per_cu);
        (void)hipGetLastError();
        grid = cus;
        if (grid != 256) fprintf(stderr, "kernel_launch: built for 256 CUs, device has %d\n", cus);
    }
    if (grid < 0) return;
    (void)hipMemsetAsync((char*)d_ws + WS_CTL, 0, CTL_ZERO_BYTES, stream);
    Args a{};
    for (int i = 0; i < N_IN; ++i) a.in[i] = (const float*)d_in[i];
    a.out = (float*)d_out; a.ws = (unsigned char*)d_ws;
#if MK_PER_PHASE
    for (int p = 0; p < N_PHASES; ++p) { a.ph_lo = p; a.ph_hi = p + 1; hipLaunchKernelGGL(mk_fwd, dim3(grid), dim3(512), LDS_BYTES, stream, a); }
#else
    a.ph_lo = 0; a.ph_hi = N_PHASES;
    hipLaunchKernelGGL(mk_fwd, dim3(grid), dim3(512), LDS_BYTES, stream, a);
#endif
}
```

```cpp
#include <hip/hip_runtime.h>
#include <cstdio>
#include <cstdint>

#ifndef MK_PER_PHASE
#define MK_PER_PHASE 0
#endif

#define LAS __attribute__((address_space(3)))
#define GAS __attribute__((address_space(1)))
typedef unsigned short bf16_t;
typedef short bf16x8 __attribute__((ext_vector_type(8)));
typedef short s16x4 __attribute__((ext_vector_type(4)));
typedef float f32x4 __attribute__((ext_vector_type(4)));
typedef float f32x2 __attribute__((ext_vector_type(2)));
typedef float f32x16 __attribute__((ext_vector_type(16)));
typedef unsigned u32x4 __attribute__((ext_vector_type(4)));
typedef unsigned u32x2 __attribute__((ext_vector_type(2)));
typedef __bf16 bf16x2_t __attribute__((ext_vector_type(2)));
typedef GAS unsigned gu32;

__device__ __forceinline__ int lane_now0() { int l; asm volatile("v_mbcnt_lo_u32_b32 %0, -1, 0\n\tv_mbcnt_hi_u32_b32 %0, -1, %0" : "=v"(l)); return l; }
#ifndef WT_STORES
#define WT_STORES 0
#endif
__device__ __forceinline__ void st16(void* p, u32x4 v) { if (WT_STORES) asm volatile("global_store_dwordx4 %0, %1, off sc1\n\ts_nop 1" :: "v"(p), "v"(v) : "memory"); else *(u32x4*)p = v; }
__device__ __forceinline__ void st8(void* p, u32x2 v) { if (WT_STORES) asm volatile("global_store_dwordx2 %0, %1, off sc1" :: "v"(p), "v"(v) : "memory"); else *(u32x2*)p = v; }
__device__ __forceinline__ void st4(void* p, unsigned v) { if (WT_STORES) asm volatile("global_store_dword %0, %1, off sc1" :: "v"(p), "v"(v) : "memory"); else *(unsigned*)p = v; }
__device__ __forceinline__ void st16f(void* p, f32x4 v) { st16(p, __builtin_bit_cast(u32x4, v)); }
__device__ __forceinline__ unsigned cvtpk(float lo, float hi) { f32x2 v = {lo, hi}; bf16x2_t b = __builtin_convertvector(v, bf16x2_t); return __builtin_bit_cast(unsigned, b); }
__device__ __forceinline__ unsigned pk4_fp8(float a, float b, float c, float d) {
    a = __builtin_amdgcn_fmed3f(a, -448.f, 448.f); b = __builtin_amdgcn_fmed3f(b, -448.f, 448.f); c = __builtin_amdgcn_fmed3f(c, -448.f, 448.f); d = __builtin_amdgcn_fmed3f(d, -448.f, 448.f);
    int w = 0; w = __builtin_amdgcn_cvt_pk_fp8_f32(a, b, w, false); w = __builtin_amdgcn_cvt_pk_fp8_f32(c, d, w, true); return (unsigned)w; }
__device__ __forceinline__ float bf_lo(unsigned w) { return __builtin_bit_cast(float, w << 16); }
__device__ __forceinline__ float bf_hi(unsigned w) { return __builtin_bit_cast(float, w & 0xffff0000u); }

constexpr int NB = 16, SEQ = 2048, DM = 1024, CTXL = 256;
constexpr int TL = NB * SEQ, TC = NB * CTXL, TT = TL + TC;
constexpr int DFF = 3584, NEXP = 8, MODW = 6 * DM, NCOND = 17;
constexpr float NORM_EPS = 1e-6f;
constexpr float LOG2E = 1.4426950408889634f, LN2 = 0.6931471805599453f;
#ifndef FP8_MOE_IN
#define FP8_MOE_IN 1
#endif
#ifndef FP8_MOE_OUT
#define FP8_MOE_OUT 1
#endif
#ifndef FP8_QKV
#define FP8_QKV 1
#endif
#ifndef FP8_WO
#define FP8_WO 1
#endif
#ifndef FP8_DENSE_IN
#define FP8_DENSE_IN 0
#endif
#ifndef FP8_DENSE_OUT
#define FP8_DENSE_OUT 1
#endif
#ifndef I8_QKV
#define I8_QKV 1
#endif
#ifndef I8_DENSE_IN
#define I8_DENSE_IN 1
#endif
#ifndef I8_MOE_IN
#define I8_MOE_IN 1
#endif
__host__ __device__ constexpr int qkv_dt() { return I8_QKV ? 2 : (FP8_QKV ? 1 : 0); }
__host__ __device__ constexpr int ffn_in_dt(int L) { return (L & 1) ? (I8_MOE_IN ? 2 : (FP8_MOE_IN ? 1 : 0)) : (I8_DENSE_IN ? 2 : (FP8_DENSE_IN ? 1 : 0)); }
__host__ __device__ constexpr bool ffn_out8(int L) { return (L & 1) ? (FP8_MOE_OUT != 0) : (FP8_DENSE_OUT != 0); }
constexpr float H8_SCALE = 4.0f, WIN8_SCALE = 64.0f, ACT8_SCALE = 8.0f, WOUT8_SCALE = 128.0f;
constexpr float WQKV8_SCALE = 64.0f, Y8_SCALE = 64.0f, WO8_SCALE = 64.0f;
constexpr float QKV_DESCALE = 1.0f / (H8_SCALE * WQKV8_SCALE), WO_DESCALE = 1.0f / (Y8_SCALE * WO8_SCALE);
constexpr int E8_1 = 0x7f7f7f7f, E8_2M2 = 0x7d7d7d7d, E8_2M3 = 0x7c7c7c7c, E8_2M6 = 0x79797979, E8_2M7 = 0x78787878;
constexpr float FFN_IN_DESCALE = 1.0f / (H8_SCALE * WIN8_SCALE), FFN_OUT_DESCALE = 1.0f / (ACT8_SCALE * WOUT8_SCALE);

namespace pg8 {
constexpr int BM = 256, BK = 64, HALF = 128, HTB = HALF * BK * 2, STAGE_BYTES = 8 * HTB, NXCD = 8, WGM = 8;
constexpr int XL_OFF_ = 131072;
constexpr int PARK_OFF_ = 140288;
__host__ __device__ __forceinline__ int lds_byte(int r, int c) { const int st = (r >> 4) * 2 + (c >> 5), rr = r & 15, cc = c & 31, ob = rr * 64 + cc * 2; return st * 1024 + (ob ^ (((ob >> 9) & 1) << 5)); }
__host__ __device__ __forceinline__ void stage_rc(int b, int& R, int& C) { const int st = b / 1024, sb = b % 1024, swz = sb ^ (((sb >> 9) & 1) << 5); R = (st >> 1) * 16 + swz / 64; C = (st & 1) * 32 + (swz % 64) / 2; }

struct Unit { int pm, pn, pb, e, r0; };
struct Gemm { const void* A; const void* Bt; int Kb; int sw0, sw1, sa; };

template <int MODE> struct Order {
    static constexpr bool GATHER = (MODE == 1);
    int nM, nN, nwg, G, c; const LAS int* moe; const int* listTok; int cap;
    __device__ __forceinline__ void init(int nM_, int nN_, int G_, int c_) { nM = nM_; nN = nN_; nwg = nM * nN; G = G_; c = c_; }
    __device__ __forceinline__ bool next(int i, Unit& u) const {
        const long L = (long)i * G + c; if (L >= nwg) return false;
        int wgid = (int)L; { const int q = nwg / NXCD, r = nwg % NXCD, xcd = wgid % NXCD, off = wgid / NXCD; wgid = (xcd < r ? xcd * (q + 1) : r * (q + 1) + (xcd - r) * q) + off; }
        if (MODE == 2) wgid = nwg - 1 - wgid;
        const int nig = WGM * nN, gid = wgid / nig, fm = gid * WGM, gsz = (nM - fm) < WGM ? (nM - fm) : WGM;
        u.pm = fm + ((wgid % nig) % gsz); u.pn = (wgid % nig) / gsz; u.pb = u.pn; u.e = 0; u.r0 = 0;
        if (MODE != 0) { int e = 0;
#pragma unroll
            for (int k = 1; k < 8; ++k) e += (u.pm >= moe[8 + k]) ? 1 : 0;
            e = __builtin_amdgcn_readfirstlane(e);
            u.e = e; u.r0 = __builtin_amdgcn_readfirstlane((u.pm - moe[8 + e]) * 256); u.pb = e * nN + u.pn; }
        return true;
    }
    __device__ __forceinline__ void a_offsets(const Unit& u, int Kb, const int (&R)[2], const int (&C)[2], unsigned (&va)[2][2]) const {
#pragma unroll
        for (int h = 0; h < 2; ++h)
#pragma unroll
            for (int i = 0; i < 2; ++i) {
                int row;
                if (MODE == 1) { const int pos = u.r0 + h * 128 + R[i]; const int idx = pos < moe[u.e] ? pos : 0; row = listTok[u.e * cap + idx] >> 1; }
                else row = u.pm * 256 + h * 128 + R[i];
                va[h][i] = (unsigned)row * (unsigned)Kb + (unsigned)C[i] * 2u;
            }
    }
};

typedef int v8i __attribute__((ext_vector_type(8)));
typedef int v4i_t __attribute__((ext_vector_type(4)));
__device__ __forceinline__ void glds_s(const void* sbase, unsigned voff, unsigned lds_dst) { unsigned keep;
    asm volatile("s_mov_b32 %0, m0\n\ts_mov_b32 m0, %3\n\ts_nop 0\n\tglobal_load_lds_dwordx4 %1, %2\n\ts_mov_b32 m0, %0" : "=&s"(keep) : "v"(voff), "s"(sbase), "s"(lds_dst) : "memory"); }
template <int DT, class Epi, class Sched>
__device__ __forceinline__ void gemm_phase(LAS unsigned char* lds, const int tid, const Gemm g, const Sched& S, const Epi& E) {
    const int wid = __builtin_amdgcn_readfirstlane(tid >> 6), lane = tid & 63, wr = wid >> 2, wc = wid & 3, fr = lane & 15, fq = lane >> 4;
    const int K = g.Kb, nt = K / 128;
    int R[2], C[2]; unsigned voffB[2];
#pragma unroll
    for (int i = 0; i < 2; ++i) { stage_rc(tid * 16 + i * 8192, R[i], C[i]); voffB[i] = (unsigned)(R[i] * K + C[i] * 2); }
    const size_t kstep = 128;
    const size_t hstep = (size_t)HALF * K;
    const size_t tstep = 2 * hstep;
    const unsigned ldsb = (unsigned)(uintptr_t)lds + (unsigned)wid * 1024u;
    const int aoff = lds_byte(wr * 64 + fr, fq * 8), boff = lds_byte(wc * 32 + fr, fq * 8);
#define PG8_SA(b, h) (((b) * 2 + (h)) * HTB)
#define PG8_SB(b, h) ((4 + (b) * 2 + (h)) * HTB)
#ifndef STAGE_BUILTIN_NONFP8
#define STAGE_BUILTIN_NONFP8 1
#endif
#define PG8_STAGE(bufoff, gbase, voff) do { _Pragma("unroll") for (int _i = 0; _i < 2; ++_i) { \
        if constexpr (DT != 1 && STAGE_BUILTIN_NONFP8) __builtin_amdgcn_global_load_lds((const unsigned*)((const char*)(gbase) + (voff)[_i]), (LAS unsigned*)(lds + (bufoff) + wid * 1024 + _i * 8192), 16, 0, 0); \
        else glds_s((const void*)(gbase), (voff)[_i], ldsb + (unsigned)((bufoff) + _i * 8192)); } } while (0)
#define PG8_LDA(dst, b, h) do { _Pragma("unroll") for (int m = 0; m < 4; ++m) _Pragma("unroll") for (int k = 0; k < 2; ++k) dst[m][k] = *(const LAS bf16x8*)(lds + PG8_SA(b, h) + aoff + m * 2048 + k * 1024); } while (0)
#define PG8_LDB(dst, b, h) do { _Pragma("unroll") for (int n = 0; n < 2; ++n) _Pragma("unroll") for (int k = 0; k < 2; ++k) dst[n][k] = *(const LAS bf16x8*)(lds + PG8_SB(b, h) + boff + n * 2048 + k * 1024); } while (0)
#define PG8_CAT(x) __builtin_bit_cast(v8i, __builtin_shufflevector((x)[0], (x)[1], 0, 1, 2, 3, 4, 5, 6, 7, 8, 9, 10, 11, 12, 13, 14, 15))
#define PG8_MMA(ai, bj, At, Bt) do { __builtin_amdgcn_s_setprio(1); _Pragma("unroll") for (int m = 0; m < 4; ++m) _Pragma("unroll") for (int n = 0; n < 2; ++n) { \
        if constexpr (DT == 1) acc[ai][bj][m][n] = __builtin_amdgcn_mfma_scale_f32_16x16x128_f8f6f4(PG8_CAT(Bt[n]), PG8_CAT(At[m]), acc[ai][bj][m][n], 0, 0, 0, (bj) ? g.sw1 : g.sw0, 0, g.sa); \
        else if constexpr (DT == 2) { _Pragma("unroll") for (int k = 0; k < 2; ++k) acc[ai][bj][m][n] = __builtin_bit_cast(f32x4, __builtin_amdgcn_mfma_i32_16x16x64_i8(__builtin_bit_cast(v4i_t, Bt[n][k]), __builtin_bit_cast(v4i_t, At[m][k]), __builtin_bit_cast(v4i_t, acc[ai][bj][m][n]), 0, 0, 0)); } \
        else { _Pragma("unroll") for (int k = 0; k < 2; ++k) acc[ai][bj][m][n] = __builtin_amdgcn_mfma_f32_16x16x32_bf16(Bt[n][k], At[m][k], acc[ai][bj][m][n], 0, 0, 0); } } \
        __builtin_amdgcn_s_setprio(0); } while (0)
#define PG8_WAIT_V(n) asm volatile("s_waitcnt vmcnt(" #n ")" ::: "memory")
#define PG8_WAIT_L(n) asm volatile("s_waitcnt lgkmcnt(" #n ")" ::: "memory")
#define PG8_BAR __builtin_amdgcn_s_barrier()
#define PG8_SCHED __builtin_amdgcn_sched_barrier(0)
    Unit cur, nxt; int ui = 0;
    if (!S.next(0, cur)) return;
    f32x4 acc[2][2][4][2];
#pragma unroll
    for (int a = 0; a < 2; ++a)
#pragma unroll
        for (int b = 0; b < 2; ++b)
#pragma unroll
            for (int m = 0; m < 4; ++m)
#pragma unroll
                for (int n = 0; n < 2; ++n) acc[a][b][m][n] = (f32x4){0.f, 0.f, 0.f, 0.f};
    bf16x8 At[4][2], B0[2][2], B1[2][2];
    constexpr bool GATHER = Sched::GATHER;
    unsigned vc[2][2];
    LAS unsigned* park = (LAS unsigned*)(lds + PARK_OFF_) + tid * 4;
    const char* cA = (const char*)g.A;
    if constexpr (GATHER) S.a_offsets(cur, K, R, C, vc);
    else {
#pragma unroll
        for (int h = 0; h < 2; ++h)
#pragma unroll
            for (int i = 0; i < 2; ++i) vc[h][i] = (unsigned)((h * HALF + R[i]) * K + C[i] * 2);
        cA += (size_t)cur.pm * tstep; }
    const char* cB = (const char*)g.Bt + (size_t)cur.pb * tstep;
    PG8_STAGE(PG8_SB(0, 0), cB, voffB); PG8_STAGE(PG8_SB(0, 1), cB + hstep, voffB); PG8_STAGE(PG8_SA(0, 0), cA, vc[0]); PG8_STAGE(PG8_SA(0, 1), cA, vc[1]);
    if (wr == 1) PG8_BAR;
    PG8_WAIT_V(2); PG8_BAR;
    PG8_STAGE(PG8_SB(1, 0), cB + kstep, voffB); PG8_STAGE(PG8_SA(1, 0), cA + kstep, vc[0]); PG8_STAGE(PG8_SB(1, 1), cB + hstep + kstep, voffB);
    PG8_WAIT_V(6); PG8_BAR;
    for (;;) {
        const bool has_next = S.next(ui + 1, nxt);
        if constexpr (!GATHER) { *(LAS u32x4*)park = (u32x4){vc[0][0], vc[0][1], vc[1][0], vc[1][1]}; }
        if constexpr (GATHER) { unsigned vn[2][2];
            if (has_next) S.a_offsets(nxt, K, R, C, vn);
            else {
#pragma unroll
                for (int h = 0; h < 2; ++h)
#pragma unroll
                    for (int i = 0; i < 2; ++i) vn[h][i] = vc[h][i]; }
            *(LAS u32x4*)park = (u32x4){vn[0][0], vn[0][1], vn[1][0], vn[1][1]}; }
        const char* nA = GATHER ? (const char*)g.A : (has_next ? (const char*)g.A + (size_t)nxt.pm * tstep : cA);
        const char* nB = has_next ? (const char*)g.Bt + (size_t)nxt.pb * tstep : cB;
        for (int t = 0; t < nt; t += 2) {
            const bool last = (t == nt - 2);
            const char* a1 = cA + (size_t)(t + 1) * kstep;
            const char* a2 = last ? nA : cA + (size_t)(t + 2) * kstep; const char* b2 = last ? nB : cB + (size_t)(t + 2) * kstep;
            const char* a3 = a2 + kstep; const char* b3 = b2 + kstep;
            PG8_LDB(B0, 0, 0); PG8_LDB(B1, 0, 1); PG8_SCHED; PG8_LDA(At, 0, 0); PG8_STAGE(PG8_SA(1, 1), a1, vc[1]);
            { if (last) { const u32x4 pv = *(const LAS u32x4*)park; vc[0][0] = pv.x; vc[0][1] = pv.y; vc[1][0] = pv.z; vc[1][1] = pv.w; } }
            PG8_WAIT_V(8); PG8_WAIT_L(0); PG8_BAR; PG8_SCHED; PG8_MMA(0, 0, At, B0); PG8_MMA(0, 1, At, B1); PG8_SCHED; PG8_BAR; PG8_SCHED;
            PG8_LDA(At, 0, 1); PG8_STAGE(PG8_SB(0, 0), b2, voffB); PG8_STAGE(PG8_SB(0, 1), b2 + hstep, voffB); PG8_STAGE(PG8_SA(0, 0), a2, vc[0]);
            PG8_WAIT_V(8); PG8_WAIT_L(0); PG8_BAR; PG8_SCHED; PG8_MMA(1, 0, At, B0); PG8_MMA(1, 1, At, B1); PG8_SCHED; PG8_BAR; PG8_SCHED;
            PG8_LDB(B0, 1, 0); PG8_LDB(B1, 1, 1); PG8_SCHED; PG8_LDA(At, 1, 0); PG8_STAGE(PG8_SA(0, 1), a2, vc[1]);
            PG8_WAIT_V(8); PG8_WAIT_L(0); PG8_BAR; PG8_SCHED; PG8_MMA(0, 0, At, B0); PG8_MMA(0, 1, At, B1); PG8_SCHED; PG8_BAR; PG8_SCHED;
            PG8_LDA(At, 1, 1); PG8_STAGE(PG8_SB(1, 0), b3, voffB); PG8_STAGE(PG8_SB(1, 1), b3 + hstep, voffB); PG8_STAGE(PG8_SA(1, 0), a3, vc[0]);
            PG8_WAIT_V(8); PG8_WAIT_L(0); PG8_BAR; PG8_SCHED; PG8_MMA(1, 0, At, B0); PG8_MMA(1, 1, At, B1); PG8_SCHED; PG8_BAR; PG8_SCHED;
        }
        if (wr == 0) PG8_BAR;
        E(acc, cur, wr, wc, fr, fq);
        if (!has_next) break;
#pragma unroll
        for (int a = 0; a < 2; ++a)
#pragma unroll
            for (int b = 0; b < 2; ++b)
#pragma unroll
                for (int m = 0; m < 4; ++m)
#pragma unroll
                    for (int n = 0; n < 2; ++n) acc[a][b][m][n] = (f32x4){0.f, 0.f, 0.f, 0.f};
        cur = nxt; cA = nA; cB = nB; ++ui;
        if (wr == 1) PG8_BAR;
    }
    PG8_WAIT_V(0);
    PG8_BAR;
#undef PG8_SA
#undef PG8_SB
#undef PG8_STAGE
#undef PG8_LDA
#undef PG8_LDB
#undef PG8_MMA
#undef PG8_CAT
#undef PG8_WAIT_V
#undef PG8_WAIT_L
#undef PG8_BAR
#undef PG8_SCHED
}

__device__ __forceinline__ int opq(int x) { asm volatile("" : "+v"(x)); return x; }
template <bool BASEF32> struct EpiResid {
    const void* bl; const void* bc; bf16_t* ol; bf16_t* oc; const float* gate; float sc;
    __device__ __forceinline__ void operator()(f32x4 (&acc)[2][2][4][2], const Unit& u, int wr, int wc, int fr_, int fq_) const {
        const int ln_ = lane_now0(); const int fr = ln_ & 15, fq = ln_ >> 4; (void)fr_; (void)fq_;
        const bool lat = u.pm < 128; const int rb = (lat ? u.pm : u.pm - 128) * 256 + wr * 64 + fr;
        const void* b = lat ? bl : bc; bf16_t* o = lat ? ol : oc; const int ci = lat ? (u.pm >> 3) : 16;
        const int col0 = u.pn * 256 + wc * 32 + 4 * fq; const float* gp = gate + (size_t)ci * MODW + col0;
        f32x4 gv[2][2];
#pragma unroll
        for (int bj = 0; bj < 2; ++bj)
#pragma unroll
            for (int n = 0; n < 2; ++n) gv[bj][n] = *(const f32x4*)(gp + bj * 128 + n * 16) * sc;
#pragma unroll
        for (int ai = 0; ai < 2; ++ai) {
            f32x4 bs[4][2][2];
#pragma unroll
            for (int m = 0; m < 4; ++m) { const size_t off = (size_t)(rb + ai * 128 + m * 16) * DM + col0;
#pragma unroll
                for (int bj = 0; bj < 2; ++bj)
#pragma unroll
                    for (int n = 0; n < 2; ++n) {
                        if (BASEF32) bs[m][bj][n] = __builtin_nontemporal_load((const f32x4*)((const float*)b + off + bj * 128 + n * 16));
                        else { const u32x2 w = *(const u32x2*)((const bf16_t*)b + off + bj * 128 + n * 16); bs[m][bj][n] = (f32x4){bf_lo(w.x), bf_hi(w.x), bf_lo(w.y), bf_hi(w.y)}; } } }
#pragma unroll
            for (int m = 0; m < 4; ++m) { const size_t off = (size_t)(rb + ai * 128 + m * 16) * DM + col0;
#pragma unroll
                for (int bj = 0; bj < 2; ++bj)
#pragma unroll
                    for (int n = 0; n < 2; ++n) { const f32x4 v = bs[m][bj][n] + gv[bj][n] * acc[ai][bj][m][n]; u32x2 w; w.x = cvtpk(v[0], v[1]); w.y = cvtpk(v[2], v[3]); st8(o + off + bj * 128 + n * 16, w); } }
            asm volatile("" ::: "memory"); }
    }
};
__device__ __forceinline__ f32x4 i2f(const f32x4& a) { const v4i_t q = __builtin_bit_cast(v4i_t, a); return (f32x4){(float)q[0], (float)q[1], (float)q[2], (float)q[3]}; }
template <bool OUT8, bool INT, bool MOEROWS, bool UPX8> struct EpiSwiGLU {
    unsigned char* act; const float* sa; const float* sw; const int* listTok; const LAS int* moe; int cap;
    static constexpr float usc = UPX8 ? ACT8_SCALE : 1.0f;
    __device__ __forceinline__ void operator()(f32x4 (&acc)[2][2][4][2], const Unit& u, int wr, int wc, int fr_, int fq_) const {
        const int ln_ = lane_now0(); const int fr = ln_ & 15, fq = ln_ >> 4; (void)fr_; (void)fq_;
        const int row0 = u.pm * 256 + wr * 64 + fr, col0 = u.pn * 128 + wc * 32 + 8 * fq;
        f32x4 swg[2], swu[2];
        if (INT) { const float* sp = sw + (size_t)u.pb * 256 + 32 * wc + 4 * fq;
#pragma unroll
            for (int n = 0; n < 2; ++n) { swg[n] = *(const f32x4*)(sp + 16 * n); swu[n] = *(const f32x4*)(sp + 128 + 16 * n) * usc; } }
        float rsv[2][4];
        if (INT) { int arow[2][4];
#pragma unroll
            for (int ai = 0; ai < 2; ++ai)
#pragma unroll
                for (int m = 0; m < 4; ++m) { arow[ai][m] = row0 + ai * 128 + m * 16;
                    if (MOEROWS) { const int pos = u.r0 + ai * 128 + wr * 64 + m * 16 + fr; const int idx = pos < moe[u.e] ? pos : 0; arow[ai][m] = listTok[u.e * cap + idx] >> 1; } }
#pragma unroll
            for (int ai = 0; ai < 2; ++ai)
#pragma unroll
                for (int m = 0; m < 4; ++m) rsv[ai][m] = sa[arow[ai][m]]; }
#pragma unroll
        for (int ai = 0; ai < 2; ++ai)
#pragma unroll
            for (int m = 0; m < 4; ++m) { float v[8]; const float rs = INT ? rsv[ai][m] : 1.0f;
#pragma unroll
                for (int n = 0; n < 2; ++n) { f32x4 g4, u4;
                    if (INT) { g4 = i2f(acc[ai][0][m][n]) * (swg[n] * rs); u4 = i2f(acc[ai][1][m][n]) * (swu[n] * rs); }
                    else { g4 = acc[ai][0][m][n]; u4 = acc[ai][1][m][n] * usc; }
#pragma unroll
                    for (int i = 0; i < 4; ++i) v[4 * n + i] = (g4[i] * __builtin_amdgcn_rcpf(1.0f + __builtin_amdgcn_exp2f(-g4[i]))) * u4[i]; }
                if (OUT8) { u32x2 w; w.x = pk4_fp8(v[0], v[1], v[2], v[3]); w.y = pk4_fp8(v[4], v[5], v[6], v[7]);
                    st8(act + (size_t)(row0 + ai * 128 + m * 16) * DFF + col0, w); }
                else { u32x4 w; w.x = cvtpk(v[0], v[1]); w.y = cvtpk(v[2], v[3]); w.z = cvtpk(v[4], v[5]); w.w = cvtpk(v[6], v[7]);
                    st16(act + ((size_t)(row0 + ai * 128 + m * 16) * DFF + col0) * 2, w); } }
    }
};
struct EpiMoeOut {
    bf16_t* slots; const int* listTok; const float* listW; const LAS int* moe; int cap; float sc;
    __device__ __forceinline__ void operator()(f32x4 (&acc)[2][2][4][2], const Unit& u, int wr, int wc, int fr_, int fq_) const {
        const int ln_ = lane_now0(); const int fr = ln_ & 15, fq = ln_ >> 4; (void)fr_; (void)fq_;
        const int cnt = moe[u.e]; const int col0 = u.pn * 256 + wc * 32 + 4 * fq;
        int ents[2][4]; float ws_[2][4];
#pragma unroll
        for (int ai = 0; ai < 2; ++ai)
#pragma unroll
            for (int m = 0; m < 4; ++m) { const int pos = u.r0 + ai * 128 + wr * 64 + m * 16 + fr; const int idx = pos < cnt ? pos : 0;
                ents[ai][m] = listTok[u.e * cap + idx]; ws_[ai][m] = listW[u.e * cap + idx]; }
#pragma unroll
        for (int ai = 0; ai < 2; ++ai)
#pragma unroll
            for (int m = 0; m < 4; ++m) { const int pos = u.r0 + ai * 128 + wr * 64 + m * 16 + fr;
                if (pos < cnt) { const int ent = ents[ai][m]; const float w = ws_[ai][m] * sc; bf16_t* rp = slots + (size_t)ent * DM + col0;
#pragma unroll
                    for (int bj = 0; bj < 2; ++bj)
#pragma unroll
                        for (int n = 0; n < 2; ++n) { const f32x4 v = acc[ai][bj][m][n] * w; u32x2 o; o.x = cvtpk(v[0], v[1]); o.y = cvtpk(v[2], v[3]); st8(rp + bj * 128 + n * 16, o); } } }
    }
};
template <bool INT> struct EpiQKV64 {
    bf16_t *Q, *K, *V; int nkvt, ldk; const float *qg, *kg; const float *rcos, *rsin; bool dorope; float vsc;
    const float* sa; const float* sw;
    __device__ __forceinline__ void operator()(f32x4 (&acc)[2][2][4][2], const Unit& u, int wr, int wc, int fr_, int fq_) const {
        const int ln_ = lane_now0(); const int fr = ln_ & 15, fq = ln_ >> 4; (void)fr_; (void)fq_;
        if (INT) { const float* sp = sw + (size_t)u.pn * 256 + 32 * wc + 4 * fq;
#pragma unroll
            for (int bj = 0; bj < 2; ++bj)
#pragma unroll
                for (int n = 0; n < 2; ++n) { const f32x4 cs = *(const f32x4*)(sp + 128 * bj + 16 * n);
#pragma unroll
                    for (int ai = 0; ai < 2; ++ai)
#pragma unroll
                        for (int m = 0; m < 4; ++m) acc[ai][bj][m][n] = i2f(acc[ai][bj][m][n]) * cs; } }
        const int type = u.pn < 4 ? 0 : (u.pn < 4 + nkvt ? 1 : 2);
        bf16_t* O; int ld, head;
        if (type == 0) { O = Q; ld = DM; head = 4 * u.pn + wc; } else if (type == 1) { O = K; ld = ldk; head = 4 * (u.pn - 4) + wc; } else { O = V; ld = ldk; head = 4 * (u.pn - 4 - nkvt) + wc; }
        const bool lat = u.pm < 128; const int row0 = u.pm * 256 + wr * 64 + fr;
        bf16_t* ob = O + (size_t)row0 * ld + head * 64 + 8 * fq;
        float sar[2][4];
#pragma unroll
        for (int ai = 0; ai < 2; ++ai)
#pragma unroll
            for (int m = 0; m < 4; ++m) sar[ai][m] = INT ? sa[row0 + ai * 128 + m * 16] : vsc;
        if (type == 2) {
#pragma unroll
            for (int ai = 0; ai < 2; ++ai)
#pragma unroll
                for (int m = 0; m < 4; ++m) { bf16_t* rp = ob + (size_t)(ai * 128 + m * 16) * ld; const float rsv = sar[ai][m];
#pragma unroll
                    for (int bj = 0; bj < 2; ++bj) { const f32x4 v0 = acc[ai][bj][m][0] * rsv, v1 = acc[ai][bj][m][1] * rsv;
                        u32x4 w; w.x = cvtpk(v0[0], v0[1]); w.y = cvtpk(v0[2], v0[3]); w.z = cvtpk(v1[0], v1[1]); w.w = cvtpk(v1[2], v1[3]);
                        st16(rp + 32 * bj, w); } }
            return;
        }
        const float* gp = (type == 0 ? qg : kg) + 8 * fq;
        f32x4 gv[2][2];
#pragma unroll
        for (int bj = 0; bj < 2; ++bj)
#pragma unroll
            for (int n = 0; n < 2; ++n) gv[bj][n] = *(const f32x4*)(gp + 32 * bj + 4 * n) * (type == 0 ? 0.125f * LOG2E : 1.0f);
        const bool rope = dorope && lat; const float epsv = NORM_EPS / (vsc * vsc);
        const int f0 = (fq & 1) * 8;
        f32x4 rc[2], rsn[2];
#define QKV64_ROPE_LOAD(G_) do { const int _ai = (G_) >> 2, _m = (G_) & 3; const int _grow = (4 * u.pm + 2 * _ai + wr) & 31, _gcol = 16 * _m + fr; const int _pos = rope ? (fq < 2 ? _grow : _gcol) : 64; \
        _Pragma("unroll") for (int n = 0; n < 2; ++n) { rc[n] = *(const f32x4*)(rcos + _pos * 16 + f0 + 4 * n); rsn[n] = *(const f32x4*)(rsin + _pos * 16 + f0 + 4 * n); } } while (0)
        if (dorope) QKV64_ROPE_LOAD(0);
#pragma unroll
        for (int gi = 0; gi < 8; ++gi) { const int ai = gi >> 2, m = gi & 3;
            float ss = 0.f;
#pragma unroll
            for (int bj = 0; bj < 2; ++bj)
#pragma unroll
                for (int n = 0; n < 2; ++n) { const f32x4 x = acc[ai][bj][m][n]; ss += (x[0] * x[0] + x[1] * x[1]) + (x[2] * x[2] + x[3] * x[3]); }
            ss += __shfl_xor(ss, 16); ss += __shfl_xor(ss, 32);
            float epsr = epsv; if (INT) { const float rs = sar[ai][m]; epsr = NORM_EPS / (rs * rs); }
            const float rstd = __builtin_amdgcn_rsqf(ss * (1.0f / 64.0f) + epsr);
            f32x4 y[2][2];
            if (dorope) { f32x4 c0[2], s0[2];
#pragma unroll
                for (int n = 0; n < 2; ++n) { c0[n] = rc[n]; s0[n] = rsn[n]; }
                if (gi < 7) QKV64_ROPE_LOAD(gi + 1);
#pragma unroll
                for (int n = 0; n < 2; ++n) { const f32x4 x1 = acc[ai][0][m][n] * rstd * gv[0][n], x2 = acc[ai][1][m][n] * rstd * gv[1][n];
                    y[0][n] = x1 * c0[n] - x2 * s0[n]; y[1][n] = x1 * s0[n] + x2 * c0[n]; } }
            else {
#pragma unroll
                for (int n = 0; n < 2; ++n) { y[0][n] = acc[ai][0][m][n] * rstd * gv[0][n]; y[1][n] = acc[ai][1][m][n] * rstd * gv[1][n]; } }
            bf16_t* rp = ob + (size_t)(ai * 128 + m * 16) * ld;
#pragma unroll
            for (int bj = 0; bj < 2; ++bj) { u32x4 w; w.x = cvtpk(y[bj][0][0], y[bj][0][1]); w.y = cvtpk(y[bj][0][2], y[bj][0][3]); w.z = cvtpk(y[bj][1][0], y[bj][1][1]); w.w = cvtpk(y[bj][1][2], y[bj][1][3]);
                st16(rp + 32 * bj, w); }
        }
#undef QKV64_ROPE_LOAD
    }
};
template <bool INT> struct EpiQKV128 {
    bf16_t *Q, *K, *V; const float *qg, *kg; const float *rcos, *rsin; LAS float* xl; float vsc;
    const float* sa; const float* sw;
    __device__ __forceinline__ void operator()(f32x4 (&acc)[2][2][4][2], const Unit& u, int wr, int wc, int fr_, int fq_) const {
        const int ln_ = lane_now0(); const int fr = ln_ & 15, fq = ln_ >> 4; (void)fr_; (void)fq_;
        if (INT) { const float* sp = sw + (size_t)u.pn * 256 + 32 * wc + 4 * fq;
#pragma unroll
            for (int bj = 0; bj < 2; ++bj)
#pragma unroll
                for (int n = 0; n < 2; ++n) { const f32x4 cs = *(const f32x4*)(sp + 128 * bj + 16 * n);
#pragma unroll
                    for (int ai = 0; ai < 2; ++ai)
#pragma unroll
                        for (int m = 0; m < 4; ++m) acc[ai][bj][m][n] = i2f(acc[ai][bj][m][n]) * cs; } }
        const int type = u.pn < 4 ? 0 : (u.pn < 6 ? 1 : 2);
        bf16_t* O; int ld, head0;
        if (type == 0) { O = Q; ld = DM; head0 = 2 * u.pn; } else if (type == 1) { O = K; ld = 512; head0 = 2 * (u.pn - 4); } else { O = V; ld = 512; head0 = 2 * (u.pn - 6); }
        const bool lat = u.pm < 128; const int row0 = u.pm * 256 + wr * 64 + fr;
        bf16_t* ob = O + (size_t)row0 * ld + head0 * 128 + 16 * wc + 4 * fq;
        float sar[2][4];
#pragma unroll
        for (int ai = 0; ai < 2; ++ai)
#pragma unroll
            for (int m = 0; m < 4; ++m) sar[ai][m] = INT ? sa[row0 + ai * 128 + m * 16] : vsc;
        if (type == 2) {
#pragma unroll
            for (int ai = 0; ai < 2; ++ai)
#pragma unroll
                for (int m = 0; m < 4; ++m) { const float rsv = sar[ai][m];
#pragma unroll
                    for (int bj = 0; bj < 2; ++bj) { bf16_t* rp = ob + (size_t)(ai * 128 + m * 16) * ld + bj * 128;
#pragma unroll
                        for (int n = 0; n < 2; ++n) { const f32x4 v = acc[ai][bj][m][n] * rsv; u32x2 o; o.x = cvtpk(v[0], v[1]); o.y = cvtpk(v[2], v[3]); st8(rp + 64 * n, o); } } }
            return;
        }
        const float* gp = (type == 0 ? qg : kg) + 16 * wc + 4 * fq;
        const float qsc = type == 0 ? 0.08838834764831845f * LOG2E : 1.0f;
        const f32x4 g0 = *(const f32x4*)(gp) * qsc, g1 = *(const f32x4*)(gp + 64) * qsc;
#pragma unroll
        for (int ai = 0; ai < 2; ++ai)
#pragma unroll
            for (int m = 0; m < 4; ++m)
#pragma unroll
                for (int bj = 0; bj < 2; ++bj) { const f32x4 x = acc[ai][bj][m][0], y = acc[ai][bj][m][1];
                    float ss = ((x[0] * x[0] + x[1] * x[1]) + (x[2] * x[2] + x[3] * x[3])) + ((y[0] * y[0] + y[1] * y[1]) + (y[2] * y[2] + y[3] * y[3]));
                    ss += __shfl_xor(ss, 16); ss += __shfl_xor(ss, 32);
                    if (fq == 0) xl[((ai * 128 + wr * 64 + m * 16 + fr) * 2 + bj) * 4 + wc] = ss; }
        asm volatile("s_waitcnt lgkmcnt(0)" ::: "memory"); __builtin_amdgcn_s_barrier(); asm volatile("" ::: "memory");
        const float epsv = NORM_EPS / (vsc * vsc);
        const int f0 = (wc & 1) * 16 + 4 * fq;
        f32x4 rc, rsn;
#define QKV128_ROPE_LOAD(G_) do { const int _ai = (G_) >> 2, _m = (G_) & 3; const int _grow = (4 * u.pm + 2 * _ai + wr) & 31, _gcol = 16 * _m + fr; const int _pos = lat ? (wc < 2 ? _grow : _gcol) : 64; \
        rc = *(const f32x4*)(rcos + _pos * 32 + f0); rsn = *(const f32x4*)(rsin + _pos * 32 + f0); } while (0)
        QKV128_ROPE_LOAD(0);
#pragma unroll
        for (int gi = 0; gi < 8; ++gi) { const int ai = gi >> 2, m = gi & 3;
            const f32x4 cs = rc, sn = rsn;
            if (gi < 7) QKV128_ROPE_LOAD(gi + 1);
            float epsr = epsv; if (INT) { const float rs = sar[ai][m]; epsr = NORM_EPS / (rs * rs); }
#pragma unroll
            for (int bj = 0; bj < 2; ++bj) { const f32x4 p = *(const LAS f32x4*)(xl + ((ai * 128 + wr * 64 + m * 16 + fr) * 2 + bj) * 4);
                const float rstd = __builtin_amdgcn_rsqf(((p[0] + p[1]) + (p[2] + p[3])) * (1.0f / 128.0f) + epsr);
                const f32x4 x1 = acc[ai][bj][m][0] * rstd * g0, x2 = acc[ai][bj][m][1] * rstd * g1;
                const f32x4 y1 = x1 * cs - x2 * sn, y2 = x1 * sn + x2 * cs;
                bf16_t* rp = ob + (size_t)(ai * 128 + m * 16) * ld + bj * 128;
                u32x2 o1, o2; o1.x = cvtpk(y1[0], y1[1]); o1.y = cvtpk(y1[2], y1[3]); o2.x = cvtpk(y2[0], y2[1]); o2.y = cvtpk(y2[2], y2[3]);
                st8(rp, o1); st8(rp + 64, o2); }
        }
#undef QKV128_ROPE_LOAD
    }
};
}

namespace att {
struct AUnit { int qrow0, qcol, kvcol, klat0, nlat, kctx0, a0, a1; };
#ifndef ATT_NSLOT64
#define ATT_NSLOT64 8
#endif
#ifndef ATT_PAIR64
#define ATT_PAIR64 1
#endif
template <int DH> struct Geo { static constexpr int RB = DH * 2, KB = 64 * RB, SLOT = 2 * KB, NSLOT = DH == 64 ? ATT_NSLOT64 : 4, PD = (DH == 64 && ATT_PAIR64) ? NSLOT - 2 : NSLOT - 1, NQ = DH / 16, ND = DH / 32, CPR = RB / 16, RPPC = 1024 / RB, NPW = KB / 8192, NI = 2 * NPW;
                              static constexpr int TAB_OFF = 131072 + 512; };
__device__ __forceinline__ s16x4 trd(const LAS unsigned char* p) { return __builtin_bit_cast(s16x4, __builtin_amdgcn_ds_read_tr16_b64_v4i16((LAS s16x4*)p)); }
__device__ __forceinline__ float max3f(float a, float b, float c) { float r; asm("v_max3_f32 %0, %1, %2, %3" : "=v"(r) : "v"(a), "v"(b), "v"(c)); return r; }
__device__ __forceinline__ float swapmax(float v) { auto rr = __builtin_amdgcn_permlane32_swap(__float_as_uint(v), __float_as_uint(v), false, false); return fmaxf(__uint_as_float(rr[0]), __uint_as_float(rr[1])); }
__device__ __forceinline__ float swapsum(float v) { auto rr = __builtin_amdgcn_permlane32_swap(__float_as_uint(v), __float_as_uint(v), false, false); return __uint_as_float(rr[0]) + __uint_as_float(rr[1]); }

template <int DH, int MODE, bool Y8>
__device__ __forceinline__ void attn_unit(LAS unsigned char* lds, const int tid, const bf16_t* Q, const bf16_t* K, const bf16_t* V, bf16_t* Y, int ldk, const AUnit& u, const float* bias_h, float sink_l2, bool has_sink) {
    typedef Geo<DH> G;
    const int wid = __builtin_amdgcn_readfirstlane(tid >> 6), lane = tid & 63, r32 = lane & 31, hi = lane >> 5;
    constexpr float THR = 8.0f;
    const int NT = u.nlat + 4;
    const unsigned ldsa = (unsigned)(uintptr_t)lds;
    __builtin_amdgcn_s_barrier(); asm volatile("" ::: "memory");
    const int qoff = (MODE == 1) ? (2 * (wid >> 2) + (r32 >> 4)) * 64 + 16 * (wid & 3) + (r32 & 15) : wid * 32 + r32;
    bf16x8 qr[G::NQ];
    { const bf16_t* Qw = Q + (size_t)(u.qrow0 + qoff) * DM + u.qcol + hi * 8;
#pragma unroll
      for (int d0 = 0; d0 < G::NQ; ++d0) qr[d0] = *(const bf16x8*)(Qw + d0 * 16); }
    unsigned voffK[G::NPW], voffV[G::NPW];
#pragma unroll
    for (int i = 0; i < G::NPW; ++i) { const int pc = wid * G::NPW + i, row = pc * G::RPPC + lane / G::CPR, cp = lane % G::CPR;
        const int kf = DH == 64 ? ((row >> 1) & 7) : (row & 15), vf = DH == 64 ? (((row >> 1) & 1) << 2) : ((row & 3) << 2);
        voffK[i] = (unsigned)((row * ldk + u.kvcol) * 2 + ((cp ^ kf) << 4)); voffV[i] = (unsigned)((row * ldk + u.kvcol) * 2 + ((cp ^ vf) << 4)); }
#define ATT_T0(j) (((j) < u.nlat) ? u.klat0 + 64 * (j) : u.kctx0 + 64 * ((j) - u.nlat))
#define ATT_DMA(j) do { const size_t _tb = (size_t)ATT_T0(j) * ldk * 2; const unsigned _sl = ldsa + ((j) & (G::NSLOT - 1)) * G::SLOT + wid * G::NPW * 1024; \
        _Pragma("unroll") for (int i = 0; i < G::NPW; ++i) { pg8::glds_s((const char*)K + _tb, voffK[i], _sl + i * 1024); pg8::glds_s((const char*)V + _tb, voffV[i], _sl + G::KB + i * 1024); } } while (0)
    LAS float* tab = (LAS float*)(lds + G::TAB_OFF);
    if (MODE == 1) {
        for (int i = tid; i < 608; i += 512) { const int t = i - 64; float v = 0.f; if (t >= 0 && t < 480) { const int ri = t >> 5, ci = t & 31; if (ci < 31) v = bias_h[ri * 31 + ci] * LOG2E; } tab[t] = v; } }
#pragma unroll
    for (int t = 0; t < G::PD; ++t) if (t < NT) ATT_DMA(t);
    float m_run = -1e30f, l_run = 0.f;
    f32x16 o[G::ND];
#pragma unroll
    for (int d = 0; d < G::ND; ++d)
#pragma unroll
        for (int r = 0; r < 16; ++r) o[d][r] = 0.f;
    int w_lo = 0, w_hi = 0, l_lo = 0, l_hi = 0, tb_off = 0, m_lo = 0, m_hi = 0;
    float maddL[16];
    int cw = 0, jl_lo = 0, jl_hi = 0;
    if (MODE == 1) { const int R0 = 4 * u.a0 + 2 * (wid >> 2), cg = wid & 3, rq = R0 + (r32 >> 4), c = 16 * cg + (r32 & 15);
        int ra = R0 - 4; ra = ra < 0 ? 0 : (ra > 24 ? 24 : ra); int rb = R0 - 3; rb = rb < 0 ? 0 : (rb > 24 ? 24 : rb);
        w_lo = ra - u.a1; w_hi = rb - u.a1 + 8;
        const int r0l = (r32 >> 4) ? rb : ra; jl_lo = r0l - u.a1; jl_hi = jl_lo + 8;
        int c0 = c - 8; c0 = c0 < 0 ? 0 : (c0 > 48 ? 48 : c0);
        cw = 16 * cg - 8; cw = cw < 0 ? 0 : (cw > 32 ? 32 : cw);
        tb_off = (u.a1 - rq + 7) * 32 + cw + 4 * hi - c + 15;
#pragma unroll
        for (int r = 0; r < 16; ++r) { const int kc = cw + (r & 3) + 8 * (r >> 2) + 4 * hi; maddL[r] = (kc >= c0 && kc < c0 + 16) ? 0.f : -INFINITY; } }
    if (MODE == 2) { const int qw = u.a0 + 32 * wid;
        const int lo_pos = qw - 128 - u.a1 - 63, hi_pos = qw + 159 - u.a1;
        w_lo = lo_pos <= 0 ? 0 : (lo_pos + 63) >> 6; w_hi = hi_pos < 0 ? 0 : (hi_pos >> 6) + 1;
        const int f_lo = qw - 97 - u.a1, f_hi = qw + 65 - u.a1;
        m_lo = f_lo <= 0 ? 0 : (f_lo + 63) >> 6; m_hi = f_hi < 0 ? 0 : (f_hi >> 6) + 1;
        const int base = u.a1 - (qw + r32) + 4 * hi; l_lo = -128 - base; l_hi = 128 - base; }
    const int i16 = lane & 15, tq = i16 >> 2, tp4 = i16 & 3, blk = (lane >> 4) & 1;
    const int kfr = DH == 64 ? ((r32 >> 1) & 7) : (r32 & 15), xv = DH == 64 ? (tq >> 1) : tq;
    int koff[G::NQ], vo[G::ND];
#pragma unroll
    for (int d0 = 0; d0 < G::NQ; ++d0) koff[d0] = r32 * G::RB + (((2 * d0 + hi) ^ kfr) << 4);
#pragma unroll
    for (int d0 = 0; d0 < G::ND; ++d0) vo[d0] = G::KB + (4 * hi + tq) * G::RB + 64 * (d0 ^ xv) + 32 * blk + 8 * tp4;
    int koffL[G::NQ], voL[G::ND];
#pragma unroll
    for (int d0 = 0; d0 < G::NQ; ++d0) { const int row = cw + r32; koffL[d0] = row * G::RB + (((2 * d0 + hi) ^ ((row >> 1) & 7)) << 4); }
#pragma unroll
    for (int d0 = 0; d0 < G::ND; ++d0) voL[d0] = vo[d0] + cw * G::RB;
#define ATT_ACTIVE(j) ((MODE == 0) || (j) >= u.nlat || ((j) >= w_lo && (j) < w_hi))
#define ATT_MSUB() (m_run < -1e29f ? 0.f : m_run)
#define ATT_QKL(P0, MS, sl) do { const LAS unsigned char* _Kb = lds + (sl) * G::SLOT; MS = ATT_MSUB(); \
        _Pragma("unroll") for (int r = 0; r < 16; ++r) P0[r] = maddL[r] - MS; \
        bf16x8 _a0 = *(const LAS bf16x8*)(_Kb + koffL[0]); \
        _Pragma("unroll") for (int d0 = 0; d0 < G::NQ; ++d0) { bf16x8 _n0 = _a0; if (d0 + 1 < G::NQ) _n0 = *(const LAS bf16x8*)(_Kb + koffL[d0 + 1]); \
            __builtin_amdgcn_sched_barrier(0); P0 = __builtin_amdgcn_mfma_f32_32x32x16_bf16(_a0, qr[d0], P0, 0, 0, 0); __builtin_amdgcn_sched_barrier(0); _a0 = _n0; } } while (0)
#define ATT_SMPVL(P0, MS, j, sl) do { const LAS float* tp = tab + tb_off + 32 * (j); \
        _Pragma("unroll") for (int r = 0; r < 16; ++r) P0[r] += tp[(r & 3) + 8 * (r >> 2)]; \
        if ((j) == w_lo || (j) == w_hi - 1) { const bool rowok = (j) >= jl_lo && (j) < jl_hi;          \
            _Pragma("unroll") for (int r = 0; r < 16; ++r) P0[r] = rowok ? P0[r] : -INFINITY; } \
        float pm = P0[0]; \
        _Pragma("unroll") for (int r = 1; r < 15; r += 2) pm = max3f(pm, P0[r], P0[r + 1]); \
        pm = fmaxf(pm, P0[15]); pm = swapmax(pm); \
        if (__any(pm > (m_run - MS) + THR)) { const float mn = fmaxf(m_run, pm + MS); const float alpha = __builtin_amdgcn_exp2f(m_run - mn); m_run = mn; l_run *= alpha; \
            _Pragma("unroll") for (int d = 0; d < G::ND; ++d) _Pragma("unroll") for (int r = 0; r < 16; ++r) o[d][r] *= alpha; } \
        { const float dl = m_run - MS; if (__any(dl != 0.f)) { _Pragma("unroll") for (int r = 0; r < 16; ++r) P0[r] -= dl; } }        \
        float ps = 0.f; \
        _Pragma("unroll") for (int r = 0; r < 16; ++r) { P0[r] = __builtin_amdgcn_exp2f(P0[r]); ps += P0[r]; } \
        l_run += swapsum(ps); \
        bf16x8 pbl[2]; \
        _Pragma("unroll") for (int s = 0; s < 2; ++s) { u32x4 w0; \
            w0.x = cvtpk(P0[8 * s + 0], P0[8 * s + 1]); w0.y = cvtpk(P0[8 * s + 2], P0[8 * s + 3]); w0.z = cvtpk(P0[8 * s + 4], P0[8 * s + 5]); w0.w = cvtpk(P0[8 * s + 6], P0[8 * s + 7]); \
            pbl[s] = __builtin_bit_cast(bf16x8, w0); } \
        const LAS unsigned char* _Vb = lds + (sl) * G::SLOT; \
        { s16x4 lo_ = trd(_Vb + voL[0]), hh_ = trd(_Vb + voL[0] + 8 * G::RB); \
        _Pragma("unroll") for (int i_ = 0; i_ < 2 * G::ND; ++i_) { const int s = i_ / G::ND, d0 = i_ % G::ND; s16x4 nl_ = lo_, nh_ = hh_; \
            if (i_ + 1 < 2 * G::ND) { const int s1 = (i_ + 1) / G::ND, d1 = (i_ + 1) % G::ND; nl_ = trd(_Vb + voL[d1] + (16 * s1) * G::RB); nh_ = trd(_Vb + voL[d1] + (16 * s1 + 8) * G::RB); } \
            __builtin_amdgcn_sched_barrier(0); \
            const bf16x8 va = __builtin_shufflevector(lo_, hh_, 0, 1, 2, 3, 4, 5, 6, 7); \
            o[d0] = __builtin_amdgcn_mfma_f32_32x32x16_bf16(va, pbl[s], o[d0], 0, 0, 0); \
            __builtin_amdgcn_sched_barrier(0); \
            lo_ = nl_; hh_ = nh_; } } } while (0)
#define ATT_QK(P0, P1, MS, sl) do { const LAS unsigned char* _Kb = lds + (sl) * G::SLOT; MS = ATT_MSUB(); \
        _Pragma("unroll") for (int r = 0; r < 16; ++r) { P0[r] = -MS; P1[r] = -MS; } \
        __builtin_amdgcn_s_setprio(1); \
        bf16x8 _a0 = *(const LAS bf16x8*)(_Kb + koff[0]), _a1 = *(const LAS bf16x8*)(_Kb + koff[0] + 32 * G::RB); \
        _Pragma("unroll") for (int d0 = 0; d0 < G::NQ; ++d0) { bf16x8 _n0 = _a0, _n1 = _a1;        \
            if (d0 + 1 < G::NQ) { _n0 = *(const LAS bf16x8*)(_Kb + koff[d0 + 1]); _n1 = *(const LAS bf16x8*)(_Kb + koff[d0 + 1] + 32 * G::RB); } \
            __builtin_amdgcn_sched_barrier(0); \
            P0 = __builtin_amdgcn_mfma_f32_32x32x16_bf16(_a0, qr[d0], P0, 0, 0, 0); \
            P1 = __builtin_amdgcn_mfma_f32_32x32x16_bf16(_a1, qr[d0], P1, 0, 0, 0); \
            __builtin_amdgcn_sched_barrier(0); \
            _a0 = _n0; _a1 = _n1; } \
        __builtin_amdgcn_s_setprio(0); } while (0)
#define ATT_SMPV(P0, P1, MS, j, sl) do { \
        const bool _lat = (j) < u.nlat; float pm; \
        if (MODE == 2 && _lat && !((j) >= m_lo && (j) < m_hi)) { const int lo = l_lo - 64 * (j), hh = l_hi - 64 * (j); \
            _Pragma("unroll") for (int r = 0; r < 16; ++r) { const int e0 = (r & 3) + 8 * (r >> 2), e1 = e0 + 32; \
                P0[r] = (e0 >= lo && e0 <= hh) ? P0[r] : -INFINITY; P1[r] = (e1 >= lo && e1 <= hh) ? P1[r] : -INFINITY; } } \
        pm = fmaxf(P0[0], P1[0]); \
        _Pragma("unroll") for (int r = 1; r < 16; ++r) pm = max3f(pm, P0[r], P1[r]); \
        pm = swapmax(pm); \
        if (__any(pm > (m_run - MS) + THR)) { const float mn = fmaxf(m_run, pm + MS); const float alpha = __builtin_amdgcn_exp2f(m_run - mn); m_run = mn; l_run *= alpha; \
            _Pragma("unroll") for (int d = 0; d < G::ND; ++d) _Pragma("unroll") for (int r = 0; r < 16; ++r) o[d][r] *= alpha; } \
        { const float dl = m_run - MS; if (__any(dl != 0.f)) { _Pragma("unroll") for (int r = 0; r < 16; ++r) { P0[r] -= dl; P1[r] -= dl; } } }        \
        float ps = 0.f; \
        _Pragma("unroll") for (int r = 0; r < 16; ++r) { P0[r] = __builtin_amdgcn_exp2f(P0[r]); P1[r] = __builtin_amdgcn_exp2f(P1[r]); ps += P0[r] + P1[r]; } \
        l_run += swapsum(ps); \
        bf16x8 pb[2][2]; \
        _Pragma("unroll") for (int s = 0; s < 2; ++s) { u32x4 w0, w1; \
            w0.x = cvtpk(P0[8 * s + 0], P0[8 * s + 1]); w0.y = cvtpk(P0[8 * s + 2], P0[8 * s + 3]); w0.z = cvtpk(P0[8 * s + 4], P0[8 * s + 5]); w0.w = cvtpk(P0[8 * s + 6], P0[8 * s + 7]); \
            w1.x = cvtpk(P1[8 * s + 0], P1[8 * s + 1]); w1.y = cvtpk(P1[8 * s + 2], P1[8 * s + 3]); w1.z = cvtpk(P1[8 * s + 4], P1[8 * s + 5]); w1.w = cvtpk(P1[8 * s + 6], P1[8 * s + 7]); \
            pb[0][s] = __builtin_bit_cast(bf16x8, w0); pb[1][s] = __builtin_bit_cast(bf16x8, w1); } \
        const LAS unsigned char* _Vb = lds + (sl) * G::SLOT; \
        __builtin_amdgcn_s_setprio(1); \
        { s16x4 lo_ = trd(_Vb + vo[0]), hh_ = trd(_Vb + vo[0] + 8 * G::RB);        \
        _Pragma("unroll") for (int i_ = 0; i_ < 4 * G::ND; ++i_) { const int kt = i_ / (2 * G::ND), s = (i_ / G::ND) & 1, d0 = i_ % G::ND; s16x4 nl_ = lo_, nh_ = hh_; \
            if (i_ + 1 < 4 * G::ND) { const int kt1 = (i_ + 1) / (2 * G::ND), s1 = ((i_ + 1) / G::ND) & 1, d1 = (i_ + 1) % G::ND; \
                nl_ = trd(_Vb + vo[d1] + (32 * kt1 + 16 * s1) * G::RB); nh_ = trd(_Vb + vo[d1] + (32 * kt1 + 16 * s1 + 8) * G::RB); } \
            __builtin_amdgcn_sched_barrier(0); \
            const bf16x8 va = __builtin_shufflevector(lo_, hh_, 0, 1, 2, 3, 4, 5, 6, 7); \
            o[d0] = __builtin_amdgcn_mfma_f32_32x32x16_bf16(va, pb[kt][s], o[d0], 0, 0, 0); \
            __builtin_amdgcn_sched_barrier(0); \
            lo_ = nl_; hh_ = nh_; } } \
        __builtin_amdgcn_s_setprio(0); } while (0)
#define ATT_WAIT(c) do { const int _c = (c); if (_c <= 0) asm volatile("s_waitcnt vmcnt(0)" ::: "memory"); else if (_c == 1) asm volatile("s_waitcnt vmcnt(%0)" :: "n"(G::NI) : "memory"); \
        else if (_c == 2) asm volatile("s_waitcnt vmcnt(%0)" :: "n"(2 * G::NI) : "memory"); else if (_c == 3) asm volatile("s_waitcnt vmcnt(%0)" :: "n"(3 * G::NI) : "memory"); \
        else if (_c == 4) asm volatile("s_waitcnt vmcnt(%0)" :: "n"(4 * G::NI) : "memory"); else asm volatile("s_waitcnt vmcnt(%0)" :: "n"(5 * G::NI) : "memory"); } while (0)
#define ATT_STEP(C0, C1, CM, N0, N1, NM, j) do { \
        { const int _last = ((j) + G::PD - 1 < NT - 1) ? (j) + G::PD - 1 : NT - 1; ATT_WAIT(_last - ((j) + 1)); } \
        __builtin_amdgcn_s_barrier(); asm volatile("" ::: "memory"); \
        if ((j) + G::PD < NT) ATT_DMA((j) + G::PD); \
        if ((j) + 1 < NT && ATT_ACTIVE((j) + 1)) ATT_QK(N0, N1, NM, ((j) + 1) & (G::NSLOT - 1)); \
        if (ATT_ACTIVE(j)) ATT_SMPV(C0, C1, CM, j, (j) & (G::NSLOT - 1)); } while (0)
    if constexpr (DH == 128) {
    f32x16 sA0, sA1, sB0, sB1; float msA = 0.f, msB = 0.f;
    { const int _iss = G::PD < NT ? G::PD : NT; ATT_WAIT(_iss - 2); }
    asm volatile("s_waitcnt lgkmcnt(0)" ::: "memory");
    __builtin_amdgcn_s_barrier(); asm volatile("" ::: "memory");
    if (ATT_ACTIVE(0)) ATT_QK(sA0, sA1, msA, 0);
    for (int j = 0; j < NT; j += 2) {
        ATT_STEP(sA0, sA1, msA, sB0, sB1, msB, j);
        if (j + 1 < NT) ATT_STEP(sB0, sB1, msB, sA0, sA1, msA, j + 1);
    }
    } else {
#define ATT_STEP1(C0, C1, j) do { \
        { const int _last = ((j) + G::PD - 1 < NT - 1) ? (j) + G::PD - 1 : NT - 1; ATT_WAIT(_last - (j)); } \
        __builtin_amdgcn_s_barrier(); asm volatile("" ::: "memory"); \
        if ((j) + G::PD < NT) ATT_DMA((j) + G::PD); \
        if (ATT_ACTIVE(j)) { if (MODE == 1 && (j) < u.nlat) { ATT_QKL(C0, msA, (j) & (G::NSLOT - 1)); ATT_SMPVL(C0, msA, j, (j) & (G::NSLOT - 1)); } \
                             else { ATT_QK(C0, C1, msA, (j) & (G::NSLOT - 1)); ATT_SMPV(C0, C1, msA, j, (j) & (G::NSLOT - 1)); } } } while (0)
    f32x16 sA0, sA1; float msA = 0.f;
    asm volatile("s_waitcnt lgkmcnt(0)" ::: "memory");
    if constexpr (ATT_PAIR64) {
#define ATT_TILE1(C0, C1, j) do { if (ATT_ACTIVE(j)) { if (MODE == 1 && (j) < u.nlat) { ATT_QKL(C0, msA, (j) & (G::NSLOT - 1)); ATT_SMPVL(C0, msA, j, (j) & (G::NSLOT - 1)); } \
                                                     else { ATT_QK(C0, C1, msA, (j) & (G::NSLOT - 1)); ATT_SMPV(C0, C1, msA, j, (j) & (G::NSLOT - 1)); } } } while (0)
        for (int j = 0; j < NT; j += 2) {
            { const int _iss = (j + G::PD - 1 < NT - 1) ? j + G::PD - 1 : NT - 1; const int _need = (j + 1 < NT - 1) ? j + 1 : NT - 1; ATT_WAIT(_iss - _need); }
            __builtin_amdgcn_s_barrier(); asm volatile("" ::: "memory");
            if (j + G::PD < NT) ATT_DMA(j + G::PD);
            if (j + G::PD + 1 < NT) ATT_DMA(j + G::PD + 1);
            ATT_TILE1(sA0, sA1, j);
            if (j + 1 < NT) ATT_TILE1(sA0, sA1, j + 1);
        }
#undef ATT_TILE1
    } else {
    for (int j = 0; j < NT; ++j) ATT_STEP1(sA0, sA1, j);
    }
#undef ATT_STEP1
    }
    if (has_sink) l_run += __builtin_amdgcn_exp2f(sink_l2 - m_run);
    const float inv = 1.0f / l_run;
    if (Y8) { unsigned char* Yb = (unsigned char*)Y + (size_t)(u.qrow0 + qoff) * DM + u.qcol + 4 * hi; const float sc8 = inv * Y8_SCALE;
#pragma unroll
        for (int d0 = 0; d0 < G::ND; ++d0)
#pragma unroll
            for (int g4 = 0; g4 < 4; ++g4) st4(Yb + 32 * d0 + 8 * g4, pk4_fp8(o[d0][4 * g4] * sc8, o[d0][4 * g4 + 1] * sc8, o[d0][4 * g4 + 2] * sc8, o[d0][4 * g4 + 3] * sc8));
    } else {
    bf16_t* Yw = Y + (size_t)(u.qrow0 + qoff) * DM + u.qcol + 4 * hi;
#pragma unroll
    for (int d0 = 0; d0 < G::ND; ++d0)
#pragma unroll
        for (int g4 = 0; g4 < 4; ++g4) { u32x2 w; w.x = cvtpk(o[d0][4 * g4] * inv, o[d0][4 * g4 + 1] * inv); w.y = cvtpk(o[d0][4 * g4 + 2] * inv, o[d0][4 * g4 + 3] * inv);
            st8(Yw + 32 * d0 + 8 * g4, w); } }
#undef ATT_T0
#undef ATT_DMA
#undef ATT_ACTIVE
#undef ATT_QK
#undef ATT_QKL
#undef ATT_MSUB
#undef ATT_SMPVL
#undef ATT_SMPV
#undef ATT_STEP
#undef ATT_WAIT
}
}

constexpr size_t MiB = 1u << 20;
constexpr size_t WS_CTL = 0, CTL_ZERO_BYTES = 1 * MiB;
constexpr size_t WS_MOD = 1 * MiB;
constexpr size_t WS_ROPE = 3 * MiB - 64 * 1024;
constexpr size_t WS_LIST = 3 * MiB;
constexpr size_t WS_SA = 5 * MiB + 256 * 1024;
constexpr size_t WS_SWQKV = WS_SA + 160 * 1024;
constexpr size_t WS_SWD = WS_SWQKV + 40 * 1024;
constexpr size_t WS_SWM = WS_SWD + 56 * 1024;
static_assert(WS_SWM + 8 * 7168 * 4 <= 6 * MiB, "scale arrays");
constexpr size_t WS_XC = 6 * MiB;
constexpr size_t WS_H = 22 * MiB;
constexpr size_t WS_SLOTS = 94 * MiB;
constexpr size_t WS_WQKV = 238 * MiB;
constexpr size_t WS_WO = 257 * MiB;
constexpr size_t WS_WDENSE = 265 * MiB;
constexpr size_t WS_WMOE = 307 * MiB;
constexpr size_t WS_ARENA = 475 * MiB;
constexpr size_t WS_Q = WS_ARENA, WS_K = WS_ARENA + 72 * MiB, WS_V = WS_ARENA + 144 * MiB, WS_ACT = WS_ARENA;
constexpr int MOE_ROWS_MAX = 2 * TT + 2048;
constexpr size_t ACT_MOE_BYTES = (size_t)MOE_ROWS_MAX * DFF * (FP8_MOE_OUT ? 1 : 2), ACT_DENSE_BYTES = (size_t)TT * DFF * (FP8_DENSE_OUT ? 1 : 2);
constexpr size_t ARENA_BYTES = ((ACT_MOE_BYTES > ACT_DENSE_BYTES ? (ACT_MOE_BYTES > 216 * MiB ? ACT_MOE_BYTES : 216 * MiB) : (ACT_DENSE_BYTES > 216 * MiB ? ACT_DENSE_BYTES : 216 * MiB)) + MiB - 1) / MiB * MiB;
constexpr size_t WS_XBL = WS_ARENA + ARENA_BYTES;
constexpr size_t WS_END = WS_XBL + (size_t)TL * DM * 2;
static_assert(WS_END <= 1040 * MiB, "ws map: d_ws is >= sum of the inputs = 1050 MiB");
constexpr size_t WDENSE_SLOT = (size_t)(2 * DFF * DM + DM * DFF) * 2;
constexpr size_t WMOE_IN_BYTES = (size_t)NEXP * 2 * DFF * DM * 2;
constexpr int CW_TMO = 0, CW_BAR = 4096, CW_MOECNT = 8192;

constexpr int RING_BYTES = 131072, XL_OFF = RING_BYTES, MOE_OFF = XL_OFF + 8192, MISC_OFF = MOE_OFF + 256, PARK_OFF = 140288, LDS_BYTES = PARK_OFF + 8192;
static_assert(XL_OFF == pg8::XL_OFF_ && PARK_OFF == pg8::PARK_OFF_ && MISC_OFF + 256 <= PARK_OFF && LDS_BYTES <= 160 * 1024, "LDS map");

#define XB_TMO      128
#define XB_XCNT(j)  (256  + 64 * (j))
#define XB_XSUB(j)  (1280 + 64 * (j))
#define XB_XGEN(j)  (2304 + 64 * (j))
#define XB_TOP      3328
#define XB_TOPGEN   3392
#define XCD_BAR_WORDS 3456
#define XB_SPIN_CAP (1u << 18)
__device__ __forceinline__ unsigned xb_ld(unsigned* p)              { return __hip_atomic_load(p, __ATOMIC_RELAXED, __HIP_MEMORY_SCOPE_AGENT); }
__device__ __forceinline__ unsigned xb_add(unsigned* p, unsigned v) { return __hip_atomic_fetch_add(p, v, __ATOMIC_RELAXED, __HIP_MEMORY_SCOPE_AGENT); }
__device__ __forceinline__ unsigned xb_xcc_id() { return (unsigned)__builtin_amdgcn_s_getreg((3 << 11) | 20) & 0xFu; }
#define XB_SPIN(cond, bar) do { unsigned _sp = 0; while (cond) { __builtin_amdgcn_s_sleep(1); \
    if ((++_sp & 255u) == 0u) { if (xb_ld(&(bar)[XB_TMO])) break; if (_sp > XB_SPIN_CAP) { atomicAdd(&(bar)[XB_TMO], 1u); break; } } } } while (0)
struct XcdBarrier { unsigned* bar; unsigned x; volatile LAS unsigned* st; int wave; };
__device__ __forceinline__ XcdBarrier xcd_barrier_post(unsigned* bar, volatile LAS unsigned* st, int wave) {
    XcdBarrier b; b.bar = bar; b.x = xb_xcc_id(); b.st = st; b.wave = wave;
    if (wave == 0 && lane_now0() == 0) (void)xb_add(&bar[XB_XCNT(b.x)], 1u);
    return b;
}
__device__ __forceinline__ void xcd_barrier_complete(unsigned* bar, unsigned x, unsigned& nloc, unsigned& nx) {
    const unsigned G = gridDim.x * gridDim.y * gridDim.z;
    unsigned sum, cnt, mine, sp = 0u;
    for (;;) {
        sum = 0u; cnt = 0u; mine = 0u;
#pragma unroll
        for (unsigned j = 0; j < 16; ++j) { const unsigned c = xb_ld(&bar[XB_XCNT(j)]); sum += c; cnt += (c > 0u) ? 1u : 0u; mine = (j == x) ? c : mine; }
        if (sum == G) break;
        __builtin_amdgcn_s_sleep(1);
        if ((++sp & 255u) == 0u) { if (xb_ld(&bar[XB_TMO])) break; if (sp > XB_SPIN_CAP) { atomicAdd(&bar[XB_TMO], 1u); break; } }
    }
    nloc = mine > 0u ? mine : 1u; nx = cnt > 0u ? cnt : 1u;
}
__device__ __forceinline__ void xcd_barrier(const XcdBarrier& b) {
    asm volatile("s_waitcnt vmcnt(0)" ::: "memory");
    __syncthreads();
    if (b.wave == 0 && lane_now0() == 0) {
        unsigned* bar = b.bar;
        __builtin_amdgcn_s_waitcnt(0);
        unsigned nloc = b.st[0], nx = b.st[1];
        if (nloc == 0u) { xcd_barrier_complete(bar, b.x, nloc, nx); b.st[0] = nloc; b.st[1] = nx; }
        const unsigned old = xb_add(&bar[XB_XSUB(b.x)], 1u);
        const unsigned gen = old / nloc;
        if (old + 1u == (gen + 1u) * nloc) {
            __builtin_amdgcn_fence(__ATOMIC_RELEASE, "agent");
            asm volatile("s_waitcnt vmcnt(0)" ::: "memory");
            const unsigned og = xb_add(&bar[XB_TOP], 1u);
            const unsigned tg = og / nx;
            if (og + 1u == (tg + 1u) * nx) xb_add(&bar[XB_TOPGEN], 1u);
            else XB_SPIN(xb_ld(&bar[XB_TOPGEN]) == tg, bar);
            __builtin_amdgcn_fence(__ATOMIC_ACQUIRE, "agent");
            xb_add(&bar[XB_XGEN(b.x)], 1u);
            asm volatile("s_waitcnt vmcnt(0)" ::: "memory");
        } else {
            XB_SPIN(xb_ld(&bar[XB_XGEN(b.x)]) == gen, bar);
            __builtin_amdgcn_fence(__ATOMIC_ACQUIRE, "agent");
            asm volatile("s_waitcnt vmcnt(0)" ::: "memory");
        }
    }
    __syncthreads();
}

constexpr int N_IN = 51;
struct Args { const float* in[N_IN]; float* out; unsigned char* ws; int ph_lo, ph_hi; };
struct Frame { LAS unsigned char* lds; int tid, lane, wave, vcu, G, gw, NGW; const Args* a; unsigned char* ws; float* out; bf16_t* xl16; bf16_t* xc16; const float* mod; };

#define LDS_WAIT() asm volatile("s_waitcnt lgkmcnt(0)" ::: "memory")
__device__ __forceinline__ int lane_now() { int l; asm volatile("v_mbcnt_lo_u32_b32 %0, -1, 0\n\tv_mbcnt_hi_u32_b32 %0, -1, %0" : "=v"(l)); return l; }
__device__ __forceinline__ float wave_sum(float v) {
#pragma unroll
    for (int o = 1; o < 64; o <<= 1) v += __shfl_xor(v, o);
    return v;
}
__host__ __device__ constexpr int layer_base(int L) { return L == 0 ? 4 : (L == 1 ? 15 : (L == 2 ? 28 : 38)); }
__host__ __device__ constexpr int layer_mixer(int L) { return L % 3; }
__host__ __device__ constexpr bool layer_moe(int L) { return (L & 1) != 0; }
__host__ __device__ constexpr int layer_nqkv(int L) { return L == 1 ? 1536 : (L == 2 ? 2048 : 3072); }
__host__ __device__ constexpr int layer_wqkv_row(int L) { return L == 0 ? 0 : (L == 1 ? 3072 : (L == 2 ? 4608 : 6656)); }
__host__ __device__ constexpr int layer_wo_idx(int L) { return layer_base(L) + (L == 2 ? 7 : 8); }
__host__ __device__ constexpr int layer_ffn_idx(int L) { return layer_base(L) + (L == 2 ? 8 : 9); }

__device__ __forceinline__ int conv_map(int mt, int rd) {
    if (mt == 0) return rd;
    const int pn = rd >> 8, s = rd & 255, bj = s >> 7, wc = (s >> 5) & 3, n = (s >> 4) & 1, fq = (s >> 2) & 3, i = s & 3;
    if (mt == 1) return (4 * pn + wc) * 64 + 32 * bj + 8 * fq + 4 * n + i;
    if (mt == 2) return (2 * pn + bj) * 128 + 64 * n + 16 * wc + 4 * fq + i;
    return bj * DFF + 128 * pn + 32 * wc + 8 * fq + 4 * n + i;
}
__device__ __forceinline__ void conv_item8(const float* W, int K, int N, unsigned char* WT, int mt, float scale, int item, int lane, LAS float* scr) {
    const int nblk = N / 32, kb = item / nblk, nb = item % nblk, k0 = 64 * kb, rd0 = 32 * nb;
    const float sc2 = mt == 3 ? scale * (((rd0 >> 7) & 1) ? LN2 : LOG2E) : scale;
    const int kq = lane >> 3, gq = lane & 7;
    const float* wp = W + (size_t)(k0 + kq) * N + conv_map(mt, rd0 + 4 * gq);
#pragma unroll
    for (int i = 0; i < 8; ++i) { const f32x4 v = __builtin_nontemporal_load((const f32x4*)(wp + (size_t)(8 * i) * N));        LAS float* d = scr + (8 * i + kq) * 33 + 4 * gq; d[0] = v[0]; d[1] = v[1]; d[2] = v[2]; d[3] = v[3]; }
    LDS_WAIT(); asm volatile("" ::: "memory");
    const int c = lane & 7;
#pragma unroll
    for (int j = 0; j < 4; ++j) { const int n = (lane >> 3) + 8 * j; const LAS float* s = scr + (8 * c) * 33 + n;
        u32x2 o; o.x = pk4_fp8(s[0 * 33] * sc2, s[1 * 33] * sc2, s[2 * 33] * sc2, s[3 * 33] * sc2); o.y = pk4_fp8(s[4 * 33] * sc2, s[5 * 33] * sc2, s[6 * 33] * sc2, s[7 * 33] * sc2);
        __builtin_nontemporal_store(o, (u32x2*)(WT + (size_t)(rd0 + n) * K + k0 + 8 * c)); }
    LDS_WAIT(); asm volatile("" ::: "memory");
}
__device__ __forceinline__ unsigned pk4_i8(float a, float b, float c, float d) {
    const unsigned ya = __float_as_uint(a + 12582912.0f), yb = __float_as_uint(b + 12582912.0f), yc = __float_as_uint(c + 12582912.0f), yd = __float_as_uint(d + 12582912.0f);
    return __builtin_amdgcn_perm(yb, ya, 0x0c0c0400u) | __builtin_amdgcn_perm(yd, yc, 0x04000c0cu); }
__device__ __forceinline__ void conv_cols_i8(const float* W, int K, int N, unsigned char* WT, int mt, float* swout, int nb, int lane, LAS float* scr) {
    const int rd0 = 32 * nb, kq = lane >> 3, gq = lane & 7;
    const float fac = mt == 3 ? (((rd0 >> 7) & 1) ? LN2 : LOG2E) : 1.0f;
    const float* wp = W + (size_t)kq * N + conv_map(mt, rd0 + 4 * gq);
    f32x4 mx = {0.f, 0.f, 0.f, 0.f};
    for (int kb = 0; kb < K / 64; ++kb) {
#pragma unroll
        for (int i = 0; i < 8; ++i) { const f32x4 v = *(const f32x4*)(wp + (size_t)(64 * kb + 8 * i) * N);
            mx[0] = fmaxf(mx[0], fabsf(v[0])); mx[1] = fmaxf(mx[1], fabsf(v[1])); mx[2] = fmaxf(mx[2], fabsf(v[2])); mx[3] = fmaxf(mx[3], fabsf(v[3])); } }
#pragma unroll
    for (int c = 0; c < 4; ++c) { mx[c] = fmaxf(mx[c], __shfl_xor(mx[c], 8)); mx[c] = fmaxf(mx[c], __shfl_xor(mx[c], 16)); mx[c] = fmaxf(mx[c], __shfl_xor(mx[c], 32)); }
    LAS float* invs = scr + 64 * 33;
    if (kq == 0) {
#pragma unroll
        for (int c = 0; c < 4; ++c) { const float m = mx[c]; invs[4 * gq + c] = m > 0.f ? 127.0f / m : 0.f; swout[rd0 + 4 * gq + c] = m > 0.f ? m * fac * (1.0f / 127.0f) : 1.0f; } }
    LDS_WAIT(); asm volatile("" ::: "memory");
    const int c4 = lane & 3, nn = lane >> 2;
    for (int kb = 0; kb < K / 64; ++kb) {
#pragma unroll
        for (int i = 0; i < 8; ++i) { const f32x4 v = *(const f32x4*)(wp + (size_t)(64 * kb + 8 * i) * N); LAS float* d = scr + (8 * i + kq) * 33 + 4 * gq; d[0] = v[0]; d[1] = v[1]; d[2] = v[2]; d[3] = v[3]; }
        LDS_WAIT(); asm volatile("" ::: "memory");
#pragma unroll
        for (int j = 0; j < 2; ++j) { const int n = nn + 16 * j; const float inv = invs[n]; const LAS float* sp = scr + (16 * c4) * 33 + n;
            u32x4 o; o.x = pk4_i8(sp[0 * 33] * inv, sp[1 * 33] * inv, sp[2 * 33] * inv, sp[3 * 33] * inv); o.y = pk4_i8(sp[4 * 33] * inv, sp[5 * 33] * inv, sp[6 * 33] * inv, sp[7 * 33] * inv);
            o.z = pk4_i8(sp[8 * 33] * inv, sp[9 * 33] * inv, sp[10 * 33] * inv, sp[11 * 33] * inv); o.w = pk4_i8(sp[12 * 33] * inv, sp[13 * 33] * inv, sp[14 * 33] * inv, sp[15 * 33] * inv);
            *(u32x4*)(WT + (size_t)(rd0 + n) * K + 64 * kb + 16 * c4) = o; }
        LDS_WAIT(); asm volatile("" ::: "memory");
    }
}
__device__ __forceinline__ void conv_block_i8(Frame& F, const float* W, int N, unsigned char* WT, int mt, float* swout, int nb) {
    constexpr int K = DM;
    const int lane = F.lane, w = F.wave, rd0 = 32 * nb, kq = lane >> 3, gq = lane & 7;
    const float fac = mt == 3 ? (((rd0 >> 7) & 1) ? LN2 : LOG2E) : 1.0f;
    LAS float* T = (LAS float*)F.lds; LAS float* xm = (LAS float*)(F.lds + pg8::XL_OFF_);
    const float* wp = W + (size_t)(128 * w + kq) * N + conv_map(mt, rd0 + 4 * gq);
    f32x4 mx = {0.f, 0.f, 0.f, 0.f};
#pragma unroll
    for (int i = 0; i < 16; ++i) { const f32x4 v = __builtin_nontemporal_load((const f32x4*)(wp + (size_t)(8 * i) * N));        const int k = 128 * w + 8 * i + kq, rot = 8 * ((k >> 4) & 3);
        LAS float* d = T + k * 32;
        d[(4 * gq + 0 + rot) & 31] = v[0]; d[(4 * gq + 1 + rot) & 31] = v[1]; d[(4 * gq + 2 + rot) & 31] = v[2]; d[(4 * gq + 3 + rot) & 31] = v[3];
        mx[0] = fmaxf(mx[0], fabsf(v[0])); mx[1] = fmaxf(mx[1], fabsf(v[1])); mx[2] = fmaxf(mx[2], fabsf(v[2])); mx[3] = fmaxf(mx[3], fabsf(v[3])); }
#pragma unroll
    for (int c = 0; c < 4; ++c) { mx[c] = fmaxf(mx[c], __shfl_xor(mx[c], 8)); mx[c] = fmaxf(mx[c], __shfl_xor(mx[c], 16)); mx[c] = fmaxf(mx[c], __shfl_xor(mx[c], 32)); }
    if (kq == 0) {
#pragma unroll
        for (int c = 0; c < 4; ++c) xm[w * 32 + 4 * gq + c] = mx[c]; }
    __syncthreads();
    const int c8 = lane & 7, n8 = lane >> 3;
#pragma unroll
    for (int j = 0; j < 4; ++j) { const int n = n8 + 8 * j;
        float m = xm[n];
#pragma unroll
        for (int ww = 1; ww < 8; ++ww) m = fmaxf(m, xm[ww * 32 + n]);
        const float inv = m > 0.f ? 127.0f / m : 0.f;
        if (w == 0 && c8 == 0) swout[rd0 + n] = m > 0.f ? m * fac * (1.0f / 127.0f) : 1.0f;
        const int k0 = 128 * w + 16 * c8, rot = 8 * ((k0 >> 4) & 3); const LAS float* sp = T + k0 * 32 + ((n + rot) & 31);
        u32x4 o; o.x = pk4_i8(sp[0 * 32] * inv, sp[1 * 32] * inv, sp[2 * 32] * inv, sp[3 * 32] * inv); o.y = pk4_i8(sp[4 * 32] * inv, sp[5 * 32] * inv, sp[6 * 32] * inv, sp[7 * 32] * inv);
        o.z = pk4_i8(sp[8 * 32] * inv, sp[9 * 32] * inv, sp[10 * 32] * inv, sp[11 * 32] * inv); o.w = pk4_i8(sp[12 * 32] * inv, sp[13 * 32] * inv, sp[14 * 32] * inv, sp[15 * 32] * inv);
        __builtin_nontemporal_store(o, (u32x4*)(WT + (size_t)(rd0 + n) * K + k0)); }
    __syncthreads();
}
__device__ __forceinline__ void conv_item(const float* W, int K, int N, bf16_t* WT, int mt, int item, int lane, LAS float* scr) {
    const int nblk = N / 32, kb = item / nblk, nb = item % nblk, k0 = 64 * kb, rd0 = 32 * nb;
    const float sc2 = mt == 3 ? (((rd0 >> 7) & 1) ? LN2 : LOG2E) : 1.0f;
    const int kq = lane >> 3, gq = lane & 7;
    const float* wp = W + (size_t)(k0 + kq) * N + conv_map(mt, rd0 + 4 * gq);
#pragma unroll
    for (int i = 0; i < 8; ++i) { const f32x4 v = __builtin_nontemporal_load((const f32x4*)(wp + (size_t)(8 * i) * N));        LAS float* d = scr + (8 * i + kq) * 33 + 4 * gq; d[0] = v[0]; d[1] = v[1]; d[2] = v[2]; d[3] = v[3]; }
    LDS_WAIT(); asm volatile("" ::: "memory");
    const int c = lane & 7;
#pragma unroll
    for (int j = 0; j < 4; ++j) { const int n = (lane >> 3) + 8 * j; const LAS float* s = scr + (8 * c) * 33 + n;
        u32x4 o; o.x = cvtpk(s[0 * 33] * sc2, s[1 * 33] * sc2); o.y = cvtpk(s[2 * 33] * sc2, s[3 * 33] * sc2); o.z = cvtpk(s[4 * 33] * sc2, s[5 * 33] * sc2); o.w = cvtpk(s[6 * 33] * sc2, s[7 * 33] * sc2);
        __builtin_nontemporal_store(o, (u32x4*)(WT + (size_t)(rd0 + n) * K + k0 + 8 * c)); }
    LDS_WAIT(); asm volatile("" ::: "memory");
}
template <int L>
__device__ __forceinline__ void conv_layer(Frame& F, int bi, int nb, int b0 = 0, int b1 = 1 << 30, int w0 = 0, int w1 = 1 << 30) {
    constexpr int NQ = layer_nqkv(L), MTQ = (layer_mixer(L) == 2) ? 2 : 1;
    constexpr int QDT = qkv_dt(), IDT = ffn_in_dt(L); constexpr bool OUT8 = ffn_out8(L), MOE = layer_moe(L);
    const float* wq = F.a->in[layer_base(L) + 4]; const float* wo = F.a->in[layer_wo_idx(L)];
    const float* win = F.a->in[layer_ffn_idx(L) + (MOE ? 2 : 0)]; const float* wout = F.a->in[layer_ffn_idx(L) + (MOE ? 3 : 1)];
    unsigned char* dq = F.ws + WS_WQKV + (size_t)layer_wqkv_row(L) * DM * (QDT ? 1 : 2);
    unsigned char* din = MOE ? F.ws + WS_WMOE : F.ws + WS_WDENSE + (L >> 1) * WDENSE_SLOT;
    unsigned char* dout = MOE ? F.ws + WS_WMOE + WMOE_IN_BYTES : din + (size_t)2 * DFF * DM * 2;
    constexpr int NEX = MOE ? NEXP : 1;
    constexpr size_t EB_IN = (size_t)2 * DFF * DM * (IDT ? 1 : 2), EB_OUT = (size_t)DM * DFF * (OUT8 ? 1 : 2);
    float* swin = MOE ? (float*)(F.ws + WS_SWM) : (float*)(F.ws + WS_SWD) + (L >> 1) * 2 * DFF;
    constexpr int B_Q = QDT == 2 ? NQ / 32 : 0, B_I = IDT == 2 ? NEX * (2 * DFF / 32) : 0;
    for (int g = b0 + bi; g < (b1 < B_Q + B_I ? b1 : B_Q + B_I); g += nb) {
        if (g < B_Q) conv_block_i8(F, wq, NQ, dq, MTQ, (float*)(F.ws + WS_SWQKV) + layer_wqkv_row(L), g);
        else { const int r = g - B_Q, e = r / (2 * DFF / 32), rr = r % (2 * DFF / 32); conv_block_i8(F, win + (size_t)e * DM * 2 * DFF, 2 * DFF, din + e * EB_IN, 3, swin + e * 2 * DFF, rr); }
    }
    LAS float* scr = (LAS float*)(F.lds + F.wave * 16384);
    constexpr int I_Q = QDT == 2 ? 0 : 16 * (NQ / 32), I_O = 16 * 32, I_DI = IDT == 2 ? 0 : 16 * (2 * DFF / 32), I_DO = (DFF / 64) * 32;
    constexpr int NIT = I_Q + I_O + NEX * (I_DI + I_DO);
    for (int g = w0 + bi * 8 + F.wave; g < (w1 < NIT ? w1 : NIT); g += nb * 8) {
        int r = g;
        if (r < I_Q) { if (QDT == 1) conv_item8(wq, DM, NQ, dq, MTQ, WQKV8_SCALE, r, F.lane, scr); else conv_item(wq, DM, NQ, (bf16_t*)dq, MTQ, r, F.lane, scr); continue; } r -= I_Q;
        if (r < I_O) { if (FP8_WO) conv_item8(wo, DM, DM, F.ws + WS_WO + (size_t)L * DM * DM, 0, WO8_SCALE, r, F.lane, scr);
                       else conv_item(wo, DM, DM, (bf16_t*)(F.ws + WS_WO) + (size_t)L * DM * DM, 0, r, F.lane, scr); continue; } r -= I_O;
        if (r < NEX * I_DI) { const int e = r / (I_DI > 0 ? I_DI : 1), rr = r % (I_DI > 0 ? I_DI : 1); const float* we = win + (size_t)e * DM * 2 * DFF;
            if (IDT == 1) conv_item8(we, DM, 2 * DFF, din + e * EB_IN, 3, WIN8_SCALE, rr, F.lane, scr); else conv_item(we, DM, 2 * DFF, (bf16_t*)(din + e * EB_IN), 3, rr, F.lane, scr); continue; } r -= NEX * I_DI;
        { const int e = r / I_DO, rr = r % I_DO; const float* we = wout + (size_t)e * DFF * DM;
            if (OUT8) conv_item8(we, DFF, DM, dout + e * EB_OUT, 0, WOUT8_SCALE, rr, F.lane, scr); else conv_item(we, DFF, DM, (bf16_t*)(dout + e * EB_OUT), 0, rr, F.lane, scr); }
    }
}
template <int LN>
__device__ __forceinline__ void tail_convert(Frame& F, int nunits, int b0 = 0, int b1 = 1 << 30, int w0 = 0, int w1 = 1 << 30) {
    const int rem = nunits % F.G; const int c = (int)blockIdx.x;
    if (rem == 0) conv_layer<LN>(F, c, F.G, b0, b1, w0, w1);
    else if (c >= rem) conv_layer<LN>(F, c - rem, F.G - rem, b0, b1, w0, w1);
}
#ifndef CV1_Q
#define CV1_Q 0
#endif
#ifndef CV1_A
#define CV1_A 370
#endif
#ifndef CV1_D
#define CV1_D 0
#endif
#ifndef CV3_M
#define CV3_M 250
#endif
#ifndef CV3_A
#define CV3_A 250
#endif
#ifndef CV3_B
#define CV3_B 370
#endif
#ifndef CV3_C
#define CV3_C 150
#endif
#ifndef CV3_W
#define CV3_W 0
#endif
constexpr int CVQ1 = 1536 / 32, CVQ3 = 3072 / 32, CVW_O = 512, CVW_HALF = 512 + 4 * 1792, CVW_ALL = 512 + 8 * 1792;
constexpr int CV1_0 = CVQ1 + CV1_Q, CV1_1 = CV1_0 + CV1_A, CV1_2 = CV1_1 + CV1_D;
constexpr int CV3_0 = CVQ3 + CV3_M, CV3_1 = CV3_0 + CV3_A, CV3_2 = CV3_1 + CV3_B, CV3_3 = CV3_2 + CV3_C;

__device__ __forceinline__ void phase_prologue(Frame& F) {
    LAS float* scond = (LAS float*)F.lds;
    LAS float* part = (LAS float*)(F.lds + 17 * 1024 * 4);
    for (int i = F.tid; i < NCOND * DM; i += 512) { const int ci = i >> 10, k = i & 1023; const float v = ci < 16 ? F.a->in[1][ci * DM + k] : F.a->in[3][k];
        scond[i] = v / (1.0f + __expf(-v)); }
    __syncthreads();
    for (int item = blockIdx.x; item < 4 * 96; item += F.G) {
        const int l = item / 96, nc = item % 96;
        const float* wm = F.a->in[layer_base(0)]; if (l == 1) wm = F.a->in[layer_base(1)]; if (l == 2) wm = F.a->in[layer_base(2)]; if (l == 3) wm = F.a->in[layer_base(3)];
        const float* bm = F.a->in[layer_base(0) + 1]; if (l == 1) bm = F.a->in[layer_base(1) + 1]; if (l == 2) bm = F.a->in[layer_base(2) + 1]; if (l == 3) bm = F.a->in[layer_base(3) + 1];
        f32x4 acc[NCOND];
#pragma unroll
        for (int ci = 0; ci < NCOND; ++ci) acc[ci] = (f32x4){0.f, 0.f, 0.f, 0.f};
        const int kq = F.lane >> 4, cq = F.lane & 15;
        const float* wp = wm + (size_t)(128 * F.wave + kq) * MODW + 64 * nc + 4 * cq;
        for (int i0 = 0; i0 < 32; i0 += 8) { f32x4 wv[8];
#pragma unroll
            for (int j = 0; j < 8; ++j) wv[j] = __builtin_nontemporal_load((const f32x4*)(wp + (size_t)(4 * (i0 + j)) * MODW));
#pragma unroll
            for (int j = 0; j < 8; ++j) { const LAS float* sc = scond + 128 * F.wave + 4 * (i0 + j) + kq;
#pragma unroll
                for (int ci = 0; ci < NCOND; ++ci) acc[ci] += wv[j] * sc[ci * DM];
                __builtin_amdgcn_sched_barrier(0); } }
#pragma unroll
        for (int ci = 0; ci < NCOND; ++ci)
#pragma unroll
            for (int c = 0; c < 4; ++c) { float v = acc[ci][c]; v += __shfl_xor(v, 16); v += __shfl_xor(v, 32); acc[ci][c] = v; }
        if (kq == 0) {
#pragma unroll
            for (int ci = 0; ci < NCOND; ++ci) *(LAS f32x4*)(part + (F.wave * NCOND + ci) * 64 + 4 * cq) = acc[ci]; }
        __syncthreads();
        for (int i = F.tid; i < NCOND * 64; i += 512) { const int ci = i >> 6, n = i & 63; float s = 0.f;
#pragma unroll
            for (int w = 0; w < 8; ++w) s += part[(w * NCOND + ci) * 64 + n];
            ((float*)(F.ws + WS_MOD))[(size_t)(l * NCOND + ci) * MODW + 64 * nc + n] = s + bm[64 * nc + n]; }
        __syncthreads();
    }
    { float* rt = (float*)(F.ws + WS_ROPE); const int gt = blockIdx.x * 512 + F.tid;
      if (gt < 65 * 16) { const int pos = gt >> 4, f = gt & 15; const float ang = (float)pos * powf(10000.0f, -(float)f / 16.0f); rt[gt] = pos < 64 ? cosf(ang) : 1.0f; rt[1040 + gt] = pos < 64 ? sinf(ang) : 0.0f; }
      else if (gt < 65 * 16 + 65 * 32) { const int g2 = gt - 1040, pos = g2 >> 5, f = g2 & 31; const float ang = (float)pos * powf(10000.0f, -(float)f / 32.0f); rt[2080 + g2] = pos < 64 ? cosf(ang) : 1.0f; rt[4160 + g2] = pos < 64 ? sinf(ang) : 0.0f; } }
    __syncthreads();
    conv_layer<0>(F, F.vcu, F.G);
}

__device__ __forceinline__ void reduce8(float (&lg)[8], int lane) {
    const bool o1 = lane & 1; float a[4];
#pragma unroll
    for (int i = 0; i < 4; ++i) { const float mine = o1 ? lg[4 + i] : lg[i], give = o1 ? lg[i] : lg[4 + i]; a[i] = mine + __shfl_xor(give, 1); }
    const bool o2 = lane & 2; float b2[2];
#pragma unroll
    for (int i = 0; i < 2; ++i) { const float mine = o2 ? a[2 + i] : a[i], give = o2 ? a[i] : a[2 + i]; b2[i] = mine + __shfl_xor(give, 2); }
    const bool o4 = lane & 4; float c1;
    { const float mine = o4 ? b2[1] : b2[0], give = o4 ? b2[0] : b2[1]; c1 = mine + __shfl_xor(give, 4); }
    c1 += __shfl_xor(c1, 8); c1 += __shfl_xor(c1, 16); c1 += __shfl_xor(c1, 32);
#pragma unroll
    for (int e = 0; e < 8; ++e) { const int src = ((e >> 2) & 1) | (((e >> 1) & 1) << 1) | ((e & 1) << 2); lg[e] = __shfl(c1, src); }
}
template <bool COMBINE, bool ROUTE, int OUTF, bool XIN32>
__device__ __forceinline__ void phase_norm(Frame& F, const float* g2prev, const float* gain, const float* modl, int psh, int psc, int nrows,
                                           const float* wrt, const float* brt, int moe_slot) {
    bf16_t* H = (bf16_t*)(F.ws + WS_H); const bf16_t* slots = (const bf16_t*)(F.ws + WS_SLOTS);
    LAS float* wr_l = (LAS float*)F.lds;
    LAS int* lcnt = (LAS int*)(F.lds + 32768);
    LAS int* ent_i = (LAS int*)(F.lds + 32768 + 64);
    LAS float* ent_w = (LAS float*)(F.lds + 32768 + 64 + 8 * 24 * 16);
    if (ROUTE) {
        for (int t = F.tid; t < DM * 8 / 4; t += 512) { const int d = t >> 1, half = t & 1, ln = (d & 255) >> 2, ii = d & 3, jj = d >> 8; ((LAS f32x4*)wr_l)[half * 1024 + (jj * 4 + ii) * 64 + ln] = ((const f32x4*)wrt)[t]; }
        if (F.tid < 16) lcnt[F.tid] = 0;
        __syncthreads();
    }
    const int rpw = nrows / F.NGW;
    const int row_b = F.gw * rpw;
    int ci_cur = -1; f32x4 ma[4], mb[4], mg[4];
#pragma unroll
    for (int j = 0; j < 4; ++j) { ma[j] = (f32x4){0.f, 0.f, 0.f, 0.f}; mb[j] = ma[j]; mg[j] = ma[j]; }
    f32x4 vnxA[2][4], vnxB[2][4]; u32x2 vnhA[2][4], vnhB[2][4]; u32x2 nsA[2][2][4], nsB[2][2][4];
    const float* xl32 = F.a->in[0]; const float* xc32 = F.a->in[2];
#define NORM_LOAD(NX, NH, NS, R0) do { _Pragma("unroll") for (int q = 0; q < 2; ++q) { const int _row = (R0) + q; const bool _lat = _row < TL; const size_t _ro = _lat ? (size_t)_row * DM : (size_t)(_row - TL) * DM; \
        if (XIN32) { const float* _x = (_lat ? xl32 : xc32) + _ro; _Pragma("unroll") for (int j = 0; j < 4; ++j) NX[q][j] = __builtin_nontemporal_load((const f32x4*)(_x + 4 * F.lane + 256 * j)); } \
        else { const bf16_t* _x = (_lat ? F.xl16 : F.xc16) + _ro; _Pragma("unroll") for (int j = 0; j < 4; ++j) NH[q][j] = *(const u32x2*)(_x + 4 * F.lane + 256 * j); } \
        if (COMBINE) { _Pragma("unroll") for (int k = 0; k < 2; ++k) _Pragma("unroll") for (int j = 0; j < 4; ++j) NS[q][k][j] = __builtin_nontemporal_load((const u32x2*)(slots + (size_t)(2 * _row + k) * DM + 4 * F.lane + 256 * j)); } } } while (0)
    auto pair = [&](f32x4 (&NX)[2][4], u32x2 (&NH)[2][4], u32x2 (&NS)[2][2][4], const int it, const int nxt) __attribute__((always_inline)) {
        const int row0 = row_b + it;
        f32x4 v[2][4]; u32x2 sl[2][2][4];
        bool lat[2]; size_t ro[2];
#pragma unroll
        for (int q = 0; q < 2; ++q) { const int row = row0 + q; lat[q] = row < TL; ro[q] = lat[q] ? (size_t)row * DM : (size_t)(row - TL) * DM;
#pragma unroll
            for (int j = 0; j < 4; ++j) { if (XIN32) v[q][j] = NX[q][j]; else v[q][j] = (f32x4){bf_lo(NH[q][j].x), bf_hi(NH[q][j].x), bf_lo(NH[q][j].y), bf_hi(NH[q][j].y)};
                if (COMBINE) { sl[q][0][j] = NS[q][0][j]; sl[q][1][j] = NS[q][1][j]; } } }
        if (nxt < rpw) NORM_LOAD(NX, NH, NS, row_b + nxt);
#pragma unroll
        for (int q = 0; q < 2; ++q) {
            const int row = row0 + q; const int ci = lat[q] ? (row >> 11) : 16;
            if (ci != ci_cur) { ci_cur = ci;
                if (gain != nullptr) { const float* mp = modl + (size_t)ci * MODW;
#pragma unroll
                    for (int j = 0; j < 4; ++j) { const int c0 = 4 * F.lane + 256 * j; const f32x4 gn = *(const f32x4*)(gain + c0), sc = *(const f32x4*)(mp + psc * DM + c0); ma[j] = gn * (1.0f + sc); mb[j] = *(const f32x4*)(mp + psh * DM + c0); } }
                if (COMBINE) {
#pragma unroll
                    for (int j = 0; j < 4; ++j) mg[j] = *(const f32x4*)(g2prev + (size_t)ci * MODW + 4 * F.lane + 256 * j); } }
            if (COMBINE) {
#pragma unroll
                for (int j = 0; j < 4; ++j) { const u32x2 s0 = sl[q][0][j], s1 = sl[q][1][j];
                    f32x4 sv; sv[0] = bf_lo(s0.x) + bf_lo(s1.x); sv[1] = bf_hi(s0.x) + bf_hi(s1.x); sv[2] = bf_lo(s0.y) + bf_lo(s1.y); sv[3] = bf_hi(s0.y) + bf_hi(s1.y);
                    v[q][j] = v[q][j] + mg[j] * sv;
                    if (gain == nullptr) __builtin_nontemporal_store(v[q][j], (f32x4*)(F.out + ro[q] + 4 * F.lane + 256 * j));
                    else { u32x2 o; o.x = cvtpk(v[q][j][0], v[q][j][1]); o.y = cvtpk(v[q][j][2], v[q][j][3]); st8((lat[q] ? F.xl16 : F.xc16) + ro[q] + 4 * F.lane + 256 * j, o); } }
            }
            if (gain == nullptr) continue;
            float ss = 0.f;
#pragma unroll
            for (int j = 0; j < 4; ++j) ss += (v[q][j][0] * v[q][j][0] + v[q][j][1] * v[q][j][1]) + (v[q][j][2] * v[q][j][2] + v[q][j][3] * v[q][j][3]);
            const float rstd = __builtin_amdgcn_rsqf(wave_sum(ss) * (1.0f / DM) + NORM_EPS);
#pragma unroll
            for (int j = 0; j < 4; ++j) v[q][j] = (v[q][j] * rstd) * ma[j] + mb[j];
            if (OUTF == 2) {
                float am = 0.f;
#pragma unroll
                for (int j = 0; j < 4; ++j) am = fmaxf(fmaxf(am, fmaxf(fabsf(v[q][j][0]), fabsf(v[q][j][1]))), fmaxf(fabsf(v[q][j][2]), fabsf(v[q][j][3])));
#pragma unroll
                for (int o = 1; o < 64; o <<= 1) am = fmaxf(am, __shfl_xor(am, o));
                const float inv = am > 0.f ? 127.0f / am : 0.f;
                if (F.lane == 0) ((float*)(F.ws + WS_SA))[row] = am > 0.f ? am * (1.0f / 127.0f) : 1.0f;
#pragma unroll
                for (int j = 0; j < 4; ++j) st4((unsigned char*)H + (size_t)row * DM + 4 * F.lane + 256 * j, pk4_i8(v[q][j][0] * inv, v[q][j][1] * inv, v[q][j][2] * inv, v[q][j][3] * inv));
            } else {
#pragma unroll
            for (int j = 0; j < 4; ++j) { const int c0 = 4 * F.lane + 256 * j;
                if (OUTF == 1) st4((unsigned char*)H + (size_t)row * DM + c0, pk4_fp8(v[q][j][0] * H8_SCALE, v[q][j][1] * H8_SCALE, v[q][j][2] * H8_SCALE, v[q][j][3] * H8_SCALE));
                else { u32x2 o; o.x = cvtpk(v[q][j][0], v[q][j][1]); o.y = cvtpk(v[q][j][2], v[q][j][3]); st8(H + (size_t)row * DM + c0, o); } } }
            if (ROUTE) {
                float lg[8];
#pragma unroll
                for (int e = 0; e < 8; ++e) lg[e] = 0.f;
#pragma unroll
                for (int j = 0; j < 4; ++j) { f32x4 rw[4][2];
#pragma unroll
                    for (int i = 0; i < 4; ++i) { rw[i][0] = ((const LAS f32x4*)wr_l)[(j * 4 + i) * 64 + F.lane]; rw[i][1] = ((const LAS f32x4*)wr_l)[1024 + (j * 4 + i) * 64 + F.lane]; }
                    __builtin_amdgcn_sched_barrier(0);
#pragma unroll
                    for (int i = 0; i < 4; ++i) { const f32x4 w0 = rw[i][0], w1 = rw[i][1]; const float hv = v[q][j][i];
                        lg[0] += hv * w0[0]; lg[1] += hv * w0[1]; lg[2] += hv * w0[2]; lg[3] += hv * w0[3]; lg[4] += hv * w1[0]; lg[5] += hv * w1[1]; lg[6] += hv * w1[2]; lg[7] += hv * w1[3]; }
                    __builtin_amdgcn_sched_barrier(0); }
                reduce8(lg, F.lane);
#pragma unroll
                for (int e = 0; e < 8; ++e) lg[e] += brt[e];
                int e0 = 0; float v0 = lg[0];
#pragma unroll
                for (int e = 1; e < 8; ++e) if (lg[e] > v0) { v0 = lg[e]; e0 = e; }
                int e1 = -1; float v1 = -INFINITY;
#pragma unroll
                for (int e = 0; e < 8; ++e) if (e != e0 && lg[e] > v1) { v1 = lg[e]; e1 = e; }
                if (e1 < 0) { e1 = (e0 + 1) & 7; v1 = v0; }
                const float w0 = 1.0f / (1.0f + __expf(v1 - v0)), w1 = 1.0f - w0;
                if (F.lane == 0) { const int p0 = atomicAdd((int*)&lcnt[e0], 1), p1 = atomicAdd((int*)&lcnt[e1], 1);
                    LAS int* ei = ent_i + (F.wave * 24 + it + q) * 4; ei[0] = e0; ei[1] = e1; ei[2] = p0; ei[3] = p1;
                    LAS float* ew = ent_w + (F.wave * 24 + it + q) * 2; ew[0] = w0; ew[1] = w1; }
            }
        }
    };
    NORM_LOAD(vnxA, vnhA, nsA, row_b);
    if (rpw > 2) NORM_LOAD(vnxB, vnhB, nsB, row_b + 2);
    for (int it = 0; it < rpw; it += 4) {
        pair(vnxA, vnhA, nsA, it, it + 4);
        if (it + 2 < rpw) pair(vnxB, vnhB, nsB, it + 2, it + 6);
    }
#undef NORM_LOAD
    if (ROUTE) {
        __syncthreads();
        unsigned* gcnt = (unsigned*)(F.ws + WS_CTL) + CW_MOECNT + moe_slot * 64;
        if (F.tid < 8) lcnt[8 + F.tid] = (int)__hip_atomic_fetch_add(gcnt + F.tid, (unsigned)lcnt[F.tid], __ATOMIC_RELAXED, __HIP_MEMORY_SCOPE_AGENT);
        __syncthreads();
        int* listTok = (int*)(F.ws + WS_LIST); float* listW = (float*)(F.ws + WS_LIST + (size_t)NEXP * TT * 4);
        for (int i = F.tid; i < 8 * 24 * 2; i += 512) { const int w = i / 48, r = (i % 48) >> 1, k = i & 1; const int row = (F.vcu * 8 + w) * rpw + r;
            if (r < rpw) { const int e = ent_i[(w * 24 + r) * 4 + k], p = ent_i[(w * 24 + r) * 4 + 2 + k] + lcnt[8 + e];
                listTok[e * TT + p] = row * 2 + k; listW[e * TT + p] = ent_w[(w * 24 + r) * 2 + k]; } }
    }
}

template <int MIXER, bool LAST>
__device__ __forceinline__ void phase_attention(Frame& F, const float* mparam) {
    constexpr int DH = MIXER == 2 ? 128 : 64, NQH = MIXER == 2 ? 8 : 16, NKV = MIXER == 0 ? 16 : 4, GQ = NQH / NKV, LDK = NKV * DH;
    const bf16_t* Q = (const bf16_t*)(F.ws + WS_Q); const bf16_t* K = (const bf16_t*)(F.ws + WS_K); const bf16_t* V = (const bf16_t*)(F.ws + WS_V); bf16_t* Y = (bf16_t*)(F.ws + WS_H);
    constexpr int UL = NB * NQH * 8;
    for (int ui = F.vcu; ui < UL; ui += F.G) {
        const int qblk = (ui + ui / F.G) & 7, h = (ui >> 3) % NQH, b = ui / (8 * NQH);
        att::AUnit u; u.qrow0 = b * SEQ + 256 * qblk; u.qcol = h * DH; u.kvcol = (h / GQ) * DH; u.kctx0 = TL + b * CTXL;
        if (MIXER == 0) { int lo = 4 * qblk - 4; lo = lo < 0 ? 0 : lo; int hi = 4 * qblk + 3 - 4; hi = hi < 0 ? 0 : (hi > 24 ? 24 : hi); hi += 8; if (lo > 24) lo = 24;
            u.klat0 = b * SEQ + 64 * lo; u.nlat = hi - lo; u.a0 = qblk; u.a1 = lo;
            att::attn_unit<64, 1, FP8_WO != 0>(F.lds, F.tid, Q, K, V, Y, LDK, u, mparam + h * 465, 0.f, false); }
        else if (MIXER == 1) { int tlo = 4 * qblk - 2; tlo = tlo < 0 ? 0 : tlo; int thi = 4 * qblk + 6; thi = thi > 32 ? 32 : thi;
            u.klat0 = b * SEQ + 64 * tlo; u.nlat = thi - tlo; u.a0 = 256 * qblk; u.a1 = 64 * tlo;
            att::attn_unit<64, 2, FP8_WO != 0>(F.lds, F.tid, Q, K, V, Y, LDK, u, nullptr, mparam[h] * LOG2E, true); }
        else { u.klat0 = b * SEQ; u.nlat = 32; u.a0 = 0; u.a1 = 0;
            att::attn_unit<128, 0, FP8_WO != 0>(F.lds, F.tid, Q, K, V, Y, LDK, u, nullptr, 0.f, false); }
    }
    if (!LAST) {
        constexpr int UC = NB * NQH;
        for (int ui = F.vcu; ui < UC; ui += F.G) {
            const int h = ui % NQH, b = ui / NQH;
            att::AUnit u; u.qrow0 = TL + b * CTXL; u.qcol = h * DH; u.kvcol = (h / GQ) * DH; u.kctx0 = TL + b * CTXL; u.klat0 = 0; u.nlat = 0; u.a0 = 0; u.a1 = 0;
            if (MIXER == 1) att::attn_unit<64, 0, FP8_WO != 0>(F.lds, F.tid, Q, K, V, Y, LDK, u, nullptr, mparam[h] * LOG2E, true);
            else if (MIXER == 0) att::attn_unit<64, 0, FP8_WO != 0>(F.lds, F.tid, Q, K, V, Y, LDK, u, nullptr, 0.f, false);
            else att::attn_unit<128, 0, FP8_WO != 0>(F.lds, F.tid, Q, K, V, Y, LDK, u, nullptr, 0.f, false);
        }
    }
}

__device__ __forceinline__ int moe_table(Frame& F, int moe_slot) {
    LAS int* mt = (LAS int*)(F.lds + MOE_OFF);
    unsigned* gcnt = (unsigned*)(F.ws + WS_CTL) + CW_MOECNT + moe_slot * 64;
    __syncthreads();
    if (F.tid == 0) { int tb = 0;
        for (int e = 0; e < 8; ++e) { const int c = (int)__hip_atomic_load(gcnt + e, __ATOMIC_RELAXED, __HIP_MEMORY_SCOPE_AGENT); mt[e] = c; mt[8 + e] = tb; tb += (c + 255) >> 8; }
        mt[16] = tb; }
    __syncthreads();
    return mt[16];
}

#define IN_(k) (lo <= (k) && (k) < hi)
#define REFRESH_() do { F.lane = lane_now(); F.tid = F.wave * 64 + F.lane; } while (0)
#define SEAM_(k) do { if (IN_(k) && IN_((k) + 1)) xcd_barrier(bar); } while (0)
template <int L>
__device__ __forceinline__ void run_layer(Frame& F, const XcdBarrier& bar, int lo, int hi) {
    constexpr int LB = layer_base(L), MIX = layer_mixer(L); constexpr bool MOE = layer_moe(L), LAST = (L == 3), PREV_MOE = (L > 0) && layer_moe(L - 1);
    constexpr int P = 1 + 7 * L;
    constexpr int NROWS = LAST ? TL : TT;
    constexpr int QDT = qkv_dt(), IDT = ffn_in_dt(L); constexpr bool OUT8 = ffn_out8(L);
    const float* modl = F.mod + (size_t)L * NCOND * MODW;
    bf16_t* H = (bf16_t*)(F.ws + WS_H);
    const float* SA = (const float*)(F.ws + WS_SA);
    if (IN_(P + 0)) { REFRESH_();
        phase_norm<PREV_MOE, false, QDT, L == 0>(F, F.mod + (size_t)(L > 0 ? L - 1 : 0) * NCOND * MODW + 5 * DM, F.a->in[LB + 2], modl, 0, 1, TT, nullptr, nullptr, 0);
    }
    SEAM_(P + 0);
    if (IN_(P + 1)) { REFRESH_();
        pg8::Gemm g{H, F.ws + WS_WQKV + (size_t)layer_wqkv_row(L) * DM * (QDT ? 1 : 2), QDT ? DM : 2 * DM, E8_2M6, E8_2M6, E8_2M2};
        pg8::Order<0> S; S.init(TT / 256, layer_nqkv(L) / 256, F.G, (int)blockIdx.x);
        const float* rt = (const float*)(F.ws + WS_ROPE); const float* swq = (const float*)(F.ws + WS_SWQKV) + layer_wqkv_row(L);
        if (MIX == 2) { pg8::EpiQKV128<QDT == 2> E{(bf16_t*)(F.ws + WS_Q), (bf16_t*)(F.ws + WS_K), (bf16_t*)(F.ws + WS_V), F.a->in[LB + 5], F.a->in[LB + 6], rt + 2080, rt + 4160, (LAS float*)(F.lds + XL_OFF), 1.0f, SA, swq};
            pg8::gemm_phase<QDT>(F.lds, F.tid, g, S, E); }
        else { pg8::EpiQKV64<QDT == 2> E{(bf16_t*)(F.ws + WS_Q), (bf16_t*)(F.ws + WS_K), (bf16_t*)(F.ws + WS_V), MIX == 0 ? 4 : 1, MIX == 0 ? 1024 : 256, F.a->in[LB + 5], F.a->in[LB + 6], rt, rt + 1040, MIX == 1, 1.0f, SA, swq};
            pg8::gemm_phase<QDT>(F.lds, F.tid, g, S, E); }
        if (L == 0) { REFRESH_(); tail_convert<1>(F, (TT / 256) * (layer_nqkv(L) / 256), 0, CV1_0, 0, 0); }
        if (L == 1) { REFRESH_(); tail_convert<1>(F, (TT / 256) * (layer_nqkv(L) / 256), 0, 0, CVW_O, CVW_HALF); }
        if (L == 2) { REFRESH_(); tail_convert<3>(F, (TT / 256) * (layer_nqkv(L) / 256), CV3_0, CV3_1, 0, 0); }
        if (L == 3) { REFRESH_(); tail_convert<3>(F, (TT / 256) * (layer_nqkv(L) / 256), 0, 0, CVW_ALL - CV3_W, CVW_ALL); }
    }
    SEAM_(P + 1);
    if (IN_(P + 2)) { REFRESH_(); phase_attention<MIX, LAST>(F, MIX == 2 ? nullptr : F.a->in[LB + 7]); }
    SEAM_(P + 2);
    if (IN_(P + 3)) { REFRESH_();
        pg8::Gemm g{F.ws + WS_H, F.ws + WS_WO + (size_t)L * DM * DM * (FP8_WO ? 1 : 2), FP8_WO ? DM : 2 * DM, E8_2M6, E8_2M6, E8_2M6};
        pg8::Order<0> S; S.init(NROWS / 256, 4, F.G, (int)blockIdx.x);
        pg8::EpiResid<L == 0> E{L == 0 ? (const void*)F.a->in[0] : (const void*)F.xl16, L == 0 ? (const void*)F.a->in[2] : (const void*)F.xc16, F.xl16, F.xc16, modl + 2 * DM, 1.0f};
        pg8::gemm_phase<FP8_WO ? 1 : 0>(F.lds, F.tid, g, S, E);
        if (L == 0) { REFRESH_(); tail_convert<1>(F, (NROWS / 256) * 4, CV1_0, CV1_1, 0, 0); }
        if (L == 1) { REFRESH_(); tail_convert<1>(F, (NROWS / 256) * 4, 0, 0, CVW_HALF, 1 << 30); }
        if (L == 2) { REFRESH_(); tail_convert<3>(F, (NROWS / 256) * 4, CV3_1, CV3_2, 0, 0); }
    }
    SEAM_(P + 3);
    if (IN_(P + 4)) { REFRESH_();
        if (MOE) phase_norm<false, true, IDT, false>(F, nullptr, F.a->in[LB + 3], modl, 3, 4, NROWS, F.a->in[layer_ffn_idx(L)], F.a->in[layer_ffn_idx(L) + 1], L >> 1);
        else phase_norm<false, false, IDT, false>(F, nullptr, F.a->in[LB + 3], modl, 3, 4, NROWS, nullptr, nullptr, 0);
    }
    SEAM_(P + 4);
    if (IN_(P + 5)) { REFRESH_();
        constexpr bool UPX8 = (IDT != 1 && OUT8);
        if (MOE) { const int ntile = moe_table(F, L >> 1);
            pg8::EpiSwiGLU<OUT8, IDT == 2, true, UPX8> E{F.ws + WS_ACT, SA, (const float*)(F.ws + WS_SWM), (const int*)(F.ws + WS_LIST), (const LAS int*)(F.lds + MOE_OFF), TT};
            pg8::Gemm g{H, F.ws + WS_WMOE, IDT ? DM : 2 * DM, E8_2M6, OUT8 ? E8_2M3 : E8_2M6, E8_2M2};
            pg8::Order<1> S; S.init(ntile, 2 * DFF / 256, F.G, (int)blockIdx.x); S.moe = (const LAS int*)(F.lds + MOE_OFF); S.listTok = (const int*)(F.ws + WS_LIST); S.cap = TT;
            pg8::gemm_phase<IDT>(F.lds, F.tid, g, S, E); }
        else { pg8::EpiSwiGLU<OUT8, IDT == 2, false, UPX8> E{F.ws + WS_ACT, SA, (const float*)(F.ws + WS_SWD) + (L >> 1) * 2 * DFF, nullptr, nullptr, 0};
            pg8::Gemm g{H, F.ws + WS_WDENSE + (L >> 1) * WDENSE_SLOT, IDT ? DM : 2 * DM, E8_2M6, OUT8 ? E8_2M3 : E8_2M6, E8_2M2};
            pg8::Order<0> S; S.init(NROWS / 256, 2 * DFF / 256, F.G, (int)blockIdx.x);
            pg8::gemm_phase<IDT>(F.lds, F.tid, g, S, E);
            if (L == 0) { REFRESH_(); tail_convert<1>(F, (NROWS / 256) * (2 * DFF / 256), CV1_1, CV1_2, 0, 0); }
            if (L == 2) { REFRESH_(); tail_convert<3>(F, (NROWS / 256) * (2 * DFF / 256), CV3_2, CV3_3, 0, 0); } }
    }
    SEAM_(P + 5);
    if (IN_(P + 6)) { REFRESH_();
        if (MOE) { const int ntile = moe_table(F, L >> 1);
            pg8::Gemm g{F.ws + WS_ACT, F.ws + WS_WMOE + WMOE_IN_BYTES, OUT8 ? DFF : 2 * DFF, E8_2M7, E8_2M7, E8_2M3};
            pg8::Order<2> S; S.init(ntile, 4, F.G, (int)blockIdx.x); S.moe = (const LAS int*)(F.lds + MOE_OFF); S.listTok = nullptr; S.cap = TT;
            pg8::EpiMoeOut E{(bf16_t*)(F.ws + WS_SLOTS), (const int*)(F.ws + WS_LIST), (const float*)(F.ws + WS_LIST + (size_t)NEXP * TT * 4), (const LAS int*)(F.lds + MOE_OFF), TT, 1.0f};
            pg8::gemm_phase<OUT8 ? 1 : 0>(F.lds, F.tid, g, S, E);
            if (L == 1) { REFRESH_(); tail_convert<2>(F, ntile * 4); REFRESH_(); tail_convert<3>(F, ntile * 4, 0, CV3_0, 0, 0); } }
        else { pg8::Gemm g{F.ws + WS_ACT, F.ws + WS_WDENSE + (L >> 1) * WDENSE_SLOT + (size_t)2 * DFF * DM * 2, OUT8 ? DFF : 2 * DFF, E8_2M7, E8_2M7, E8_2M3};
            pg8::Order<0> S; S.init(NROWS / 256, 4, F.G, (int)blockIdx.x);
            pg8::EpiResid<false> E{F.xl16, F.xc16, F.xl16, F.xc16, modl + 5 * DM, 1.0f};
            pg8::gemm_phase<OUT8 ? 1 : 0>(F.lds, F.tid, g, S, E);
            if (L == 0) { REFRESH_(); tail_convert<1>(F, (NROWS / 256) * 4, CV1_2, 1 << 30, 0, CVW_O); }
            if (L == 2) { REFRESH_(); tail_convert<3>(F, (NROWS / 256) * 4, CV3_3, 1 << 30, 0, CVW_ALL - CV3_W); } }
    }
    SEAM_(P + 6);
}

constexpr int N_PHASES = 30;
__global__ void __launch_bounds__(512, 2) mk_fwd(Args args) {
    extern __shared__ __attribute__((aligned(16))) unsigned char lds_raw[];
    Frame F;
    F.lds = (LAS unsigned char*)lds_raw;
    F.wave = __builtin_amdgcn_readfirstlane((int)threadIdx.x >> 6); F.lane = lane_now(); F.tid = F.wave * 64 + F.lane;
    F.G = gridDim.x; { const int bx = blockIdx.x; F.vcu = (F.G % 8 == 0) ? (bx % 8) * (F.G / 8) + bx / 8 : bx; }
    F.gw = F.vcu * 8 + F.wave; F.NGW = F.G * 8;
    F.a = &args; F.ws = args.ws; F.out = args.out; F.xl16 = (bf16_t*)(args.ws + WS_XBL); F.xc16 = (bf16_t*)(args.ws + WS_XC); F.mod = (const float*)(args.ws + WS_MOD);
    volatile LAS unsigned* MISC = (volatile LAS unsigned*)(F.lds + MISC_OFF);
    for (int u = F.tid; u < (PARK_OFF - MOE_OFF) / 4; u += 512) ((LAS unsigned*)(F.lds + MOE_OFF))[u] = 0u;
    __syncthreads();
    const int lo = args.ph_lo, hi = args.ph_hi;
    XcdBarrier bar; bar.bar = (unsigned*)(F.ws + WS_CTL) + CW_BAR; bar.x = 0; bar.st = nullptr; bar.wave = F.wave;
    if (hi - lo > 1) bar = xcd_barrier_post((unsigned*)(F.ws + WS_CTL) + CW_BAR, MISC + 8, F.wave);

    if (IN_(0)) { REFRESH_(); phase_prologue(F); }
    SEAM_(0);
    run_layer<0>(F, bar, lo, hi);
    run_layer<1>(F, bar, lo, hi);
    run_layer<2>(F, bar, lo, hi);
    run_layer<3>(F, bar, lo, hi);
    if (IN_(29)) { REFRESH_(); phase_norm<true, false, 0, false>(F, F.mod + (size_t)3 * NCOND * MODW + 5 * DM, nullptr, nullptr, 0, 0, TL, nullptr, nullptr, 0); }
}

extern "C" void kernel_launch(void* const* d_in, const int* in_sizes, int n_in, void* d_out, int out_size, void* d_ws, size_t ws_size, hipStream_t stream) {
    static int grid = 0;
    if (grid == 0) {
        if (n_in != N_IN || out_size != TL * DM || ws_size < WS_END) { fprintf(stderr, "kernel_launch: unexpected shapes: n_in %d out %d ws %zu (need %zu)\n", n_in, out_size, ws_size, (size_t)WS_END); grid = -1; return; }
        int dev = 0, cus = 0, per_cu = 0;
        if (hipGetDevice(&dev) != hipSuccess || hipDeviceGetAttribute(&cus, hipDeviceAttributeMultiprocessorCount, dev) != hipSuccess) { grid = -1; return; }
        if (hipFuncSetAttribute((const void*)mk_fwd, hipFuncAttributeMaxDynamicSharedMemorySize, LDS_BYTES) != hipSuccess) { fprintf(stderr, "kernel_launch: hipFuncSetAttribute failed\n"); grid = -1; return; }
        if (hipOccupancyMaxActiveBlocksPerMultiprocessor(&per_cu, (const void*)mk_fwd, 512, LDS_BYTES) != hipSuccess || per_cu < 1) fprintf(stderr, "kernel_launch: occupancy query says %d\n", per_cu);
        (void)hipGetLastError();
        grid = cus;
        if (grid != 256) fprintf(stderr, "kernel_launch: built for 256 CUs, device has %d\n", cus);
    }
    if (grid < 0) return;
    (void)hipMemsetAsync((char*)d_ws + WS_CTL, 0, CTL_ZERO_BYTES, stream);
    Args a{};
    for (int i = 0; i < N_IN; ++i) a.in[i] = (const float*)d_in[i];
    a.out = (float*)d_out; a.ws = (unsigned char*)d_ws;
#if MK_PER_PHASE
    for (int p = 0; p < N_PHASES; ++p) { a.ph_lo = p; a.ph_hi = p + 1; hipLaunchKernelGGL(mk_fwd, dim3(grid), dim3(512), LDS_BYTES, stream, a); }
#else
    a.ph_lo = 0; a.ph_hi = N_PHASES;
    hipLaunchKernelGGL(mk_fwd, dim3(grid), dim3(512), LDS_BYTES, stream, a);
#endif
}
```

```cpp
#include <hip/hip_runtime.h>
#include <cstdio>
#include <cstdint>

#ifndef MK_PER_PHASE
#define MK_PER_PHASE 0
#endif

#define LAS __attribute__((address_space(3)))
#define GAS __attribute__((address_space(1)))
typedef unsigned short bf16_t;
typedef short bf16x8 __attribute__((ext_vector_type(8)));
typedef short s16x4 __attribute__((ext_vector_type(4)));
typedef float f32x4 __attribute__((ext_vector_type(4)));
typedef float f32x2 __attribute__((ext_vector_type(2)));
typedef float f32x16 __attribute__((ext_vector_type(16)));
typedef unsigned u32x4 __attribute__((ext_vector_type(4)));
typedef unsigned u32x2 __attribute__((ext_vector_type(2)));
typedef __bf16 bf16x2_t __attribute__((ext_vector_type(2)));
typedef GAS unsigned gu32;

__device__ __forceinline__ int lane_now0() { int l; asm volatile("v_mbcnt_lo_u32_b32 %0, -1, 0\n\tv_mbcnt_hi_u32_b32 %0, -1, %0" : "=v"(l)); return l; }
#ifndef WT_STORES
#define WT_STORES 0
#endif
__device__ __forceinline__ void st16(void* p, u32x4 v) { if (WT_STORES) asm volatile("global_store_dwordx4 %0, %1, off sc1\n\ts_nop 1" :: "v"(p), "v"(v) : "memory"); else *(u32x4*)p = v; }
__device__ __forceinline__ void st8(void* p, u32x2 v) { if (WT_STORES) asm volatile("global_store_dwordx2 %0, %1, off sc1" :: "v"(p), "v"(v) : "memory"); else *(u32x2*)p = v; }
__device__ __forceinline__ void st4(void* p, unsigned v) { if (WT_STORES) asm volatile("global_store_dword %0, %1, off sc1" :: "v"(p), "v"(v) : "memory"); else *(unsigned*)p = v; }
__device__ __forceinline__ void st16f(void* p, f32x4 v) { st16(p, __builtin_bit_cast(u32x4, v)); }
__device__ __forceinline__ unsigned cvtpk(float lo, float hi) { f32x2 v = {lo, hi}; bf16x2_t b = __builtin_convertvector(v, bf16x2_t); return __builtin_bit_cast(unsigned, b); }
__device__ __forceinline__ unsigned pk4_fp8(float a, float b, float c, float d) {
    a = __builtin_amdgcn_fmed3f(a, -448.f, 448.f); b = __builtin_amdgcn_fmed3f(b, -448.f, 448.f); c = __builtin_amdgcn_fmed3f(c, -448.f, 448.f); d = __builtin_amdgcn_fmed3f(d, -448.f, 448.f);
    int w = 0; w = __builtin_amdgcn_cvt_pk_fp8_f32(a, b, w, false); w = __builtin_amdgcn_cvt_pk_fp8_f32(c, d, w, true); return (unsigned)w; }
__device__ __forceinline__ float bf_lo(unsigned w) { return __builtin_bit_cast(float, w << 16); }
__device__ __forceinline__ float bf_hi(unsigned w) { return __builtin_bit_cast(float, w & 0xffff0000u); }

constexpr int NB = 16, SEQ = 2048, DM = 1024, CTXL = 256;
constexpr int TL = NB * SEQ, TC = NB * CTXL, TT = TL + TC;
constexpr int DFF = 3584, NEXP = 8, MODW = 6 * DM, NCOND = 17;
constexpr float NORM_EPS = 1e-6f;
constexpr float LOG2E = 1.4426950408889634f, LN2 = 0.6931471805599453f;
#ifndef FP8_MOE_IN
#define FP8_MOE_IN 1
#endif
#ifndef FP8_MOE_OUT
#define FP8_MOE_OUT 1
#endif
#ifndef FP8_QKV
#define FP8_QKV 1
#endif
#ifndef FP8_WO
#define FP8_WO 1
#endif
#ifndef FP8_DENSE_IN
#define FP8_DENSE_IN 0
#endif
#ifndef FP8_DENSE_OUT
#define FP8_DENSE_OUT 1
#endif
#ifndef I8_QKV
#define I8_QKV 1
#endif
#ifndef I8_DENSE_IN
#define I8_DENSE_IN 1
#endif
#ifndef I8_MOE_IN
#define I8_MOE_IN 1
#endif
__host__ __device__ constexpr int qkv_dt() { return I8_QKV ? 2 : (FP8_QKV ? 1 : 0); }
__host__ __device__ constexpr int ffn_in_dt(int L) { return (L & 1) ? (I8_MOE_IN ? 2 : (FP8_MOE_IN ? 1 : 0)) : (I8_DENSE_IN ? 2 : (FP8_DENSE_IN ? 1 : 0)); }
__host__ __device__ constexpr bool ffn_out8(int L) { return (L & 1) ? (FP8_MOE_OUT != 0) : (FP8_DENSE_OUT != 0); }
constexpr float H8_SCALE = 4.0f, WIN8_SCALE = 64.0f, ACT8_SCALE = 8.0f, WOUT8_SCALE = 128.0f;
constexpr float WQKV8_SCALE = 64.0f, Y8_SCALE = 64.0f, WO8_SCALE = 64.0f;
constexpr float QKV_DESCALE = 1.0f / (H8_SCALE * WQKV8_SCALE), WO_DESCALE = 1.0f / (Y8_SCALE * WO8_SCALE);
constexpr int E8_1 = 0x7f7f7f7f, E8_2M2 = 0x7d7d7d7d, E8_2M3 = 0x7c7c7c7c, E8_2M6 = 0x79797979, E8_2M7 = 0x78787878;
constexpr float FFN_IN_DESCALE = 1.0f / (H8_SCALE * WIN8_SCALE), FFN_OUT_DESCALE = 1.0f / (ACT8_SCALE * WOUT8_SCALE);

namespace pg8 {
constexpr int BM = 256, BK = 64, HALF = 128, HTB = HALF * BK * 2, STAGE_BYTES = 8 * HTB, NXCD = 8, WGM = 8;
constexpr int XL_OFF_ = 131072;
constexpr int PARK_OFF_ = 140288;
__host__ __device__ __forceinline__ int lds_byte(int r, int c) { const int st = (r >> 4) * 2 + (c >> 5), rr = r & 15, cc = c & 31, ob = rr * 64 + cc * 2; return st * 1024 + (ob ^ (((ob >> 9) & 1) << 5)); }
__host__ __device__ __forceinline__ void stage_rc(int b, int& R, int& C) { const int st = b / 1024, sb = b % 1024, swz = sb ^ (((sb >> 9) & 1) << 5); R = (st >> 1) * 16 + swz / 64; C = (st & 1) * 32 + (swz % 64) / 2; }

struct Unit { int pm, pn, pb, e, r0; };
struct Gemm { const void* A; const void* Bt; int Kb; int sw0, sw1, sa; };

template <int MODE> struct Order {
    static constexpr bool GATHER = (MODE == 1);
    int nM, nN, nwg, G, c; const LAS int* moe; const int* listTok; int cap;
    __device__ __forceinline__ void init(int nM_, int nN_, int G_, int c_) { nM = nM_; nN = nN_; nwg = nM * nN; G = G_; c = c_; }
    __device__ __forceinline__ bool next(int i, Unit& u) const {
        const long L = (long)i * G + c; if (L >= nwg) return false;
        int wgid = (int)L; { const int q = nwg / NXCD, r = nwg % NXCD, xcd = wgid % NXCD, off = wgid / NXCD; wgid = (xcd < r ? xcd * (q + 1) : r * (q + 1) + (xcd - r) * q) + off; }
        if (MODE == 2) wgid = nwg - 1 - wgid;
        const int nig = WGM * nN, gid = wgid / nig, fm = gid * WGM, gsz = (nM - fm) < WGM ? (nM - fm) : WGM;
        u.pm = fm + ((wgid % nig) % gsz); u.pn = (wgid % nig) / gsz; u.pb = u.pn; u.e = 0; u.r0 = 0;
        if (MODE != 0) { int e = 0;
#pragma unroll
            for (int k = 1; k < 8; ++k) e += (u.pm >= moe[8 + k]) ? 1 : 0;
            e = __builtin_amdgcn_readfirstlane(e);
            u.e = e; u.r0 = __builtin_amdgcn_readfirstlane((u.pm - moe[8 + e]) * 256); u.pb = e * nN + u.pn; }
        return true;
    }
    __device__ __forceinline__ void a_offsets(const Unit& u, int Kb, const int (&R)[2], const int (&C)[2], unsigned (&va)[2][2]) const {
#pragma unroll
        for (int h = 0; h < 2; ++h)
#pragma unroll
            for (int i = 0; i < 2; ++i) {
                int row;
                if (MODE == 1) { const int pos = u.r0 + h * 128 + R[i]; const int idx = pos < moe[u.e] ? pos : 0; row = listTok[u.e * cap + idx] >> 1; }
                else row = u.pm * 256 + h * 128 + R[i];
                va[h][i] = (unsigned)row * (unsigned)Kb + (unsigned)C[i] * 2u;
            }
    }
};

typedef int v8i __attribute__((ext_vector_type(8)));
typedef int v4i_t __attribute__((ext_vector_type(4)));
__device__ __forceinline__ void glds_s(const void* sbase, unsigned voff, unsigned lds_dst) { unsigned keep;
    asm volatile("s_mov_b32 %0, m0\n\ts_mov_b32 m0, %3\n\ts_nop 0\n\tglobal_load_lds_dwordx4 %1, %2\n\ts_mov_b32 m0, %0" : "=&s"(keep) : "v"(voff), "s"(sbase), "s"(lds_dst) : "memory"); }
template <int DT, class Epi, class Sched>
__device__ __forceinline__ void gemm_phase(LAS unsigned char* lds, const int tid, const Gemm g, const Sched& S, const Epi& E) {
    const int wid = __builtin_amdgcn_readfirstlane(tid >> 6), lane = tid & 63, wr = wid >> 2, wc = wid & 3, fr = lane & 15, fq = lane >> 4;
    const int K = g.Kb, nt = K / 128;
    int R[2], C[2]; unsigned voffB[2];
#pragma unroll
    for (int i = 0; i < 2; ++i) { stage_rc(tid * 16 + i * 8192, R[i], C[i]); voffB[i] = (unsigned)(R[i] * K + C[i] * 2); }
    const size_t kstep = 128;
    const size_t hstep = (size_t)HALF * K;
    const size_t tstep = 2 * hstep;
    const unsigned ldsb = (unsigned)(uintptr_t)lds + (unsigned)wid * 1024u;
    const int aoff = lds_byte(wr * 64 + fr, fq * 8), boff = lds_byte(wc * 32 + fr, fq * 8);
#define PG8_SA(b, h) (((b) * 2 + (h)) * HTB)
#define PG8_SB(b, h) ((4 + (b) * 2 + (h)) * HTB)
#ifndef STAGE_BUILTIN_NONFP8
#define STAGE_BUILTIN_NONFP8 1
#endif
#define PG8_STAGE(bufoff, gbase, voff) do { _Pragma("unroll") for (int _i = 0; _i < 2; ++_i) { \
        if constexpr (DT != 1 && STAGE_BUILTIN_NONFP8) __builtin_amdgcn_global_load_lds((const unsigned*)((const char*)(gbase) + (voff)[_i]), (LAS unsigned*)(lds + (bufoff) + wid * 1024 + _i * 8192), 16, 0, 0); \
        else glds_s((const void*)(gbase), (voff)[_i], ldsb + (unsigned)((bufoff) + _i * 8192)); } } while (0)
#define PG8_LDA(dst, b, h) do { _Pragma("unroll") for (int m = 0; m < 4; ++m) _Pragma("unroll") for (int k = 0; k < 2; ++k) dst[m][k] = *(const LAS bf16x8*)(lds + PG8_SA(b, h) + aoff + m * 2048 + k * 1024); } while (0)
#define PG8_LDB(dst, b, h) do { _Pragma("unroll") for (int n = 0; n < 2; ++n) _Pragma("unroll") for (int k = 0; k < 2; ++k) dst[n][k] = *(const LAS bf16x8*)(lds + PG8_SB(b, h) + boff + n * 2048 + k * 1024); } while (0)
#define PG8_CAT(x) __builtin_bit_cast(v8i, __builtin_shufflevector((x)[0], (x)[1], 0, 1, 2, 3, 4, 5, 6, 7, 8, 9, 10, 11, 12, 13, 14, 15))
#define PG8_MMA(ai, bj, At, Bt) do { __builtin_amdgcn_s_setprio(1); _Pragma("unroll") for (int m = 0; m < 4; ++m) _Pragma("unroll") for (int n = 0; n < 2; ++n) { \
        if constexpr (DT == 1) acc[ai][bj][m][n] = __builtin_amdgcn_mfma_scale_f32_16x16x128_f8f6f4(PG8_CAT(Bt[n]), PG8_CAT(At[m]), acc[ai][bj][m][n], 0, 0, 0, (bj) ? g.sw1 : g.sw0, 0, g.sa); \
        else if constexpr (DT == 2) { _Pragma("unroll") for (int k = 0; k < 2; ++k) acc[ai][bj][m][n] = __builtin_bit_cast(f32x4, __builtin_amdgcn_mfma_i32_16x16x64_i8(__builtin_bit_cast(v4i_t, Bt[n][k]), __builtin_bit_cast(v4i_t, At[m][k]), __builtin_bit_cast(v4i_t, acc[ai][bj][m][n]), 0, 0, 0)); } \
        else { _Pragma("unroll") for (int k = 0; k < 2; ++k) acc[ai][bj][m][n] = __builtin_amdgcn_mfma_f32_16x16x32_bf16(Bt[n][k], At[m][k], acc[ai][bj][m][n], 0, 0, 0); } } \
        __builtin_amdgcn_s_setprio(0); } while (0)
#define PG8_WAIT_V(n) asm volatile("s_waitcnt vmcnt(" #n ")" ::: "memory")
#define PG8_WAIT_L(n) asm volatile("s_waitcnt lgkmcnt(" #n ")" ::: "memory")
#define PG8_BAR __builtin_amdgcn_s_barrier()
#define PG8_SCHED __builtin_amdgcn_sched_barrier(0)
    Unit cur, nxt; int ui = 0;
    if (!S.next(0, cur)) return;
    f32x4 acc[2][2][4][2];
#pragma unroll
    for (int a = 0; a < 2; ++a)
#pragma unroll
        for (int b = 0; b < 2; ++b)
#pragma unroll
            for (int m = 0; m < 4; ++m)
#pragma unroll
                for (int n = 0; n < 2; ++n) acc[a][b][m][n] = (f32x4){0.f, 0.f, 0.f, 0.f};
    bf16x8 At[4][2], B0[2][2], B1[2][2];
    constexpr bool GATHER = Sched::GATHER;
    unsigned vc[2][2];
    LAS unsigned* park = (LAS unsigned*)(lds + PARK_OFF_) + tid * 4;
    const char* cA = (const char*)g.A;
    if constexpr (GATHER) S.a_offsets(cur, K, R, C, vc);
    else {
#pragma unroll
        for (int h = 0; h < 2; ++h)
#pragma unroll
            for (int i = 0; i < 2; ++i) vc[h][i] = (unsigned)((h * HALF + R[i]) * K + C[i] * 2);
        cA += (size_t)cur.pm * tstep; }
    const char* cB = (const char*)g.Bt + (size_t)cur.pb * tstep;
    PG8_STAGE(PG8_SB(0, 0), cB, voffB); PG8_STAGE(PG8_SB(0, 1), cB + hstep, voffB); PG8_STAGE(PG8_SA(0, 0), cA, vc[0]); PG8_STAGE(PG8_SA(0, 1), cA, vc[1]);
    if (wr == 1) PG8_BAR;
    PG8_WAIT_V(2); PG8_BAR;
    PG8_STAGE(PG8_SB(1, 0), cB + kstep, voffB); PG8_STAGE(PG8_SA(1, 0), cA + kstep, vc[0]); PG8_STAGE(PG8_SB(1, 1), cB + hstep + kstep, voffB);
    PG8_WAIT_V(6); PG8_BAR;
    for (;;) {
        const bool has_next = S.next(ui + 1, nxt);
        if constexpr (!GATHER) { *(LAS u32x4*)park = (u32x4){vc[0][0], vc[0][1], vc[1][0], vc[1][1]}; }
        if constexpr (GATHER) { unsigned vn[2][2];
            if (has_next) S.a_offsets(nxt, K, R, C, vn);
            else {
#pragma unroll
                for (int h = 0; h < 2; ++h)
#pragma unroll
                    for (int i = 0; i < 2; ++i) vn[h][i] = vc[h][i]; }
            *(LAS u32x4*)park = (u32x4){vn[0][0], vn[0][1], vn[1][0], vn[1][1]}; }
        const char* nA = GATHER ? (const char*)g.A : (has_next ? (const char*)g.A + (size_t)nxt.pm * tstep : cA);
        const char* nB = has_next ? (const char*)g.Bt + (size_t)nxt.pb * tstep : cB;
        for (int t = 0; t < nt; t += 2) {
            const bool last = (t == nt - 2);
            const char* a1 = cA + (size_t)(t + 1) * kstep;
            const char* a2 = last ? nA : cA + (size_t)(t + 2) * kstep; const char* b2 = last ? nB : cB + (size_t)(t + 2) * kstep;
            const char* a3 = a2 + kstep; const char* b3 = b2 + kstep;
            PG8_LDB(B0, 0, 0); PG8_LDB(B1, 0, 1); PG8_SCHED; PG8_LDA(At, 0, 0); PG8_STAGE(PG8_SA(1, 1), a1, vc[1]);
            { if (last) { const u32x4 pv = *(const LAS u32x4*)park; vc[0][0] = pv.x; vc[0][1] = pv.y; vc[1][0] = pv.z; vc[1][1] = pv.w; } }
            PG8_WAIT_V(8); PG8_WAIT_L(0); PG8_BAR; PG8_SCHED; PG8_MMA(0, 0, At, B0); PG8_MMA(0, 1, At, B1); PG8_SCHED; PG8_BAR; PG8_SCHED;
            PG8_LDA(At, 0, 1); PG8_STAGE(PG8_SB(0, 0), b2, voffB); PG8_STAGE(PG8_SB(0, 1), b2 + hstep, voffB); PG8_STAGE(PG8_SA(0, 0), a2, vc[0]);
            PG8_WAIT_V(8); PG8_WAIT_L(0); PG8_BAR; PG8_SCHED; PG8_MMA(1, 0, At, B0); PG8_MMA(1, 1, At, B1); PG8_SCHED; PG8_BAR; PG8_SCHED;
            PG8_LDB(B0, 1, 0); PG8_LDB(B1, 1, 1); PG8_SCHED; PG8_LDA(At, 1, 0); PG8_STAGE(PG8_SA(0, 1), a2, vc[1]);
            PG8_WAIT_V(8); PG8_WAIT_L(0); PG8_BAR; PG8_SCHED; PG8_MMA(0, 0, At, B0); PG8_MMA(0, 1, At, B1); PG8_SCHED; PG8_BAR; PG8_SCHED;
            PG8_LDA(At, 1, 1); PG8_STAGE(PG8_SB(1, 0), b3, voffB); PG8_STAGE(PG8_SB(1, 1), b3 + hstep, voffB); PG8_STAGE(PG8_SA(1, 0), a3, vc[0]);
            PG8_WAIT_V(8); PG8_WAIT_L(0); PG8_BAR; PG8_SCHED; PG8_MMA(1, 0, At, B0); PG8_MMA(1, 1, At, B1); PG8_SCHED; PG8_BAR; PG8_SCHED;
        }
        if (wr == 0) PG8_BAR;
        E(acc, cur, wr, wc, fr, fq);
        if (!has_next) break;
#pragma unroll
        for (int a = 0; a < 2; ++a)
#pragma unroll
            for (int b = 0; b < 2; ++b)
#pragma unroll
                for (int m = 0; m < 4; ++m)
#pragma unroll
                    for (int n = 0; n < 2; ++n) acc[a][b][m][n] = (f32x4){0.f, 0.f, 0.f, 0.f};
        cur = nxt; cA = nA; cB = nB; ++ui;
        if (wr == 1) PG8_BAR;
    }
    PG8_WAIT_V(0);
    PG8_BAR;
#undef PG8_SA
#undef PG8_SB
#undef PG8_STAGE
#undef PG8_LDA
#undef PG8_LDB
#undef PG8_MMA
#undef PG8_CAT
#undef PG8_WAIT_V
#undef PG8_WAIT_L
#undef PG8_BAR
#undef PG8_SCHED
}

__device__ __forceinline__ int opq(int x) { asm volatile("" : "+v"(x)); return x; }
template <bool BASEF32> struct EpiResid {
    const void* bl; const void* bc; bf16_t* ol; bf16_t* oc; const float* gate; float sc;
    __device__ __forceinline__ void operator()(f32x4 (&acc)[2][2][4][2], const Unit& u, int wr, int wc, int fr_, int fq_) const {
        const int ln_ = lane_now0(); const int fr = ln_ & 15, fq = ln_ >> 4; (void)fr_; (void)fq_;
        const bool lat = u.pm < 128; const int rb = (lat ? u.pm : u.pm - 128) * 256 + wr * 64 + fr;
        const void* b = lat ? bl : bc; bf16_t* o = lat ? ol : oc; const int ci = lat ? (u.pm >> 3) : 16;
        const int col0 = u.pn * 256 + wc * 32 + 4 * fq; const float* gp = gate + (size_t)ci * MODW + col0;
        f32x4 gv[2][2];
#pragma unroll
        for (int bj = 0; bj < 2; ++bj)
#pragma unroll
            for (int n = 0; n < 2; ++n) gv[bj][n] = *(const f32x4*)(gp + bj * 128 + n * 16) * sc;
#pragma unroll
        for (int ai = 0; ai < 2; ++ai) {
            f32x4 bs[4][2][2];
#pragma unroll
            for (int m = 0; m < 4; ++m) { const size_t off = (size_t)(rb + ai * 128 + m * 16) * DM + col0;
#pragma unroll
                for (int bj = 0; bj < 2; ++bj)
#pragma unroll
                    for (int n = 0; n < 2; ++n) {
                        if (BASEF32) bs[m][bj][n] = __builtin_nontemporal_load((const f32x4*)((const float*)b + off + bj * 128 + n * 16));
                        else { const u32x2 w = *(const u32x2*)((const bf16_t*)b + off + bj * 128 + n * 16); bs[m][bj][n] = (f32x4){bf_lo(w.x), bf_hi(w.x), bf_lo(w.y), bf_hi(w.y)}; } } }
#pragma unroll
            for (int m = 0; m < 4; ++m) { const size_t off = (size_t)(rb + ai * 128 + m * 16) * DM + col0;
#pragma unroll
                for (int bj = 0; bj < 2; ++bj)
#pragma unroll
                    for (int n = 0; n < 2; ++n) { const f32x4 v = bs[m][bj][n] + gv[bj][n] * acc[ai][bj][m][n]; u32x2 w; w.x = cvtpk(v[0], v[1]); w.y = cvtpk(v[2], v[3]); st8(o + off + bj * 128 + n * 16, w); } }
            asm volatile("" ::: "memory"); }
    }
};
__device__ __forceinline__ f32x4 i2f(const f32x4& a) { const v4i_t q = __builtin_bit_cast(v4i_t, a); return (f32x4){(float)q[0], (float)q[1], (float)q[2], (float)q[3]}; }
template <bool OUT8, bool INT, bool MOEROWS, bool UPX8> struct EpiSwiGLU {
    unsigned char* act; const float* sa; const float* sw; const int* listTok; const LAS int* moe; int cap;
    static constexpr float usc = UPX8 ? ACT8_SCALE : 1.0f;
    __device__ __forceinline__ void operator()(f32x4 (&acc)[2][2][4][2], const Unit& u, int wr, int wc, int fr_, int fq_) const {
        const int ln_ = lane_now0(); const int fr = ln_ & 15, fq = ln_ >> 4; (void)fr_; (void)fq_;
        const int row0 = u.pm * 256 + wr * 64 + fr, col0 = u.pn * 128 + wc * 32 + 8 * fq;
        f32x4 swg[2], swu[2];
        if (INT) { const float* sp = sw + (size_t)u.pb * 256 + 32 * wc + 4 * fq;
#pragma unroll
            for (int n = 0; n < 2; ++n) { swg[n] = *(const f32x4*)(sp + 16 * n); swu[n] = *(const f32x4*)(sp + 128 + 16 * n) * usc; } }
        float rsv[2][4];
        if (INT) { int arow[2][4];
#pragma unroll
            for (int ai = 0; ai < 2; ++ai)
#pragma unroll
                for (int m = 0; m < 4; ++m) { arow[ai][m] = row0 + ai * 128 + m * 16;
                    if (MOEROWS) { const int pos = u.r0 + ai * 128 + wr * 64 + m * 16 + fr; const int idx = pos < moe[u.e] ? pos : 0; arow[ai][m] = listTok[u.e * cap + idx] >> 1; } }
#pragma unroll
            for (int ai = 0; ai < 2; ++ai)
#pragma unroll
                for (int m = 0; m < 4; ++m) rsv[ai][m] = sa[arow[ai][m]]; }
#pragma unroll
        for (int ai = 0; ai < 2; ++ai)
#pragma unroll
            for (int m = 0; m < 4; ++m) { float v[8]; const float rs = INT ? rsv[ai][m] : 1.0f;
#pragma unroll
                for (int n = 0; n < 2; ++n) { f32x4 g4, u4;
                    if (INT) { g4 = i2f(acc[ai][0][m][n]) * (swg[n] * rs); u4 = i2f(acc[ai][1][m][n]) * (swu[n] * rs); }
                    else { g4 = acc[ai][0][m][n]; u4 = acc[ai][1][m][n] * usc; }
#pragma unroll
                    for (int i = 0; i < 4; ++i) v[4 * n + i] = (g4[i] * __builtin_amdgcn_rcpf(1.0f + __builtin_amdgcn_exp2f(-g4[i]))) * u4[i]; }
                if (OUT8) { u32x2 w; w.x = pk4_fp8(v[0], v[1], v[2], v[3]); w.y = pk4_fp8(v[4], v[5], v[6], v[7]);
                    st8(act + (size_t)(row0 + ai * 128 + m * 16) * DFF + col0, w); }
                else { u32x4 w; w.x = cvtpk(v[0], v[1]); w.y = cvtpk(v[2], v[3]); w.z = cvtpk(v[4], v[5]); w.w = cvtpk(v[6], v[7]);
                    st16(act + ((size_t)(row0 + ai * 128 + m * 16) * DFF + col0) * 2, w); } }
    }
};
struct EpiMoeOut {
    bf16_t* slots; const int* listTok; const float* listW; const LAS int* moe; int cap; float sc;
    __device__ __forceinline__ void operator()(f32x4 (&acc)[2][2][4][2], const Unit& u, int wr, int wc, int fr_, int fq_) const {
        const int ln_ = lane_now0(); const int fr = ln_ & 15, fq = ln_ >> 4; (void)fr_; (void)fq_;
        const int cnt = moe[u.e]; const int col0 = u.pn * 256 + wc * 32 + 4 * fq;
        int ents[2][4]; float ws_[2][4];
#pragma unroll
        for (int ai = 0; ai < 2; ++ai)
#pragma unroll
            for (int m = 0; m < 4; ++m) { const int pos = u.r0 + ai * 128 + wr * 64 + m * 16 + fr; const int idx = pos < cnt ? pos : 0;
                ents[ai][m] = listTok[u.e * cap + idx]; ws_[ai][m] = listW[u.e * cap + idx]; }
#pragma unroll
        for (int ai = 0; ai < 2; ++ai)
#pragma unroll
            for (int m = 0; m < 4; ++m) { const int pos = u.r0 + ai * 128 + wr * 64 + m * 16 + fr;
                if (pos < cnt) { const int ent = ents[ai][m]; const float w = ws_[ai][m] * sc; bf16_t* rp = slots + (size_t)ent * DM + col0;
#pragma unroll
                    for (int bj = 0; bj < 2; ++bj)
#pragma unroll
                        for (int n = 0; n < 2; ++n) { const f32x4 v = acc[ai][bj][m][n] * w; u32x2 o; o.x = cvtpk(v[0], v[1]); o.y = cvtpk(v[2], v[3]); st8(rp + bj * 128 + n * 16, o); } } }
    }
};
template <bool INT> struct EpiQKV64 {
    bf16_t *Q, *K, *V; int nkvt, ldk; const float *qg, *kg; const float *rcos, *rsin; bool dorope; float vsc;
    const float* sa; const float* sw;
    __device__ __forceinline__ void operator()(f32x4 (&acc)[2][2][4][2], const Unit& u, int wr, int wc, int fr_, int fq_) const {
        const int ln_ = lane_now0(); const int fr = ln_ & 15, fq = ln_ >> 4; (void)fr_; (void)fq_;
        if (INT) { const float* sp = sw + (size_t)u.pn * 256 + 32 * wc + 4 * fq;
#pragma unroll
            for (int bj = 0; bj < 2; ++bj)
#pragma unroll
                for (int n = 0; n < 2; ++n) { const f32x4 cs = *(const f32x4*)(sp + 128 * bj + 16 * n);
#pragma unroll
                    for (int ai = 0; ai < 2; ++ai)
#pragma unroll
                        for (int m = 0; m < 4; ++m) acc[ai][bj][m][n] = i2f(acc[ai][bj][m][n]) * cs; } }
        const int type = u.pn < 4 ? 0 : (u.pn < 4 + nkvt ? 1 : 2);
        bf16_t* O; int ld, head;
        if (type == 0) { O = Q; ld = DM; head = 4 * u.pn + wc; } else if (type == 1) { O = K; ld = ldk; head = 4 * (u.pn - 4) + wc; } else { O = V; ld = ldk; head = 4 * (u.pn - 4 - nkvt) + wc; }
        const bool lat = u.pm < 128; const int row0 = u.pm * 256 + wr * 64 + fr;
        bf16_t* ob = O + (size_t)row0 * ld + head * 64 + 8 * fq;
        float sar[2][4];
#pragma unroll
        for (int ai = 0; ai < 2; ++ai)
#pragma unroll
            for (int m = 0; m < 4; ++m) sar[ai][m] = INT ? sa[row0 + ai * 128 + m * 16] : vsc;
        if (type == 2) {
#pragma unroll
            for (int ai = 0; ai < 2; ++ai)
#pragma unroll
                for (int m = 0; m < 4; ++m) { bf16_t* rp = ob + (size_t)(ai * 128 + m * 16) * ld; const float rsv = sar[ai][m];
#pragma unroll
                    for (int bj = 0; bj < 2; ++bj) { const f32x4 v0 = acc[ai][bj][m][0] * rsv, v1 = acc[ai][bj][m][1] * rsv;
                        u32x4 w; w.x = cvtpk(v0[0], v0[1]); w.y = cvtpk(v0[2], v0[3]); w.z = cvtpk(v1[0], v1[1]); w.w = cvtpk(v1[2], v1[3]);
                        st16(rp + 32 * bj, w); } }
            return;
        }
        const float* gp = (type == 0 ? qg : kg) + 8 * fq;
        f32x4 gv[2][2];
#pragma unroll
        for (int bj = 0; bj < 2; ++bj)
#pragma unroll
            for (int n = 0; n < 2; ++n) gv[bj][n] = *(const f32x4*)(gp + 32 * bj + 4 * n) * (type == 0 ? 0.125f * LOG2E : 1.0f);
        const bool rope = dorope && lat; const float epsv = NORM_EPS / (vsc * vsc);
        const int f0 = (fq & 1) * 8;
        f32x4 rc[2], rsn[2];
#define QKV64_ROPE_LOAD(G_) do { const int _ai = (G_) >> 2, _m = (G_) & 3; const int _grow = (4 * u.pm + 2 * _ai + wr) & 31, _gcol = 16 * _m + fr; const int _pos = rope ? (fq < 2 ? _grow : _gcol) : 64; \
        _Pragma("unroll") for (int n = 0; n < 2; ++n) { rc[n] = *(const f32x4*)(rcos + _pos * 16 + f0 + 4 * n); rsn[n] = *(const f32x4*)(rsin + _pos * 16 + f0 + 4 * n); } } while (0)
        if (dorope) QKV64_ROPE_LOAD(0);
#pragma unroll
        for (int gi = 0; gi < 8; ++gi) { const int ai = gi >> 2, m = gi & 3;
            float ss = 0.f;
#pragma unroll
            for (int bj = 0; bj < 2; ++bj)
#pragma unroll
                for (int n = 0; n < 2; ++n) { const f32x4 x = acc[ai][bj][m][n]; ss += (x[0] * x[0] + x[1] * x[1]) + (x[2] * x[2] + x[3] * x[3]); }
            ss += __shfl_xor(ss, 16); ss += __shfl_xor(ss, 32);
            float epsr = epsv; if (INT) { const float rs = sar[ai][m]; epsr = NORM_EPS / (rs * rs); }
            const float rstd = __builtin_amdgcn_rsqf(ss * (1.0f / 64.0f) + epsr);
            f32x4 y[2][2];
            if (dorope) { f32x4 c0[2], s0[2];
#pragma unroll
                for (int n = 0; n < 2; ++n) { c0[n] = rc[n]; s0[n] = rsn[n]; }
                if (gi < 7) QKV64_ROPE_LOAD(gi + 1);
#pragma unroll
                for (int n = 0; n < 2; ++n) { const f32x4 x1 = acc[ai][0][m][n] * rstd * gv[0][n], x2 = acc[ai][1][m][n] * rstd * gv[1][n];
                    y[0][n] = x1 * c0[n] - x2 * s0[n]; y[1][n] = x1 * s0[n] + x2 * c0[n]; } }
            else {
#pragma unroll
                for (int n = 0; n < 2; ++n) { y[0][n] = acc[ai][0][m][n] * rstd * gv[0][n]; y[1][n] = acc[ai][1][m][n] * rstd * gv[1][n]; } }
            bf16_t* rp = ob + (size_t)(ai * 128 + m * 16) * ld;
#pragma unroll
            for (int bj = 0; bj < 2; ++bj) { u32x4 w; w.x = cvtpk(y[bj][0][0], y[bj][0][1]); w.y = cvtpk(y[bj][0][2], y[bj][0][3]); w.z = cvtpk(y[bj][1][0], y[bj][1][1]); w.w = cvtpk(y[bj][1][2], y[bj][1][3]);
                st16(rp + 32 * bj, w); }
        }
#undef QKV64_ROPE_LOAD
    }
};
template <bool INT> struct EpiQKV128 {
    bf16_t *Q, *K, *V; const float *qg, *kg; const float *rcos, *rsin; LAS float* xl; float vsc;
    const float* sa; const float* sw;
    __device__ __forceinline__ void operator()(f32x4 (&acc)[2][2][4][2], const Unit& u, int wr, int wc, int fr_, int fq_) const {
        const int ln_ = lane_now0(); const int fr = ln_ & 15, fq = ln_ >> 4; (void)fr_; (void)fq_;
        if (INT) { const float* sp = sw + (size_t)u.pn * 256 + 32 * wc + 4 * fq;
#pragma unroll
            for (int bj = 0; bj < 2; ++bj)
#pragma unroll
                for (int n = 0; n < 2; ++n) { const f32x4 cs = *(const f32x4*)(sp + 128 * bj + 16 * n);
#pragma unroll
                    for (int ai = 0; ai < 2; ++ai)
#pragma unroll
                        for (int m = 0; m < 4; ++m) acc[ai][bj][m][n] = i2f(acc[ai][bj][m][n]) * cs; } }
        const int type = u.pn < 4 ? 0 : (u.pn < 6 ? 1 : 2);
        bf16_t* O; int ld, head0;
        if (type == 0) { O = Q; ld = DM; head0 = 2 * u.pn; } else if (type == 1) { O = K; ld = 512; head0 = 2 * (u.pn - 4); } else { O = V; ld = 512; head0 = 2 * (u.pn - 6); }
        const bool lat = u.pm < 128; const int row0 = u.pm * 256 + wr * 64 + fr;
        bf16_t* ob = O + (size_t)row0 * ld + head0 * 128 + 16 * wc + 4 * fq;
        float sar[2][4];
#pragma unroll
        for (int ai = 0; ai < 2; ++ai)
#pragma unroll
            for (int m = 0; m < 4; ++m) sar[ai][m] = INT ? sa[row0 + ai * 128 + m * 16] : vsc;
        if (type == 2) {
#pragma unroll
            for (int ai = 0; ai < 2; ++ai)
#pragma unroll
                for (int m = 0; m < 4; ++m) { const float rsv = sar[ai][m];
#pragma unroll
                    for (int bj = 0; bj < 2; ++bj) { bf16_t* rp = ob + (size_t)(ai * 128 + m * 16) * ld + bj * 128;
#pragma unroll
                        for (int n = 0; n < 2; ++n) { const f32x4 v = acc[ai][bj][m][n] * rsv; u32x2 o; o.x = cvtpk(v[0], v[1]); o.y = cvtpk(v[2], v[3]); st8(rp + 64 * n, o); } } }
            return;
        }
        const float* gp = (type == 0 ? qg : kg) + 16 * wc + 4 * fq;
        const float qsc = type == 0 ? 0.08838834764831845f * LOG2E : 1.0f;
        const f32x4 g0 = *(const f32x4*)(gp) * qsc, g1 = *(const f32x4*)(gp + 64) * qsc;
#pragma unroll
        for (int ai = 0; ai < 2; ++ai)
#pragma unroll
            for (int m = 0; m < 4; ++m)
#pragma unroll
                for (int bj = 0; bj < 2; ++bj) { const f32x4 x = acc[ai][bj][m][0], y = acc[ai][bj][m][1];
                    float ss = ((x[0] * x[0] + x[1] * x[1]) + (x[2] * x[2] + x[3] * x[3])) + ((y[0] * y[0] + y[1] * y[1]) + (y[2] * y[2] + y[3] * y[3]));
                    ss += __shfl_xor(ss, 16); ss += __shfl_xor(ss, 32);
                    if (fq == 0) xl[((ai * 128 + wr * 64 + m * 16 + fr) * 2 + bj) * 4 + wc] = ss; }
        asm volatile("s_waitcnt lgkmcnt(0)" ::: "memory"); __builtin_amdgcn_s_barrier(); asm volatile("" ::: "memory");
        const float epsv = NORM_EPS / (vsc * vsc);
        const int f0 = (wc & 1) * 16 + 4 * fq;
        f32x4 rc, rsn;
#define QKV128_ROPE_LOAD(G_) do { const int _ai = (G_) >> 2, _m = (G_) & 3; const int _grow = (4 * u.pm + 2 * _ai + wr) & 31, _gcol = 16 * _m + fr; const int _pos = lat ? (wc < 2 ? _grow : _gcol) : 64; \
        rc = *(const f32x4*)(rcos + _pos * 32 + f0); rsn = *(const f32x4*)(rsin + _pos * 32 + f0); } while (0)
        QKV128_ROPE_LOAD(0);
#pragma unroll
        for (int gi = 0; gi < 8; ++gi) { const int ai = gi >> 2, m = gi & 3;
            const f32x4 cs = rc, sn = rsn;
            if (gi < 7) QKV128_ROPE_LOAD(gi + 1);
            float epsr = epsv; if (INT) { const float rs = sar[ai][m]; epsr = NORM_EPS / (rs * rs); }
#pragma unroll
            for (int bj = 0; bj < 2; ++bj) { const f32x4 p = *(const LAS f32x4*)(xl + ((ai * 128 + wr * 64 + m * 16 + fr) * 2 + bj) * 4);
                const float rstd = __builtin_amdgcn_rsqf(((p[0] + p[1]) + (p[2] + p[3])) * (1.0f / 128.0f) + epsr);
                const f32x4 x1 = acc[ai][bj][m][0] * rstd * g0, x2 = acc[ai][bj][m][1] * rstd * g1;
                const f32x4 y1 = x1 * cs - x2 * sn, y2 = x1 * sn + x2 * cs;
                bf16_t* rp = ob + (size_t)(ai * 128 + m * 16) * ld + bj * 128;
                u32x2 o1, o2; o1.x = cvtpk(y1[0], y1[1]); o1.y = cvtpk(y1[2], y1[3]); o2.x = cvtpk(y2[0], y2[1]); o2.y = cvtpk(y2[2], y2[3]);
                st8(rp, o1); st8(rp + 64, o2); }
        }
#undef QKV128_ROPE_LOAD
    }
};
}

namespace att {
struct AUnit { int qrow0, qcol, kvcol, klat0, nlat, kctx0, a0, a1; };
#ifndef ATT_NSLOT64
#define ATT_NSLOT64 8
#endif
#ifndef ATT_GRP64
#define ATT_GRP64 4
#endif
#ifndef ATT_PAIR64
#define ATT_PAIR64 1
#endif
template <int DH> struct Geo { static constexpr int RB = DH * 2, KB = 64 * RB, SLOT = 2 * KB, NSLOT = DH == 64 ? ATT_NSLOT64 : 4, PD = (DH == 64 && ATT_PAIR64) ? NSLOT - ATT_GRP64 : NSLOT - 1, NQ = DH / 16, ND = DH / 32, CPR = RB / 16, RPPC = 1024 / RB, NPW = KB / 8192, NI = 2 * NPW;
                              static constexpr int TAB_OFF = 131072 + 512; };
__device__ __forceinline__ s16x4 trd(const LAS unsigned char* p) { return __builtin_bit_cast(s16x4, __builtin_amdgcn_ds_read_tr16_b64_v4i16((LAS s16x4*)p)); }
__device__ __forceinline__ float max3f(float a, float b, float c) { float r; asm("v_max3_f32 %0, %1, %2, %3" : "=v"(r) : "v"(a), "v"(b), "v"(c)); return r; }
__device__ __forceinline__ float swapmax(float v) { auto rr = __builtin_amdgcn_permlane32_swap(__float_as_uint(v), __float_as_uint(v), false, false); return fmaxf(__uint_as_float(rr[0]), __uint_as_float(rr[1])); }
__device__ __forceinline__ float swapsum(float v) { auto rr = __builtin_amdgcn_permlane32_swap(__float_as_uint(v), __float_as_uint(v), false, false); return __uint_as_float(rr[0]) + __uint_as_float(rr[1]); }

template <int DH, int MODE, bool Y8>
__device__ __forceinline__ void attn_unit(LAS unsigned char* lds, const int tid, const bf16_t* Q, const bf16_t* K, const bf16_t* V, bf16_t* Y, int ldk, const AUnit& u, const float* bias_h, float sink_l2, bool has_sink) {
    typedef Geo<DH> G;
    const int wid = __builtin_amdgcn_readfirstlane(tid >> 6), lane = tid & 63, r32 = lane & 31, hi = lane >> 5;
    constexpr float THR = 8.0f;
    const int NT = u.nlat + 4;
    const unsigned ldsa = (unsigned)(uintptr_t)lds;
    __builtin_amdgcn_s_barrier(); asm volatile("" ::: "memory");
    const int qoff = (MODE == 1) ? (2 * (wid >> 2) + (r32 >> 4)) * 64 + 16 * (wid & 3) + (r32 & 15) : wid * 32 + r32;
    bf16x8 qr[G::NQ];
    { const bf16_t* Qw = Q + (size_t)(u.qrow0 + qoff) * DM + u.qcol + hi * 8;
#pragma unroll
      for (int d0 = 0; d0 < G::NQ; ++d0) qr[d0] = *(const bf16x8*)(Qw + d0 * 16); }
    unsigned voffK[G::NPW], voffV[G::NPW];
#pragma unroll
    for (int i = 0; i < G::NPW; ++i) { const int pc = wid * G::NPW + i, row = pc * G::RPPC + lane / G::CPR, cp = lane % G::CPR;
        const int kf = DH == 64 ? ((row >> 1) & 7) : (row & 15), vf = DH == 64 ? (((row >> 1) & 1) << 2) : ((row & 3) << 2);
        voffK[i] = (unsigned)((row * ldk + u.kvcol) * 2 + ((cp ^ kf) << 4)); voffV[i] = (unsigned)((row * ldk + u.kvcol) * 2 + ((cp ^ vf) << 4)); }
#define ATT_T0(j) (((j) < u.nlat) ? u.klat0 + 64 * (j) : u.kctx0 + 64 * ((j) - u.nlat))
#define ATT_DMA(j) do { const size_t _tb = (size_t)ATT_T0(j) * ldk * 2; const unsigned _sl = ldsa + ((j) & (G::NSLOT - 1)) * G::SLOT + wid * G::NPW * 1024; \
        _Pragma("unroll") for (int i = 0; i < G::NPW; ++i) { pg8::glds_s((const char*)K + _tb, voffK[i], _sl + i * 1024); pg8::glds_s((const char*)V + _tb, voffV[i], _sl + G::KB + i * 1024); } } while (0)
    LAS float* tab = (LAS float*)(lds + G::TAB_OFF);
    if (MODE == 1) {
        for (int i = tid; i < 608; i += 512) { const int t = i - 64; float v = 0.f; if (t >= 0 && t < 480) { const int ri = t >> 5, ci = t & 31; if (ci < 31) v = bias_h[ri * 31 + ci] * LOG2E; } tab[t] = v; } }
#pragma unroll
    for (int t = 0; t < G::PD; ++t) if (t < NT) ATT_DMA(t);
    float m_run = -1e30f, l_run = 0.f;
    f32x16 o[G::ND];
#pragma unroll
    for (int d = 0; d < G::ND; ++d)
#pragma unroll
        for (int r = 0; r < 16; ++r) o[d][r] = 0.f;
    int w_lo = 0, w_hi = 0, l_lo = 0, l_hi = 0, tb_off = 0, m_lo = 0, m_hi = 0;
    float maddL[16];
    int cw = 0, jl_lo = 0, jl_hi = 0;
    if (MODE == 1) { const int R0 = 4 * u.a0 + 2 * (wid >> 2), cg = wid & 3, rq = R0 + (r32 >> 4), c = 16 * cg + (r32 & 15);
        int ra = R0 - 4; ra = ra < 0 ? 0 : (ra > 24 ? 24 : ra); int rb = R0 - 3; rb = rb < 0 ? 0 : (rb > 24 ? 24 : rb);
        w_lo = ra - u.a1; w_hi = rb - u.a1 + 8;
        const int r0l = (r32 >> 4) ? rb : ra; jl_lo = r0l - u.a1; jl_hi = jl_lo + 8;
        int c0 = c - 8; c0 = c0 < 0 ? 0 : (c0 > 48 ? 48 : c0);
        cw = 16 * cg - 8; cw = cw < 0 ? 0 : (cw > 32 ? 32 : cw);
        tb_off = (u.a1 - rq + 7) * 32 + cw + 4 * hi - c + 15;
#pragma unroll
        for (int r = 0; r < 16; ++r) { const int kc = cw + (r & 3) + 8 * (r >> 2) + 4 * hi; maddL[r] = (kc >= c0 && kc < c0 + 16) ? 0.f : -INFINITY; } }
    if (MODE == 2) { const int qw = u.a0 + 32 * wid;
        const int lo_pos = qw - 128 - u.a1 - 63, hi_pos = qw + 159 - u.a1;
        w_lo = lo_pos <= 0 ? 0 : (lo_pos + 63) >> 6; w_hi = hi_pos < 0 ? 0 : (hi_pos >> 6) + 1;
        const int f_lo = qw - 97 - u.a1, f_hi = qw + 65 - u.a1;
        m_lo = f_lo <= 0 ? 0 : (f_lo + 63) >> 6; m_hi = f_hi < 0 ? 0 : (f_hi >> 6) + 1;
        const int base = u.a1 - (qw + r32) + 4 * hi; l_lo = -128 - base; l_hi = 128 - base; }
    const int i16 = lane & 15, tq = i16 >> 2, tp4 = i16 & 3, blk = (lane >> 4) & 1;
    const int kfr = DH == 64 ? ((r32 >> 1) & 7) : (r32 & 15), xv = DH == 64 ? (tq >> 1) : tq;
    int koff[G::NQ], vo[G::ND];
#pragma unroll
    for (int d0 = 0; d0 < G::NQ; ++d0) koff[d0] = r32 * G::RB + (((2 * d0 + hi) ^ kfr) << 4);
#pragma unroll
    for (int d0 = 0; d0 < G::ND; ++d0) vo[d0] = G::KB + (4 * hi + tq) * G::RB + 64 * (d0 ^ xv) + 32 * blk + 8 * tp4;
    int koffL[G::NQ], voL[G::ND];
#pragma unroll
    for (int d0 = 0; d0 < G::NQ; ++d0) { const int row = cw + r32; koffL[d0] = row * G::RB + (((2 * d0 + hi) ^ ((row >> 1) & 7)) << 4); }
#pragma unroll
    for (int d0 = 0; d0 < G::ND; ++d0) voL[d0] = vo[d0] + cw * G::RB;
#define ATT_ACTIVE(j) ((MODE == 0) || (j) >= u.nlat || ((j) >= w_lo && (j) < w_hi))
#define ATT_MSUB() (m_run < -1e29f ? 0.f : m_run)
#define ATT_QKL(P0, MS, sl) do { const LAS unsigned char* _Kb = lds + (sl) * G::SLOT; MS = ATT_MSUB(); \
        _Pragma("unroll") for (int r = 0; r < 16; ++r) P0[r] = maddL[r] - MS; \
        bf16x8 _a0 = *(const LAS bf16x8*)(_Kb + koffL[0]); \
        _Pragma("unroll") for (int d0 = 0; d0 < G::NQ; ++d0) { bf16x8 _n0 = _a0; if (d0 + 1 < G::NQ) _n0 = *(const LAS bf16x8*)(_Kb + koffL[d0 + 1]); \
            __builtin_amdgcn_sched_barrier(0); P0 = __builtin_amdgcn_mfma_f32_32x32x16_bf16(_a0, qr[d0], P0, 0, 0, 0); __builtin_amdgcn_sched_barrier(0); _a0 = _n0; } } while (0)
#define ATT_SMPVL(P0, MS, j, sl) do { const LAS float* tp = tab + tb_off + 32 * (j); \
        _Pragma("unroll") for (int r = 0; r < 16; ++r) P0[r] += tp[(r & 3) + 8 * (r >> 2)]; \
        if ((j) == w_lo || (j) == w_hi - 1) { const bool rowok = (j) >= jl_lo && (j) < jl_hi;          \
            _Pragma("unroll") for (int r = 0; r < 16; ++r) P0[r] = rowok ? P0[r] : -INFINITY; } \
        float pm = P0[0]; \
        _Pragma("unroll") for (int r = 1; r < 15; r += 2) pm = max3f(pm, P0[r], P0[r + 1]); \
        pm = fmaxf(pm, P0[15]); pm = swapmax(pm); \
        if (__any(pm > (m_run - MS) + THR)) { const float mn = fmaxf(m_run, pm + MS); const float alpha = __builtin_amdgcn_exp2f(m_run - mn); m_run = mn; l_run *= alpha; \
            _Pragma("unroll") for (int d = 0; d < G::ND; ++d) _Pragma("unroll") for (int r = 0; r < 16; ++r) o[d][r] *= alpha; } \
        { const float dl = m_run - MS; if (__any(dl != 0.f)) { _Pragma("unroll") for (int r = 0; r < 16; ++r) P0[r] -= dl; } }        \
        float ps = 0.f; \
        _Pragma("unroll") for (int r = 0; r < 16; ++r) { P0[r] = __builtin_amdgcn_exp2f(P0[r]); ps += P0[r]; } \
        l_run += swapsum(ps); \
        bf16x8 pbl[2]; \
        _Pragma("unroll") for (int s = 0; s < 2; ++s) { u32x4 w0; \
            w0.x = cvtpk(P0[8 * s + 0], P0[8 * s + 1]); w0.y = cvtpk(P0[8 * s + 2], P0[8 * s + 3]); w0.z = cvtpk(P0[8 * s + 4], P0[8 * s + 5]); w0.w = cvtpk(P0[8 * s + 6], P0[8 * s + 7]); \
            pbl[s] = __builtin_bit_cast(bf16x8, w0); } \
        const LAS unsigned char* _Vb = lds + (sl) * G::SLOT; \
        { s16x4 lo_ = trd(_Vb + voL[0]), hh_ = trd(_Vb + voL[0] + 8 * G::RB); \
        _Pragma("unroll") for (int i_ = 0; i_ < 2 * G::ND; ++i_) { const int s = i_ / G::ND, d0 = i_ % G::ND; s16x4 nl_ = lo_, nh_ = hh_; \
            if (i_ + 1 < 2 * G::ND) { const int s1 = (i_ + 1) / G::ND, d1 = (i_ + 1) % G::ND; nl_ = trd(_Vb + voL[d1] + (16 * s1) * G::RB); nh_ = trd(_Vb + voL[d1] + (16 * s1 + 8) * G::RB); } \
            __builtin_amdgcn_sched_barrier(0); \
            const bf16x8 va = __builtin_shufflevector(lo_, hh_, 0, 1, 2, 3, 4, 5, 6, 7); \
            o[d0] = __builtin_amdgcn_mfma_f32_32x32x16_bf16(va, pbl[s], o[d0], 0, 0, 0); \
            __builtin_amdgcn_sched_barrier(0); \
            lo_ = nl_; hh_ = nh_; } } } while (0)
#define ATT_QK(P0, P1, MS, sl) do { const LAS unsigned char* _Kb = lds + (sl) * G::SLOT; MS = ATT_MSUB(); \
        _Pragma("unroll") for (int r = 0; r < 16; ++r) { P0[r] = -MS; P1[r] = -MS; } \
        __builtin_amdgcn_s_setprio(1); \
        bf16x8 _a0 = *(const LAS bf16x8*)(_Kb + koff[0]), _a1 = *(const LAS bf16x8*)(_Kb + koff[0] + 32 * G::RB); \
        _Pragma("unroll") for (int d0 = 0; d0 < G::NQ; ++d0) { bf16x8 _n0 = _a0, _n1 = _a1;        \
            if (d0 + 1 < G::NQ) { _n0 = *(const LAS bf16x8*)(_Kb + koff[d0 + 1]); _n1 = *(const LAS bf16x8*)(_Kb + koff[d0 + 1] + 32 * G::RB); } \
            __builtin_amdgcn_sched_barrier(0); \
            P0 = __builtin_amdgcn_mfma_f32_32x32x16_bf16(_a0, qr[d0], P0, 0, 0, 0); \
            P1 = __builtin_amdgcn_mfma_f32_32x32x16_bf16(_a1, qr[d0], P1, 0, 0, 0); \
            __builtin_amdgcn_sched_barrier(0); \
            _a0 = _n0; _a1 = _n1; } \
        __builtin_amdgcn_s_setprio(0); } while (0)
#define ATT_SMPV(P0, P1, MS, j, sl) do { \
        const bool _lat = (j) < u.nlat; float pm; \
        if (MODE == 2 && _lat && !((j) >= m_lo && (j) < m_hi)) { const int lo = l_lo - 64 * (j), hh = l_hi - 64 * (j); \
            _Pragma("unroll") for (int r = 0; r < 16; ++r) { const int e0 = (r & 3) + 8 * (r >> 2), e1 = e0 + 32; \
                P0[r] = (e0 >= lo && e0 <= hh) ? P0[r] : -INFINITY; P1[r] = (e1 >= lo && e1 <= hh) ? P1[r] : -INFINITY; } } \
        pm = fmaxf(P0[0], P1[0]); \
        _Pragma("unroll") for (int r = 1; r < 16; ++r) pm = max3f(pm, P0[r], P1[r]); \
        pm = swapmax(pm); \
        if (__any(pm > (m_run - MS) + THR)) { const float mn = fmaxf(m_run, pm + MS); const float alpha = __builtin_amdgcn_exp2f(m_run - mn); m_run = mn; l_run *= alpha; \
            _Pragma("unroll") for (int d = 0; d < G::ND; ++d) _Pragma("unroll") for (int r = 0; r < 16; ++r) o[d][r] *= alpha; } \
        { const float dl = m_run - MS; if (__any(dl != 0.f)) { _Pragma("unroll") for (int r = 0; r < 16; ++r) { P0[r] -= dl; P1[r] -= dl; } } }        \
        float ps = 0.f; \
        _Pragma("unroll") for (int r = 0; r < 16; ++r) { P0[r] = __builtin_amdgcn_exp2f(P0[r]); P1[r] = __builtin_amdgcn_exp2f(P1[r]); ps += P0[r] + P1[r]; } \
        l_run += swapsum(ps); \
        bf16x8 pb[2][2]; \
        _Pragma("unroll") for (int s = 0; s < 2; ++s) { u32x4 w0, w1; \
            w0.x = cvtpk(P0[8 * s + 0], P0[8 * s + 1]); w0.y = cvtpk(P0[8 * s + 2], P0[8 * s + 3]); w0.z = cvtpk(P0[8 * s + 4], P0[8 * s + 5]); w0.w = cvtpk(P0[8 * s + 6], P0[8 * s + 7]); \
            w1.x = cvtpk(P1[8 * s + 0], P1[8 * s + 1]); w1.y = cvtpk(P1[8 * s + 2], P1[8 * s + 3]); w1.z = cvtpk(P1[8 * s + 4], P1[8 * s + 5]); w1.w = cvtpk(P1[8 * s + 6], P1[8 * s + 7]); \
            pb[0][s] = __builtin_bit_cast(bf16x8, w0); pb[1][s] = __builtin_bit_cast(bf16x8, w1); } \
        const LAS unsigned char* _Vb = lds + (sl) * G::SLOT; \
        __builtin_amdgcn_s_setprio(1); \
        { s16x4 lo_ = trd(_Vb + vo[0]), hh_ = trd(_Vb + vo[0] + 8 * G::RB);        \
        _Pragma("unroll") for (int i_ = 0; i_ < 4 * G::ND; ++i_) { const int kt = i_ / (2 * G::ND), s = (i_ / G::ND) & 1, d0 = i_ % G::ND; s16x4 nl_ = lo_, nh_ = hh_; \
            if (i_ + 1 < 4 * G::ND) { const int kt1 = (i_ + 1) / (2 * G::ND), s1 = ((i_ + 1) / G::ND) & 1, d1 = (i_ + 1) % G::ND; \
                nl_ = trd(_Vb + vo[d1] + (32 * kt1 + 16 * s1) * G::RB); nh_ = trd(_Vb + vo[d1] + (32 * kt1 + 16 * s1 + 8) * G::RB); } \
            __builtin_amdgcn_sched_barrier(0); \
            const bf16x8 va = __builtin_shufflevector(lo_, hh_, 0, 1, 2, 3, 4, 5, 6, 7); \
            o[d0] = __builtin_amdgcn_mfma_f32_32x32x16_bf16(va, pb[kt][s], o[d0], 0, 0, 0); \
            __builtin_amdgcn_sched_barrier(0); \
            lo_ = nl_; hh_ = nh_; } } \
        __builtin_amdgcn_s_setprio(0); } while (0)
#define ATT_WAIT(c) do { const int _c = (c); if (_c <= 0) asm volatile("s_waitcnt vmcnt(0)" ::: "memory"); else if (_c == 1) asm volatile("s_waitcnt vmcnt(%0)" :: "n"(G::NI) : "memory"); \
        else if (_c == 2) asm volatile("s_waitcnt vmcnt(%0)" :: "n"(2 * G::NI) : "memory"); else if (_c == 3) asm volatile("s_waitcnt vmcnt(%0)" :: "n"(3 * G::NI) : "memory"); \
        else if (_c == 4) asm volatile("s_waitcnt vmcnt(%0)" :: "n"(4 * G::NI) : "memory"); else asm volatile("s_waitcnt vmcnt(%0)" :: "n"(5 * G::NI) : "memory"); } while (0)
#define ATT_STEP(C0, C1, CM, N0, N1, NM, j) do { \
        { const int _last = ((j) + G::PD - 1 < NT - 1) ? (j) + G::PD - 1 : NT - 1; ATT_WAIT(_last - ((j) + 1)); } \
        __builtin_amdgcn_s_barrier(); asm volatile("" ::: "memory"); \
        if ((j) + G::PD < NT) ATT_DMA((j) + G::PD); \
        if ((j) + 1 < NT && ATT_ACTIVE((j) + 1)) ATT_QK(N0, N1, NM, ((j) + 1) & (G::NSLOT - 1)); \
        if (ATT_ACTIVE(j)) ATT_SMPV(C0, C1, CM, j, (j) & (G::NSLOT - 1)); } while (0)
    if constexpr (DH == 128) {
    f32x16 sA0, sA1, sB0, sB1; float msA = 0.f, msB = 0.f;
    { const int _iss = G::PD < NT ? G::PD : NT; ATT_WAIT(_iss - 2); }
    asm volatile("s_waitcnt lgkmcnt(0)" ::: "memory");
    __builtin_amdgcn_s_barrier(); asm volatile("" ::: "memory");
    if (ATT_ACTIVE(0)) ATT_QK(sA0, sA1, msA, 0);
    for (int j = 0; j < NT; j += 2) {
        ATT_STEP(sA0, sA1, msA, sB0, sB1, msB, j);
        if (j + 1 < NT) ATT_STEP(sB0, sB1, msB, sA0, sA1, msA, j + 1);
    }
    } else {
#define ATT_STEP1(C0, C1, j) do { \
        { const int _last = ((j) + G::PD - 1 < NT - 1) ? (j) + G::PD - 1 : NT - 1; ATT_WAIT(_last - (j)); } \
        __builtin_amdgcn_s_barrier(); asm volatile("" ::: "memory"); \
        if ((j) + G::PD < NT) ATT_DMA((j) + G::PD); \
        if (ATT_ACTIVE(j)) { if (MODE == 1 && (j) < u.nlat) { ATT_QKL(C0, msA, (j) & (G::NSLOT - 1)); ATT_SMPVL(C0, msA, j, (j) & (G::NSLOT - 1)); } \
                             else { ATT_QK(C0, C1, msA, (j) & (G::NSLOT - 1)); ATT_SMPV(C0, C1, msA, j, (j) & (G::NSLOT - 1)); } } } while (0)
    f32x16 sA0, sA1; float msA = 0.f;
    asm volatile("s_waitcnt lgkmcnt(0)" ::: "memory");
    if constexpr (ATT_PAIR64) {
#define ATT_TILE1(C0, C1, j) do { if (ATT_ACTIVE(j)) { if (MODE == 1 && (j) < u.nlat) { ATT_QKL(C0, msA, (j) & (G::NSLOT - 1)); ATT_SMPVL(C0, msA, j, (j) & (G::NSLOT - 1)); } \
                                                     else { ATT_QK(C0, C1, msA, (j) & (G::NSLOT - 1)); ATT_SMPV(C0, C1, msA, j, (j) & (G::NSLOT - 1)); } } } while (0)
        for (int j = 0; j < NT; j += ATT_GRP64) {
            { const int _iss = (j + G::PD - 1 < NT - 1) ? j + G::PD - 1 : NT - 1; const int _need = (j + ATT_GRP64 - 1 < NT - 1) ? j + ATT_GRP64 - 1 : NT - 1; ATT_WAIT(_iss - _need); }
            __builtin_amdgcn_s_barrier(); asm volatile("" ::: "memory");
#pragma unroll
            for (int g = 0; g < ATT_GRP64; ++g) if (j + G::PD + g < NT) ATT_DMA(j + G::PD + g);
#pragma unroll
            for (int g = 0; g < ATT_GRP64; ++g) if (j + g < NT) ATT_TILE1(sA0, sA1, j + g);
        }
#undef ATT_TILE1
    } else {
    for (int j = 0; j < NT; ++j) ATT_STEP1(sA0, sA1, j);
    }
#undef ATT_STEP1
    }
    if (has_sink) l_run += __builtin_amdgcn_exp2f(sink_l2 - m_run);
    const float inv = 1.0f / l_run;
    if (Y8) { unsigned char* Yb = (unsigned char*)Y + (size_t)(u.qrow0 + qoff) * DM + u.qcol + 4 * hi; const float sc8 = inv * Y8_SCALE;
#pragma unroll
        for (int d0 = 0; d0 < G::ND; ++d0)
#pragma unroll
            for (int g4 = 0; g4 < 4; ++g4) st4(Yb + 32 * d0 + 8 * g4, pk4_fp8(o[d0][4 * g4] * sc8, o[d0][4 * g4 + 1] * sc8, o[d0][4 * g4 + 2] * sc8, o[d0][4 * g4 + 3] * sc8));
    } else {
    bf16_t* Yw = Y + (size_t)(u.qrow0 + qoff) * DM + u.qcol + 4 * hi;
#pragma unroll
    for (int d0 = 0; d0 < G::ND; ++d0)
#pragma unroll
        for (int g4 = 0; g4 < 4; ++g4) { u32x2 w; w.x = cvtpk(o[d0][4 * g4] * inv, o[d0][4 * g4 + 1] * inv); w.y = cvtpk(o[d0][4 * g4 + 2] * inv, o[d0][4 * g4 + 3] * inv);
            st8(Yw + 32 * d0 + 8 * g4, w); } }
#undef ATT_T0
#undef ATT_DMA
#undef ATT_ACTIVE
#undef ATT_QK
#undef ATT_QKL
#undef ATT_MSUB
#undef ATT_SMPVL
#undef ATT_SMPV
#undef ATT_STEP
#undef ATT_WAIT
}
}

constexpr size_t MiB = 1u << 20;
constexpr size_t WS_CTL = 0, CTL_ZERO_BYTES = 1 * MiB;
constexpr size_t WS_MOD = 1 * MiB;
constexpr size_t WS_ROPE = 3 * MiB - 64 * 1024;
constexpr size_t WS_LIST = 3 * MiB;
constexpr size_t WS_SA = 5 * MiB + 256 * 1024;
constexpr size_t WS_SWQKV = WS_SA + 160 * 1024;
constexpr size_t WS_SWD = WS_SWQKV + 40 * 1024;
constexpr size_t WS_SWM = WS_SWD + 56 * 1024;
static_assert(WS_SWM + 8 * 7168 * 4 <= 6 * MiB, "scale arrays");
constexpr size_t WS_XC = 6 * MiB;
constexpr size_t WS_H = 22 * MiB;
constexpr size_t WS_SLOTS = 94 * MiB;
constexpr size_t WS_WQKV = 238 * MiB;
constexpr size_t WS_WO = 257 * MiB;
constexpr size_t WS_WDENSE = 265 * MiB;
constexpr size_t WS_WMOE = 307 * MiB;
constexpr size_t WS_ARENA = 475 * MiB;
constexpr size_t WS_Q = WS_ARENA, WS_K = WS_ARENA + 72 * MiB, WS_V = WS_ARENA + 144 * MiB, WS_ACT = WS_ARENA;
constexpr int MOE_ROWS_MAX = 2 * TT + 2048;
constexpr size_t ACT_MOE_BYTES = (size_t)MOE_ROWS_MAX * DFF * (FP8_MOE_OUT ? 1 : 2), ACT_DENSE_BYTES = (size_t)TT * DFF * (FP8_DENSE_OUT ? 1 : 2);
constexpr size_t ARENA_BYTES = ((ACT_MOE_BYTES > ACT_DENSE_BYTES ? (ACT_MOE_BYTES > 216 * MiB ? ACT_MOE_BYTES : 216 * MiB) : (ACT_DENSE_BYTES > 216 * MiB ? ACT_DENSE_BYTES : 216 * MiB)) + MiB - 1) / MiB * MiB;
constexpr size_t WS_XBL = WS_ARENA + ARENA_BYTES;
constexpr size_t WS_END = WS_XBL + (size_t)TL * DM * 2;
static_assert(WS_END <= 1040 * MiB, "ws map: d_ws is >= sum of the inputs = 1050 MiB");
constexpr size_t WDENSE_SLOT = (size_t)(2 * DFF * DM + DM * DFF) * 2;
constexpr size_t WMOE_IN_BYTES = (size_t)NEXP * 2 * DFF * DM * 2;
constexpr int CW_TMO = 0, CW_BAR = 4096, CW_MOECNT = 8192;

constexpr int RING_BYTES = 131072, XL_OFF = RING_BYTES, MOE_OFF = XL_OFF + 8192, MISC_OFF = MOE_OFF + 256, PARK_OFF = 140288, LDS_BYTES = PARK_OFF + 8192;
static_assert(XL_OFF == pg8::XL_OFF_ && PARK_OFF == pg8::PARK_OFF_ && MISC_OFF + 256 <= PARK_OFF && LDS_BYTES <= 160 * 1024, "LDS map");

#define XB_TMO      128
#define XB_XCNT(j)  (256  + 64 * (j))
#define XB_XSUB(j)  (1280 + 64 * (j))
#define XB_XGEN(j)  (2304 + 64 * (j))
#define XB_TOP      3328
#define XB_TOPGEN   3392
#define XCD_BAR_WORDS 3456
#define XB_SPIN_CAP (1u << 18)
__device__ __forceinline__ unsigned xb_ld(unsigned* p)              { return __hip_atomic_load(p, __ATOMIC_RELAXED, __HIP_MEMORY_SCOPE_AGENT); }
__device__ __forceinline__ unsigned xb_add(unsigned* p, unsigned v) { return __hip_atomic_fetch_add(p, v, __ATOMIC_RELAXED, __HIP_MEMORY_SCOPE_AGENT); }
__device__ __forceinline__ unsigned xb_xcc_id() { return (unsigned)__builtin_amdgcn_s_getreg((3 << 11) | 20) & 0xFu; }
#define XB_SPIN(cond, bar) do { unsigned _sp = 0; while (cond) { __builtin_amdgcn_s_sleep(1); \
    if ((++_sp & 255u) == 0u) { if (xb_ld(&(bar)[XB_TMO])) break; if (_sp > XB_SPIN_CAP) { atomicAdd(&(bar)[XB_TMO], 1u); break; } } } } while (0)
struct XcdBarrier { unsigned* bar; unsigned x; volatile LAS unsigned* st; int wave; };
__device__ __forceinline__ XcdBarrier xcd_barrier_post(unsigned* bar, volatile LAS unsigned* st, int wave) {
    XcdBarrier b; b.bar = bar; b.x = xb_xcc_id(); b.st = st; b.wave = wave;
    if (wave == 0 && lane_now0() == 0) (void)xb_add(&bar[XB_XCNT(b.x)], 1u);
    return b;
}
__device__ __forceinline__ void xcd_barrier_complete(unsigned* bar, unsigned x, unsigned& nloc, unsigned& nx) {
    const unsigned G = gridDim.x * gridDim.y * gridDim.z;
    unsigned sum, cnt, mine, sp = 0u;
    for (;;) {
        sum = 0u; cnt = 0u; mine = 0u;
#pragma unroll
        for (unsigned j = 0; j < 16; ++j) { const unsigned c = xb_ld(&bar[XB_XCNT(j)]); sum += c; cnt += (c > 0u) ? 1u : 0u; mine = (j == x) ? c : mine; }
        if (sum == G) break;
        __builtin_amdgcn_s_sleep(1);
        if ((++sp & 255u) == 0u) { if (xb_ld(&bar[XB_TMO])) break; if (sp > XB_SPIN_CAP) { atomicAdd(&bar[XB_TMO], 1u); break; } }
    }
    nloc = mine > 0u ? mine : 1u; nx = cnt > 0u ? cnt : 1u;
}
__device__ __forceinline__ void xcd_barrier(const XcdBarrier& b) {
    asm volatile("s_waitcnt vmcnt(0)" ::: "memory");
    __syncthreads();
    if (b.wave == 0 && lane_now0() == 0) {
        unsigned* bar = b.bar;
        __builtin_amdgcn_s_waitcnt(0);
        unsigned nloc = b.st[0], nx = b.st[1];
        if (nloc == 0u) { xcd_barrier_complete(bar, b.x, nloc, nx); b.st[0] = nloc; b.st[1] = nx; }
        const unsigned old = xb_add(&bar[XB_XSUB(b.x)], 1u);
        const unsigned gen = old / nloc;
        if (old + 1u == (gen + 1u) * nloc) {
            __builtin_amdgcn_fence(__ATOMIC_RELEASE, "agent");
            asm volatile("s_waitcnt vmcnt(0)" ::: "memory");
            const unsigned og = xb_add(&bar[XB_TOP], 1u);
            const unsigned tg = og / nx;
            if (og + 1u == (tg + 1u) * nx) xb_add(&bar[XB_TOPGEN], 1u);
            else XB_SPIN(xb_ld(&bar[XB_TOPGEN]) == tg, bar);
            __builtin_amdgcn_fence(__ATOMIC_ACQUIRE, "agent");
            xb_add(&bar[XB_XGEN(b.x)], 1u);
            asm volatile("s_waitcnt vmcnt(0)" ::: "memory");
        } else {
            XB_SPIN(xb_ld(&bar[XB_XGEN(b.x)]) == gen, bar);
            __builtin_amdgcn_fence(__ATOMIC_ACQUIRE, "agent");
            asm volatile("s_waitcnt vmcnt(0)" ::: "memory");
        }
    }
    __syncthreads();
}

constexpr int N_IN = 51;
struct Args { const float* in[N_IN]; float* out; unsigned char* ws; int ph_lo, ph_hi; };
struct Frame { LAS unsigned char* lds; int tid, lane, wave, vcu, G, gw, NGW; const Args* a; unsigned char* ws; float* out; bf16_t* xl16; bf16_t* xc16; const float* mod; };

#define LDS_WAIT() asm volatile("s_waitcnt lgkmcnt(0)" ::: "memory")
__device__ __forceinline__ int lane_now() { int l; asm volatile("v_mbcnt_lo_u32_b32 %0, -1, 0\n\tv_mbcnt_hi_u32_b32 %0, -1, %0" : "=v"(l)); return l; }
__device__ __forceinline__ float wave_sum(float v) {
#pragma unroll
    for (int o = 1; o < 64; o <<= 1) v += __shfl_xor(v, o);
    return v;
}
__host__ __device__ constexpr int layer_base(int L) { return L == 0 ? 4 : (L == 1 ? 15 : (L == 2 ? 28 : 38)); }
__host__ __device__ constexpr int layer_mixer(int L) { return L % 3; }
__host__ __device__ constexpr bool layer_moe(int L) { return (L & 1) != 0; }
__host__ __device__ constexpr int layer_nqkv(int L) { return L == 1 ? 1536 : (L == 2 ? 2048 : 3072); }
__host__ __device__ constexpr int layer_wqkv_row(int L) { return L == 0 ? 0 : (L == 1 ? 3072 : (L == 2 ? 4608 : 6656)); }
__host__ __device__ constexpr int layer_wo_idx(int L) { return layer_base(L) + (L == 2 ? 7 : 8); }
__host__ __device__ constexpr int layer_ffn_idx(int L) { return layer_base(L) + (L == 2 ? 8 : 9); }

__device__ __forceinline__ int conv_map(int mt, int rd) {
    if (mt == 0) return rd;
    const int pn = rd >> 8, s = rd & 255, bj = s >> 7, wc = (s >> 5) & 3, n = (s >> 4) & 1, fq = (s >> 2) & 3, i = s & 3;
    if (mt == 1) return (4 * pn + wc) * 64 + 32 * bj + 8 * fq + 4 * n + i;
    if (mt == 2) return (2 * pn + bj) * 128 + 64 * n + 16 * wc + 4 * fq + i;
    return bj * DFF + 128 * pn + 32 * wc + 8 * fq + 4 * n + i;
}
__device__ __forceinline__ void conv_item8(const float* W, int K, int N, unsigned char* WT, int mt, float scale, int item, int lane, LAS float* scr) {
    const int nblk = N / 32, kb = item / nblk, nb = item % nblk, k0 = 64 * kb, rd0 = 32 * nb;
    const float sc2 = mt == 3 ? scale * (((rd0 >> 7) & 1) ? LN2 : LOG2E) : scale;
    const int kq = lane >> 3, gq = lane & 7;
    const float* wp = W + (size_t)(k0 + kq) * N + conv_map(mt, rd0 + 4 * gq);
#pragma unroll
    for (int i = 0; i < 8; ++i) { const f32x4 v = __builtin_nontemporal_load((const f32x4*)(wp + (size_t)(8 * i) * N));        LAS float* d = scr + (8 * i + kq) * 33 + 4 * gq; d[0] = v[0]; d[1] = v[1]; d[2] = v[2]; d[3] = v[3]; }
    LDS_WAIT(); asm volatile("" ::: "memory");
    const int c = lane & 7;
#pragma unroll
    for (int j = 0; j < 4; ++j) { const int n = (lane >> 3) + 8 * j; const LAS float* s = scr + (8 * c) * 33 + n;
        u32x2 o; o.x = pk4_fp8(s[0 * 33] * sc2, s[1 * 33] * sc2, s[2 * 33] * sc2, s[3 * 33] * sc2); o.y = pk4_fp8(s[4 * 33] * sc2, s[5 * 33] * sc2, s[6 * 33] * sc2, s[7 * 33] * sc2);
        __builtin_nontemporal_store(o, (u32x2*)(WT + (size_t)(rd0 + n) * K + k0 + 8 * c)); }
    LDS_WAIT(); asm volatile("" ::: "memory");
}
__device__ __forceinline__ unsigned pk4_i8(float a, float b, float c, float d) {
    const unsigned ya = __float_as_uint(a + 12582912.0f), yb = __float_as_uint(b + 12582912.0f), yc = __float_as_uint(c + 12582912.0f), yd = __float_as_uint(d + 12582912.0f);
    return __builtin_amdgcn_perm(yb, ya, 0x0c0c0400u) | __builtin_amdgcn_perm(yd, yc, 0x04000c0cu); }
__device__ __forceinline__ void conv_cols_i8(const float* W, int K, int N, unsigned char* WT, int mt, float* swout, int nb, int lane, LAS float* scr) {
    const int rd0 = 32 * nb, kq = lane >> 3, gq = lane & 7;
    const float fac = mt == 3 ? (((rd0 >> 7) & 1) ? LN2 : LOG2E) : 1.0f;
    const float* wp = W + (size_t)kq * N + conv_map(mt, rd0 + 4 * gq);
    f32x4 mx = {0.f, 0.f, 0.f, 0.f};
    for (int kb = 0; kb < K / 64; ++kb) {
#pragma unroll
        for (int i = 0; i < 8; ++i) { const f32x4 v = *(const f32x4*)(wp + (size_t)(64 * kb + 8 * i) * N);
            mx[0] = fmaxf(mx[0], fabsf(v[0])); mx[1] = fmaxf(mx[1], fabsf(v[1])); mx[2] = fmaxf(mx[2], fabsf(v[2])); mx[3] = fmaxf(mx[3], fabsf(v[3])); } }
#pragma unroll
    for (int c = 0; c < 4; ++c) { mx[c] = fmaxf(mx[c], __shfl_xor(mx[c], 8)); mx[c] = fmaxf(mx[c], __shfl_xor(mx[c], 16)); mx[c] = fmaxf(mx[c], __shfl_xor(mx[c], 32)); }
    LAS float* invs = scr + 64 * 33;
    if (kq == 0) {
#pragma unroll
        for (int c = 0; c < 4; ++c) { const float m = mx[c]; invs[4 * gq + c] = m > 0.f ? 127.0f / m : 0.f; swout[rd0 + 4 * gq + c] = m > 0.f ? m * fac * (1.0f / 127.0f) : 1.0f; } }
    LDS_WAIT(); asm volatile("" ::: "memory");
    const int c4 = lane & 3, nn = lane >> 2;
    for (int kb = 0; kb < K / 64; ++kb) {
#pragma unroll
        for (int i = 0; i < 8; ++i) { const f32x4 v = *(const f32x4*)(wp + (size_t)(64 * kb + 8 * i) * N); LAS float* d = scr + (8 * i + kq) * 33 + 4 * gq; d[0] = v[0]; d[1] = v[1]; d[2] = v[2]; d[3] = v[3]; }
        LDS_WAIT(); asm volatile("" ::: "memory");
#pragma unroll
        for (int j = 0; j < 2; ++j) { const int n = nn + 16 * j; const float inv = invs[n]; const LAS float* sp = scr + (16 * c4) * 33 + n;
            u32x4 o; o.x = pk4_i8(sp[0 * 33] * inv, sp[1 * 33] * inv, sp[2 * 33] * inv, sp[3 * 33] * inv); o.y = pk4_i8(sp[4 * 33] * inv, sp[5 * 33] * inv, sp[6 * 33] * inv, sp[7 * 33] * inv);
            o.z = pk4_i8(sp[8 * 33] * inv, sp[9 * 33] * inv, sp[10 * 33] * inv, sp[11 * 33] * inv); o.w = pk4_i8(sp[12 * 33] * inv, sp[13 * 33] * inv, sp[14 * 33] * inv, sp[15 * 33] * inv);
            *(u32x4*)(WT + (size_t)(rd0 + n) * K + 64 * kb + 16 * c4) = o; }
        LDS_WAIT(); asm volatile("" ::: "memory");
    }
}
__device__ __forceinline__ void conv_block_i8(Frame& F, const float* W, int N, unsigned char* WT, int mt, float* swout, int nb) {
    constexpr int K = DM;
    const int lane = F.lane, w = F.wave, rd0 = 32 * nb, kq = lane >> 3, gq = lane & 7;
    const float fac = mt == 3 ? (((rd0 >> 7) & 1) ? LN2 : LOG2E) : 1.0f;
    LAS float* T = (LAS float*)F.lds; LAS float* xm = (LAS float*)(F.lds + pg8::XL_OFF_);
    const float* wp = W + (size_t)(128 * w + kq) * N + conv_map(mt, rd0 + 4 * gq);
    f32x4 mx = {0.f, 0.f, 0.f, 0.f};
#pragma unroll
    for (int i = 0; i < 16; ++i) { const f32x4 v = __builtin_nontemporal_load((const f32x4*)(wp + (size_t)(8 * i) * N));        const int k = 128 * w + 8 * i + kq, rot = 8 * ((k >> 4) & 3);
        LAS float* d = T + k * 32;
        d[(4 * gq + 0 + rot) & 31] = v[0]; d[(4 * gq + 1 + rot) & 31] = v[1]; d[(4 * gq + 2 + rot) & 31] = v[2]; d[(4 * gq + 3 + rot) & 31] = v[3];
        mx[0] = fmaxf(mx[0], fabsf(v[0])); mx[1] = fmaxf(mx[1], fabsf(v[1])); mx[2] = fmaxf(mx[2], fabsf(v[2])); mx[3] = fmaxf(mx[3], fabsf(v[3])); }
#pragma unroll
    for (int c = 0; c < 4; ++c) { mx[c] = fmaxf(mx[c], __shfl_xor(mx[c], 8)); mx[c] = fmaxf(mx[c], __shfl_xor(mx[c], 16)); mx[c] = fmaxf(mx[c], __shfl_xor(mx[c], 32)); }
    if (kq == 0) {
#pragma unroll
        for (int c = 0; c < 4; ++c) xm[w * 32 + 4 * gq + c] = mx[c]; }
    __syncthreads();
    const int c8 = lane & 7, n8 = lane >> 3;
#pragma unroll
    for (int j = 0; j < 4; ++j) { const int n = n8 + 8 * j;
        float m = xm[n];
#pragma unroll
        for (int ww = 1; ww < 8; ++ww) m = fmaxf(m, xm[ww * 32 + n]);
        const float inv = m > 0.f ? 127.0f / m : 0.f;
        if (w == 0 && c8 == 0) swout[rd0 + n] = m > 0.f ? m * fac * (1.0f / 127.0f) : 1.0f;
        const int k0 = 128 * w + 16 * c8, rot = 8 * ((k0 >> 4) & 3); const LAS float* sp = T + k0 * 32 + ((n + rot) & 31);
        u32x4 o; o.x = pk4_i8(sp[0 * 32] * inv, sp[1 * 32] * inv, sp[2 * 32] * inv, sp[3 * 32] * inv); o.y = pk4_i8(sp[4 * 32] * inv, sp[5 * 32] * inv, sp[6 * 32] * inv, sp[7 * 32] * inv);
        o.z = pk4_i8(sp[8 * 32] * inv, sp[9 * 32] * inv, sp[10 * 32] * inv, sp[11 * 32] * inv); o.w = pk4_i8(sp[12 * 32] * inv, sp[13 * 32] * inv, sp[14 * 32] * inv, sp[15 * 32] * inv);
        __builtin_nontemporal_store(o, (u32x4*)(WT + (size_t)(rd0 + n) * K + k0)); }
    __syncthreads();
}
__device__ __forceinline__ void conv_item(const float* W, int K, int N, bf16_t* WT, int mt, int item, int lane, LAS float* scr) {
    const int nblk = N / 32, kb = item / nblk, nb = item % nblk, k0 = 64 * kb, rd0 = 32 * nb;
    const float sc2 = mt == 3 ? (((rd0 >> 7) & 1) ? LN2 : LOG2E) : 1.0f;
    const int kq = lane >> 3, gq = lane & 7;
    const float* wp = W + (size_t)(k0 + kq) * N + conv_map(mt, rd0 + 4 * gq);
#pragma unroll
    for (int i = 0; i < 8; ++i) { const f32x4 v = __builtin_nontemporal_load((const f32x4*)(wp + (size_t)(8 * i) * N));        LAS float* d = scr + (8 * i + kq) * 33 + 4 * gq; d[0] = v[0]; d[1] = v[1]; d[2] = v[2]; d[3] = v[3]; }
    LDS_WAIT(); asm volatile("" ::: "memory");
    const int c = lane & 7;
#pragma unroll
    for (int j = 0; j < 4; ++j) { const int n = (lane >> 3) + 8 * j; const LAS float* s = scr + (8 * c) * 33 + n;
        u32x4 o; o.x = cvtpk(s[0 * 33] * sc2, s[1 * 33] * sc2); o.y = cvtpk(s[2 * 33] * sc2, s[3 * 33] * sc2); o.z = cvtpk(s[4 * 33] * sc2, s[5 * 33] * sc2); o.w = cvtpk(s[6 * 33] * sc2, s[7 * 33] * sc2);
        __builtin_nontemporal_store(o, (u32x4*)(WT + (size_t)(rd0 + n) * K + k0 + 8 * c)); }
    LDS_WAIT(); asm volatile("" ::: "memory");
}
template <int L>
__device__ __forceinline__ void conv_layer(Frame& F, int bi, int nb, int b0 = 0, int b1 = 1 << 30, int w0 = 0, int w1 = 1 << 30) {
    constexpr int NQ = layer_nqkv(L), MTQ = (layer_mixer(L) == 2) ? 2 : 1;
    constexpr int QDT = qkv_dt(), IDT = ffn_in_dt(L); constexpr bool OUT8 = ffn_out8(L), MOE = layer_moe(L);
    const float* wq = F.a->in[layer_base(L) + 4]; const float* wo = F.a->in[layer_wo_idx(L)];
    const float* win = F.a->in[layer_ffn_idx(L) + (MOE ? 2 : 0)]; const float* wout = F.a->in[layer_ffn_idx(L) + (MOE ? 3 : 1)];
    unsigned char* dq = F.ws + WS_WQKV + (size_t)layer_wqkv_row(L) * DM * (QDT ? 1 : 2);
    unsigned char* din = MOE ? F.ws + WS_WMOE : F.ws + WS_WDENSE + (L >> 1) * WDENSE_SLOT;
    unsigned char* dout = MOE ? F.ws + WS_WMOE + WMOE_IN_BYTES : din + (size_t)2 * DFF * DM * 2;
    constexpr int NEX = MOE ? NEXP : 1;
    constexpr size_t EB_IN = (size_t)2 * DFF * DM * (IDT ? 1 : 2), EB_OUT = (size_t)DM * DFF * (OUT8 ? 1 : 2);
    float* swin = MOE ? (float*)(F.ws + WS_SWM) : (float*)(F.ws + WS_SWD) + (L >> 1) * 2 * DFF;
    constexpr int B_Q = QDT == 2 ? NQ / 32 : 0, B_I = IDT == 2 ? NEX * (2 * DFF / 32) : 0;
    for (int g = b0 + bi; g < (b1 < B_Q + B_I ? b1 : B_Q + B_I); g += nb) {
        if (g < B_Q) conv_block_i8(F, wq, NQ, dq, MTQ, (float*)(F.ws + WS_SWQKV) + layer_wqkv_row(L), g);
        else { const int r = g - B_Q, e = r / (2 * DFF / 32), rr = r % (2 * DFF / 32); conv_block_i8(F, win + (size_t)e * DM * 2 * DFF, 2 * DFF, din + e * EB_IN, 3, swin + e * 2 * DFF, rr); }
    }
    LAS float* scr = (LAS float*)(F.lds + F.wave * 16384);
    constexpr int I_Q = QDT == 2 ? 0 : 16 * (NQ / 32), I_O = 16 * 32, I_DI = IDT == 2 ? 0 : 16 * (2 * DFF / 32), I_DO = (DFF / 64) * 32;
    constexpr int NIT = I_Q + I_O + NEX * (I_DI + I_DO);
    for (int g = w0 + bi * 8 + F.wave; g < (w1 < NIT ? w1 : NIT); g += nb * 8) {
        int r = g;
        if (r < I_Q) { if (QDT == 1) conv_item8(wq, DM, NQ, dq, MTQ, WQKV8_SCALE, r, F.lane, scr); else conv_item(wq, DM, NQ, (bf16_t*)dq, MTQ, r, F.lane, scr); continue; } r -= I_Q;
        if (r < I_O) { if (FP8_WO) conv_item8(wo, DM, DM, F.ws + WS_WO + (size_t)L * DM * DM, 0, WO8_SCALE, r, F.lane, scr);
                       else conv_item(wo, DM, DM, (bf16_t*)(F.ws + WS_WO) + (size_t)L * DM * DM, 0, r, F.lane, scr); continue; } r -= I_O;
        if (r < NEX * I_DI) { const int e = r / (I_DI > 0 ? I_DI : 1), rr = r % (I_DI > 0 ? I_DI : 1); const float* we = win + (size_t)e * DM * 2 * DFF;
            if (IDT == 1) conv_item8(we, DM, 2 * DFF, din + e * EB_IN, 3, WIN8_SCALE, rr, F.lane, scr); else conv_item(we, DM, 2 * DFF, (bf16_t*)(din + e * EB_IN), 3, rr, F.lane, scr); continue; } r -= NEX * I_DI;
        { const int e = r / I_DO, rr = r % I_DO; const float* we = wout + (size_t)e * DFF * DM;
            if (OUT8) conv_item8(we, DFF, DM, dout + e * EB_OUT, 0, WOUT8_SCALE, rr, F.lane, scr); else conv_item(we, DFF, DM, (bf16_t*)(dout + e * EB_OUT), 0, rr, F.lane, scr); }
    }
}
template <int LN>
__device__ __forceinline__ void tail_convert(Frame& F, int nunits, int b0 = 0, int b1 = 1 << 30, int w0 = 0, int w1 = 1 << 30) {
    const int rem = nunits % F.G; const int c = (int)blockIdx.x;
    if (rem == 0) conv_layer<LN>(F, c, F.G, b0, b1, w0, w1);
    else if (c >= rem) conv_layer<LN>(F, c - rem, F.G - rem, b0, b1, w0, w1);
}
#ifndef CV1_Q
#define CV1_Q 0
#endif
#ifndef CV1_A
#define CV1_A 370
#endif
#ifndef CV1_D
#define CV1_D 0
#endif
#ifndef CV3_M
#define CV3_M 250
#endif
#ifndef CV3_A
#define CV3_A 250
#endif
#ifndef CV3_B
#define CV3_B 370
#endif
#ifndef CV3_C
#define CV3_C 150
#endif
#ifndef CV3_W
#define CV3_W 0
#endif
constexpr int CVQ1 = 1536 / 32, CVQ3 = 3072 / 32, CVW_O = 512, CVW_HALF = 512 + 4 * 1792, CVW_ALL = 512 + 8 * 1792;
constexpr int CV1_0 = CVQ1 + CV1_Q, CV1_1 = CV1_0 + CV1_A, CV1_2 = CV1_1 + CV1_D;
constexpr int CV3_0 = CVQ3 + CV3_M, CV3_1 = CV3_0 + CV3_A, CV3_2 = CV3_1 + CV3_B, CV3_3 = CV3_2 + CV3_C;

__device__ __forceinline__ void phase_prologue(Frame& F) {
    LAS float* scond = (LAS float*)F.lds;
    LAS float* part = (LAS float*)(F.lds + 17 * 1024 * 4);
    for (int i = F.tid; i < NCOND * DM; i += 512) { const int ci = i >> 10, k = i & 1023; const float v = ci < 16 ? F.a->in[1][ci * DM + k] : F.a->in[3][k];
        scond[i] = v / (1.0f + __expf(-v)); }
    __syncthreads();
    for (int item = blockIdx.x; item < 4 * 96; item += F.G) {
        const int l = item / 96, nc = item % 96;
        const float* wm = F.a->in[layer_base(0)]; if (l == 1) wm = F.a->in[layer_base(1)]; if (l == 2) wm = F.a->in[layer_base(2)]; if (l == 3) wm = F.a->in[layer_base(3)];
        const float* bm = F.a->in[layer_base(0) + 1]; if (l == 1) bm = F.a->in[layer_base(1) + 1]; if (l == 2) bm = F.a->in[layer_base(2) + 1]; if (l == 3) bm = F.a->in[layer_base(3) + 1];
        f32x4 acc[NCOND];
#pragma unroll
        for (int ci = 0; ci < NCOND; ++ci) acc[ci] = (f32x4){0.f, 0.f, 0.f, 0.f};
        const int kq = F.lane >> 4, cq = F.lane & 15;
        const float* wp = wm + (size_t)(128 * F.wave + kq) * MODW + 64 * nc + 4 * cq;
        for (int i0 = 0; i0 < 32; i0 += 8) { f32x4 wv[8];
#pragma unroll
            for (int j = 0; j < 8; ++j) wv[j] = __builtin_nontemporal_load((const f32x4*)(wp + (size_t)(4 * (i0 + j)) * MODW));
#pragma unroll
            for (int j = 0; j < 8; ++j) { const LAS float* sc = scond + 128 * F.wave + 4 * (i0 + j) + kq;
#pragma unroll
                for (int ci = 0; ci < NCOND; ++ci) acc[ci] += wv[j] * sc[ci * DM];
                __builtin_amdgcn_sched_barrier(0); } }
#pragma unroll
        for (int ci = 0; ci < NCOND; ++ci)
#pragma unroll
            for (int c = 0; c < 4; ++c) { float v = acc[ci][c]; v += __shfl_xor(v, 16); v += __shfl_xor(v, 32); acc[ci][c] = v; }
        if (kq == 0) {
#pragma unroll
            for (int ci = 0; ci < NCOND; ++ci) *(LAS f32x4*)(part + (F.wave * NCOND + ci) * 64 + 4 * cq) = acc[ci]; }
        __syncthreads();
        for (int i = F.tid; i < NCOND * 64; i += 512) { const int ci = i >> 6, n = i & 63; float s = 0.f;
#pragma unroll
            for (int w = 0; w < 8; ++w) s += part[(w * NCOND + ci) * 64 + n];
            ((float*)(F.ws + WS_MOD))[(size_t)(l * NCOND + ci) * MODW + 64 * nc + n] = s + bm[64 * nc + n]; }
        __syncthreads();
    }
    { float* rt = (float*)(F.ws + WS_ROPE); const int gt = blockIdx.x * 512 + F.tid;
      if (gt < 65 * 16) { const int pos = gt >> 4, f = gt & 15; const float ang = (float)pos * powf(10000.0f, -(float)f / 16.0f); rt[gt] = pos < 64 ? cosf(ang) : 1.0f; rt[1040 + gt] = pos < 64 ? sinf(ang) : 0.0f; }
      else if (gt < 65 * 16 + 65 * 32) { const int g2 = gt - 1040, pos = g2 >> 5, f = g2 & 31; const float ang = (float)pos * powf(10000.0f, -(float)f / 32.0f); rt[2080 + g2] = pos < 64 ? cosf(ang) : 1.0f; rt[4160 + g2] = pos < 64 ? sinf(ang) : 0.0f; } }
    __syncthreads();
    conv_layer<0>(F, F.vcu, F.G);
}

__device__ __forceinline__ void reduce8(float (&lg)[8], int lane) {
    const bool o1 = lane & 1; float a[4];
#pragma unroll
    for (int i = 0; i < 4; ++i) { const float mine = o1 ? lg[4 + i] : lg[i], give = o1 ? lg[i] : lg[4 + i]; a[i] = mine + __shfl_xor(give, 1); }
    const bool o2 = lane & 2; float b2[2];
#pragma unroll
    for (int i = 0; i < 2; ++i) { const float mine = o2 ? a[2 + i] : a[i], give = o2 ? a[i] : a[2 + i]; b2[i] = mine + __shfl_xor(give, 2); }
    const bool o4 = lane & 4; float c1;
    { const float mine = o4 ? b2[1] : b2[0], give = o4 ? b2[0] : b2[1]; c1 = mine + __shfl_xor(give, 4); }
    c1 += __shfl_xor(c1, 8); c1 += __shfl_xor(c1, 16); c1 += __shfl_xor(c1, 32);
#pragma unroll
    for (int e = 0; e < 8; ++e) { const int src = ((e >> 2) & 1) | (((e >> 1) & 1) << 1) | ((e & 1) << 2); lg[e] = __shfl(c1, src); }
}
template <bool COMBINE, bool ROUTE, int OUTF, bool XIN32>
__device__ __forceinline__ void phase_norm(Frame& F, const float* g2prev, const float* gain, const float* modl, int psh, int psc, int nrows,
                                           const float* wrt, const float* brt, int moe_slot) {
    bf16_t* H = (bf16_t*)(F.ws + WS_H); const bf16_t* slots = (const bf16_t*)(F.ws + WS_SLOTS);
    LAS float* wr_l = (LAS float*)F.lds;
    LAS int* lcnt = (LAS int*)(F.lds + 32768);
    LAS int* ent_i = (LAS int*)(F.lds + 32768 + 64);
    LAS float* ent_w = (LAS float*)(F.lds + 32768 + 64 + 8 * 24 * 16);
    if (ROUTE) {
        for (int t = F.tid; t < DM * 8 / 4; t += 512) { const int d = t >> 1, half = t & 1, ln = (d & 255) >> 2, ii = d & 3, jj = d >> 8; ((LAS f32x4*)wr_l)[half * 1024 + (jj * 4 + ii) * 64 + ln] = ((const f32x4*)wrt)[t]; }
        if (F.tid < 16) lcnt[F.tid] = 0;
        __syncthreads();
    }
    const int rpw = nrows / F.NGW;
    const int row_b = F.gw * rpw;
    int ci_cur = -1; f32x4 ma[4], mb[4], mg[4];
#pragma unroll
    for (int j = 0; j < 4; ++j) { ma[j] = (f32x4){0.f, 0.f, 0.f, 0.f}; mb[j] = ma[j]; mg[j] = ma[j]; }
    f32x4 vnxA[2][4], vnxB[2][4]; u32x2 vnhA[2][4], vnhB[2][4]; u32x2 nsA[2][2][4], nsB[2][2][4];
    const float* xl32 = F.a->in[0]; const float* xc32 = F.a->in[2];
#define NORM_LOAD(NX, NH, NS, R0) do { _Pragma("unroll") for (int q = 0; q < 2; ++q) { const int _row = (R0) + q; const bool _lat = _row < TL; const size_t _ro = _lat ? (size_t)_row * DM : (size_t)(_row - TL) * DM; \
        if (XIN32) { const float* _x = (_lat ? xl32 : xc32) + _ro; _Pragma("unroll") for (int j = 0; j < 4; ++j) NX[q][j] = __builtin_nontemporal_load((const f32x4*)(_x + 4 * F.lane + 256 * j)); } \
        else { const bf16_t* _x = (_lat ? F.xl16 : F.xc16) + _ro; _Pragma("unroll") for (int j = 0; j < 4; ++j) NH[q][j] = *(const u32x2*)(_x + 4 * F.lane + 256 * j); } \
        if (COMBINE) { _Pragma("unroll") for (int k = 0; k < 2; ++k) _Pragma("unroll") for (int j = 0; j < 4; ++j) NS[q][k][j] = __builtin_nontemporal_load((const u32x2*)(slots + (size_t)(2 * _row + k) * DM + 4 * F.lane + 256 * j)); } } } while (0)
    auto pair = [&](f32x4 (&NX)[2][4], u32x2 (&NH)[2][4], u32x2 (&NS)[2][2][4], const int it, const int nxt) __attribute__((always_inline)) {
        const int row0 = row_b + it;
        f32x4 v[2][4]; u32x2 sl[2][2][4];
        bool lat[2]; size_t ro[2];
#pragma unroll
        for (int q = 0; q < 2; ++q) { const int row = row0 + q; lat[q] = row < TL; ro[q] = lat[q] ? (size_t)row * DM : (size_t)(row - TL) * DM;
#pragma unroll
            for (int j = 0; j < 4; ++j) { if (XIN32) v[q][j] = NX[q][j]; else v[q][j] = (f32x4){bf_lo(NH[q][j].x), bf_hi(NH[q][j].x), bf_lo(NH[q][j].y), bf_hi(NH[q][j].y)};
                if (COMBINE) { sl[q][0][j] = NS[q][0][j]; sl[q][1][j] = NS[q][1][j]; } } }
        if (nxt < rpw) NORM_LOAD(NX, NH, NS, row_b + nxt);
#pragma unroll
        for (int q = 0; q < 2; ++q) {
            const int row = row0 + q; const int ci = lat[q] ? (row >> 11) : 16;
            if (ci != ci_cur) { ci_cur = ci;
                if (gain != nullptr) { const float* mp = modl + (size_t)ci * MODW;
#pragma unroll
                    for (int j = 0; j < 4; ++j) { const int c0 = 4 * F.lane + 256 * j; const f32x4 gn = *(const f32x4*)(gain + c0), sc = *(const f32x4*)(mp + psc * DM + c0); ma[j] = gn * (1.0f + sc); mb[j] = *(const f32x4*)(mp + psh * DM + c0); } }
                if (COMBINE) {
#pragma unroll
                    for (int j = 0; j < 4; ++j) mg[j] = *(const f32x4*)(g2prev + (size_t)ci * MODW + 4 * F.lane + 256 * j); } }
            if (COMBINE) {
#pragma unroll
                for (int j = 0; j < 4; ++j) { const u32x2 s0 = sl[q][0][j], s1 = sl[q][1][j];
                    f32x4 sv; sv[0] = bf_lo(s0.x) + bf_lo(s1.x); sv[1] = bf_hi(s0.x) + bf_hi(s1.x); sv[2] = bf_lo(s0.y) + bf_lo(s1.y); sv[3] = bf_hi(s0.y) + bf_hi(s1.y);
                    v[q][j] = v[q][j] + mg[j] * sv;
                    if (gain == nullptr) __builtin_nontemporal_store(v[q][j], (f32x4*)(F.out + ro[q] + 4 * F.lane + 256 * j));
                    else { u32x2 o; o.x = cvtpk(v[q][j][0], v[q][j][1]); o.y = cvtpk(v[q][j][2], v[q][j][3]); st8((lat[q] ? F.xl16 : F.xc16) + ro[q] + 4 * F.lane + 256 * j, o); } }
            }
            if (gain == nullptr) continue;
            float ss = 0.f;
#pragma unroll
            for (int j = 0; j < 4; ++j) ss += (v[q][j][0] * v[q][j][0] + v[q][j][1] * v[q][j][1]) + (v[q][j][2] * v[q][j][2] + v[q][j][3] * v[q][j][3]);
            const float rstd = __builtin_amdgcn_rsqf(wave_sum(ss) * (1.0f / DM) + NORM_EPS);
#pragma unroll
            for (int j = 0; j < 4; ++j) v[q][j] = (v[q][j] * rstd) * ma[j] + mb[j];
            if (OUTF == 2) {
                float am = 0.f;
#pragma unroll
                for (int j = 0; j < 4; ++j) am = fmaxf(fmaxf(am, fmaxf(fabsf(v[q][j][0]), fabsf(v[q][j][1]))), fmaxf(fabsf(v[q][j][2]), fabsf(v[q][j][3])));
#pragma unroll
                for (int o = 1; o < 64; o <<= 1) am = fmaxf(am, __shfl_xor(am, o));
                const float inv = am > 0.f ? 127.0f / am : 0.f;
                if (F.lane == 0) ((float*)(F.ws + WS_SA))[row] = am > 0.f ? am * (1.0f / 127.0f) : 1.0f;
#pragma unroll
                for (int j = 0; j < 4; ++j) st4((unsigned char*)H + (size_t)row * DM + 4 * F.lane + 256 * j, pk4_i8(v[q][j][0] * inv, v[q][j][1] * inv, v[q][j][2] * inv, v[q][j][3] * inv));
            } else {
#pragma unroll
            for (int j = 0; j < 4; ++j) { const int c0 = 4 * F.lane + 256 * j;
                if (OUTF == 1) st4((unsigned char*)H + (size_t)row * DM + c0, pk4_fp8(v[q][j][0] * H8_SCALE, v[q][j][1] * H8_SCALE, v[q][j][2] * H8_SCALE, v[q][j][3] * H8_SCALE));
                else { u32x2 o; o.x = cvtpk(v[q][j][0], v[q][j][1]); o.y = cvtpk(v[q][j][2], v[q][j][3]); st8(H + (size_t)row * DM + c0, o); } } }
            if (ROUTE) {
                float lg[8];
#pragma unroll
                for (int e = 0; e < 8; ++e) lg[e] = 0.f;
#pragma unroll
                for (int j = 0; j < 4; ++j) { f32x4 rw[4][2];
#pragma unroll
                    for (int i = 0; i < 4; ++i) { rw[i][0] = ((const LAS f32x4*)wr_l)[(j * 4 + i) * 64 + F.lane]; rw[i][1] = ((const LAS f32x4*)wr_l)[1024 + (j * 4 + i) * 64 + F.lane]; }
                    __builtin_amdgcn_sched_barrier(0);
#pragma unroll
                    for (int i = 0; i < 4; ++i) { const f32x4 w0 = rw[i][0], w1 = rw[i][1]; const float hv = v[q][j][i];
                        lg[0] += hv * w0[0]; lg[1] += hv * w0[1]; lg[2] += hv * w0[2]; lg[3] += hv * w0[3]; lg[4] += hv * w1[0]; lg[5] += hv * w1[1]; lg[6] += hv * w1[2]; lg[7] += hv * w1[3]; }
                    __builtin_amdgcn_sched_barrier(0); }
                reduce8(lg, F.lane);
#pragma unroll
                for (int e = 0; e < 8; ++e) lg[e] += brt[e];
                int e0 = 0; float v0 = lg[0];
#pragma unroll
                for (int e = 1; e < 8; ++e) if (lg[e] > v0) { v0 = lg[e]; e0 = e; }
                int e1 = -1; float v1 = -INFINITY;
#pragma unroll
                for (int e = 0; e < 8; ++e) if (e != e0 && lg[e] > v1) { v1 = lg[e]; e1 = e; }
                if (e1 < 0) { e1 = (e0 + 1) & 7; v1 = v0; }
                const float w0 = 1.0f / (1.0f + __expf(v1 - v0)), w1 = 1.0f - w0;
                if (F.lane == 0) { const int p0 = atomicAdd((int*)&lcnt[e0], 1), p1 = atomicAdd((int*)&lcnt[e1], 1);
                    LAS int* ei = ent_i + (F.wave * 24 + it + q) * 4; ei[0] = e0; ei[1] = e1; ei[2] = p0; ei[3] = p1;
                    LAS float* ew = ent_w + (F.wave * 24 + it + q) * 2; ew[0] = w0; ew[1] = w1; }
            }
        }
    };
    NORM_LOAD(vnxA, vnhA, nsA, row_b);
    if (rpw > 2) NORM_LOAD(vnxB, vnhB, nsB, row_b + 2);
    for (int it = 0; it < rpw; it += 4) {
        pair(vnxA, vnhA, nsA, it, it + 4);
        if (it + 2 < rpw) pair(vnxB, vnhB, nsB, it + 2, it + 6);
    }
#undef NORM_LOAD
    if (ROUTE) {
        __syncthreads();
        unsigned* gcnt = (unsigned*)(F.ws + WS_CTL) + CW_MOECNT + moe_slot * 64;
        if (F.tid < 8) lcnt[8 + F.tid] = (int)__hip_atomic_fetch_add(gcnt + F.tid, (unsigned)lcnt[F.tid], __ATOMIC_RELAXED, __HIP_MEMORY_SCOPE_AGENT);
        __syncthreads();
        int* listTok = (int*)(F.ws + WS_LIST); float* listW = (float*)(F.ws + WS_LIST + (size_t)NEXP * TT * 4);
        for (int i = F.tid; i < 8 * 24 * 2; i += 512) { const int w = i / 48, r = (i % 48) >> 1, k = i & 1; const int row = (F.vcu * 8 + w) * rpw + r;
            if (r < rpw) { const int e = ent_i[(w * 24 + r) * 4 + k], p = ent_i[(w * 24 + r) * 4 + 2 + k] + lcnt[8 + e];
                listTok[e * TT + p] = row * 2 + k; listW[e * TT + p] = ent_w[(w * 24 + r) * 2 + k]; } }
    }
}

template <int MIXER, bool LAST>
__device__ __forceinline__ void phase_attention(Frame& F, const float* mparam) {
    constexpr int DH = MIXER == 2 ? 128 : 64, NQH = MIXER == 2 ? 8 : 16, NKV = MIXER == 0 ? 16 : 4, GQ = NQH / NKV, LDK = NKV * DH;
    const bf16_t* Q = (const bf16_t*)(F.ws + WS_Q); const bf16_t* K = (const bf16_t*)(F.ws + WS_K); const bf16_t* V = (const bf16_t*)(F.ws + WS_V); bf16_t* Y = (bf16_t*)(F.ws + WS_H);
    constexpr int UL = NB * NQH * 8;
    for (int ui = F.vcu; ui < UL; ui += F.G) {
        const int qblk = (ui + ui / F.G) & 7, h = (ui >> 3) % NQH, b = ui / (8 * NQH);
        att::AUnit u; u.qrow0 = b * SEQ + 256 * qblk; u.qcol = h * DH; u.kvcol = (h / GQ) * DH; u.kctx0 = TL + b * CTXL;
        if (MIXER == 0) { int lo = 4 * qblk - 4; lo = lo < 0 ? 0 : lo; int hi = 4 * qblk + 3 - 4; hi = hi < 0 ? 0 : (hi > 24 ? 24 : hi); hi += 8; if (lo > 24) lo = 24;
            u.klat0 = b * SEQ + 64 * lo; u.nlat = hi - lo; u.a0 = qblk; u.a1 = lo;
            att::attn_unit<64, 1, FP8_WO != 0>(F.lds, F.tid, Q, K, V, Y, LDK, u, mparam + h * 465, 0.f, false); }
        else if (MIXER == 1) { int tlo = 4 * qblk - 2; tlo = tlo < 0 ? 0 : tlo; int thi = 4 * qblk + 6; thi = thi > 32 ? 32 : thi;
            u.klat0 = b * SEQ + 64 * tlo; u.nlat = thi - tlo; u.a0 = 256 * qblk; u.a1 = 64 * tlo;
            att::attn_unit<64, 2, FP8_WO != 0>(F.lds, F.tid, Q, K, V, Y, LDK, u, nullptr, mparam[h] * LOG2E, true); }
        else { u.klat0 = b * SEQ; u.nlat = 32; u.a0 = 0; u.a1 = 0;
            att::attn_unit<128, 0, FP8_WO != 0>(F.lds, F.tid, Q, K, V, Y, LDK, u, nullptr, 0.f, false); }
    }
    if (!LAST) {
        constexpr int UC = NB * NQH;
        for (int ui = F.vcu; ui < UC; ui += F.G) {
            const int h = ui % NQH, b = ui / NQH;
            att::AUnit u; u.qrow0 = TL + b * CTXL; u.qcol = h * DH; u.kvcol = (h / GQ) * DH; u.kctx0 = TL + b * CTXL; u.klat0 = 0; u.nlat = 0; u.a0 = 0; u.a1 = 0;
            if (MIXER == 1) att::attn_unit<64, 0, FP8_WO != 0>(F.lds, F.tid, Q, K, V, Y, LDK, u, nullptr, mparam[h] * LOG2E, true);
            else if (MIXER == 0) att::attn_unit<64, 0, FP8_WO != 0>(F.lds, F.tid, Q, K, V, Y, LDK, u, nullptr, 0.f, false);
            else att::attn_unit<128, 0, FP8_WO != 0>(F.lds, F.tid, Q, K, V, Y, LDK, u, nullptr, 0.f, false);
        }
    }
}

__device__ __forceinline__ int moe_table(Frame& F, int moe_slot) {
    LAS int* mt = (LAS int*)(F.lds + MOE_OFF);
    unsigned* gcnt = (unsigned*)(F.ws + WS_CTL) + CW_MOECNT + moe_slot * 64;
    __syncthreads();
    if (F.tid == 0) { int tb = 0;
        for (int e = 0; e < 8; ++e) { const int c = (int)__hip_atomic_load(gcnt + e, __ATOMIC_RELAXED, __HIP_MEMORY_SCOPE_AGENT); mt[e] = c; mt[8 + e] = tb; tb += (c + 255) >> 8; }
        mt[16] = tb; }
    __syncthreads();
    return mt[16];
}

#define IN_(k) (lo <= (k) && (k) < hi)
#define REFRESH_() do { F.lane = lane_now(); F.tid = F.wave * 64 + F.lane; } while (0)
#define SEAM_(k) do { if (IN_(k) && IN_((k) + 1)) xcd_barrier(bar); } while (0)
template <int L>
__device__ __forceinline__ void run_layer(Frame& F, const XcdBarrier& bar, int lo, int hi) {
    constexpr int LB = layer_base(L), MIX = layer_mixer(L); constexpr bool MOE = layer_moe(L), LAST = (L == 3), PREV_MOE = (L > 0) && layer_moe(L - 1);
    constexpr int P = 1 + 7 * L;
    constexpr int NROWS = LAST ? TL : TT;
    constexpr int QDT = qkv_dt(), IDT = ffn_in_dt(L); constexpr bool OUT8 = ffn_out8(L);
    const float* modl = F.mod + (size_t)L * NCOND * MODW;
    bf16_t* H = (bf16_t*)(F.ws + WS_H);
    const float* SA = (const float*)(F.ws + WS_SA);
    if (IN_(P + 0)) { REFRESH_();
        phase_norm<PREV_MOE, false, QDT, L == 0>(F, F.mod + (size_t)(L > 0 ? L - 1 : 0) * NCOND * MODW + 5 * DM, F.a->in[LB + 2], modl, 0, 1, TT, nullptr, nullptr, 0);
    }
    SEAM_(P + 0);
    if (IN_(P + 1)) { REFRESH_();
        pg8::Gemm g{H, F.ws + WS_WQKV + (size_t)layer_wqkv_row(L) * DM * (QDT ? 1 : 2), QDT ? DM : 2 * DM, E8_2M6, E8_2M6, E8_2M2};
        pg8::Order<0> S; S.init(TT / 256, layer_nqkv(L) / 256, F.G, (int)blockIdx.x);
        const float* rt = (const float*)(F.ws + WS_ROPE); const float* swq = (const float*)(F.ws + WS_SWQKV) + layer_wqkv_row(L);
        if (MIX == 2) { pg8::EpiQKV128<QDT == 2> E{(bf16_t*)(F.ws + WS_Q), (bf16_t*)(F.ws + WS_K), (bf16_t*)(F.ws + WS_V), F.a->in[LB + 5], F.a->in[LB + 6], rt + 2080, rt + 4160, (LAS float*)(F.lds + XL_OFF), 1.0f, SA, swq};
            pg8::gemm_phase<QDT>(F.lds, F.tid, g, S, E); }
        else { pg8::EpiQKV64<QDT == 2> E{(bf16_t*)(F.ws + WS_Q), (bf16_t*)(F.ws + WS_K), (bf16_t*)(F.ws + WS_V), MIX == 0 ? 4 : 1, MIX == 0 ? 1024 : 256, F.a->in[LB + 5], F.a->in[LB + 6], rt, rt + 1040, MIX == 1, 1.0f, SA, swq};
            pg8::gemm_phase<QDT>(F.lds, F.tid, g, S, E); }
        if (L == 0) { REFRESH_(); tail_convert<1>(F, (TT / 256) * (layer_nqkv(L) / 256), 0, CV1_0, 0, 0); }
        if (L == 1) { REFRESH_(); tail_convert<1>(F, (TT / 256) * (layer_nqkv(L) / 256), 0, 0, CVW_O, CVW_HALF); }
        if (L == 2) { REFRESH_(); tail_convert<3>(F, (TT / 256) * (layer_nqkv(L) / 256), CV3_0, CV3_1, 0, 0); }
        if (L == 3) { REFRESH_(); tail_convert<3>(F, (TT / 256) * (layer_nqkv(L) / 256), 0, 0, CVW_ALL - CV3_W, CVW_ALL); }
    }
    SEAM_(P + 1);
    if (IN_(P + 2)) { REFRESH_(); phase_attention<MIX, LAST>(F, MIX == 2 ? nullptr : F.a->in[LB + 7]); }
    SEAM_(P + 2);
    if (IN_(P + 3)) { REFRESH_();
        pg8::Gemm g{F.ws + WS_H, F.ws + WS_WO + (size_t)L * DM * DM * (FP8_WO ? 1 : 2), FP8_WO ? DM : 2 * DM, E8_2M6, E8_2M6, E8_2M6};
        pg8::Order<0> S; S.init(NROWS / 256, 4, F.G, (int)blockIdx.x);
        pg8::EpiResid<L == 0> E{L == 0 ? (const void*)F.a->in[0] : (const void*)F.xl16, L == 0 ? (const void*)F.a->in[2] : (const void*)F.xc16, F.xl16, F.xc16, modl + 2 * DM, 1.0f};
        pg8::gemm_phase<FP8_WO ? 1 : 0>(F.lds, F.tid, g, S, E);
        if (L == 0) { REFRESH_(); tail_convert<1>(F, (NROWS / 256) * 4, CV1_0, CV1_1, 0, 0); }
        if (L == 1) { REFRESH_(); tail_convert<1>(F, (NROWS / 256) * 4, 0, 0, CVW_HALF, 1 << 30); }
        if (L == 2) { REFRESH_(); tail_convert<3>(F, (NROWS / 256) * 4, CV3_1, CV3_2, 0, 0); }
    }
    SEAM_(P + 3);
    if (IN_(P + 4)) { REFRESH_();
        if (MOE) phase_norm<false, true, IDT, false>(F, nullptr, F.a->in[LB + 3], modl, 3, 4, NROWS, F.a->in[layer_ffn_idx(L)], F.a->in[layer_ffn_idx(L) + 1], L >> 1);
        else phase_norm<false, false, IDT, false>(F, nullptr, F.a->in[LB + 3], modl, 3, 4, NROWS, nullptr, nullptr, 0);
    }
    SEAM_(P + 4);
    if (IN_(P + 5)) { REFRESH_();
        constexpr bool UPX8 = (IDT != 1 && OUT8);
        if (MOE) { const int ntile = moe_table(F, L >> 1);
            pg8::EpiSwiGLU<OUT8, IDT == 2, true, UPX8> E{F.ws + WS_ACT, SA, (const float*)(F.ws + WS_SWM), (const int*)(F.ws + WS_LIST), (const LAS int*)(F.lds + MOE_OFF), TT};
            pg8::Gemm g{H, F.ws + WS_WMOE, IDT ? DM : 2 * DM, E8_2M6, OUT8 ? E8_2M3 : E8_2M6, E8_2M2};
            pg8::Order<1> S; S.init(ntile, 2 * DFF / 256, F.G, (int)blockIdx.x); S.moe = (const LAS int*)(F.lds + MOE_OFF); S.listTok = (const int*)(F.ws + WS_LIST); S.cap = TT;
            pg8::gemm_phase<IDT>(F.lds, F.tid, g, S, E); }
        else { pg8::EpiSwiGLU<OUT8, IDT == 2, false, UPX8> E{F.ws + WS_ACT, SA, (const float*)(F.ws + WS_SWD) + (L >> 1) * 2 * DFF, nullptr, nullptr, 0};
            pg8::Gemm g{H, F.ws + WS_WDENSE + (L >> 1) * WDENSE_SLOT, IDT ? DM : 2 * DM, E8_2M6, OUT8 ? E8_2M3 : E8_2M6, E8_2M2};
            pg8::Order<0> S; S.init(NROWS / 256, 2 * DFF / 256, F.G, (int)blockIdx.x);
            pg8::gemm_phase<IDT>(F.lds, F.tid, g, S, E);
            if (L == 0) { REFRESH_(); tail_convert<1>(F, (NROWS / 256) * (2 * DFF / 256), CV1_1, CV1_2, 0, 0); }
            if (L == 2) { REFRESH_(); tail_convert<3>(F, (NROWS / 256) * (2 * DFF / 256), CV3_2, CV3_3, 0, 0); } }
    }
    SEAM_(P + 5);
    if (IN_(P + 6)) { REFRESH_();
        if (MOE) { const int ntile = moe_table(F, L >> 1);
            pg8::Gemm g{F.ws + WS_ACT, F.ws + WS_WMOE + WMOE_IN_BYTES, OUT8 ? DFF : 2 * DFF, E8_2M7, E8_2M7, E8_2M3};
            pg8::Order<2> S; S.init(ntile, 4, F.G, (int)blockIdx.x); S.moe = (const LAS int*)(F.lds + MOE_OFF); S.listTok = nullptr; S.cap = TT;
            pg8::EpiMoeOut E{(bf16_t*)(F.ws + WS_SLOTS), (const int*)(F.ws + WS_LIST), (const float*)(F.ws + WS_LIST + (size_t)NEXP * TT * 4), (const LAS int*)(F.lds + MOE_OFF), TT, 1.0f};
            pg8::gemm_phase<OUT8 ? 1 : 0>(F.lds, F.tid, g, S, E);
            if (L == 1) { REFRESH_(); tail_convert<2>(F, ntile * 4); REFRESH_(); tail_convert<3>(F, ntile * 4, 0, CV3_0, 0, 0); } }
        else { pg8::Gemm g{F.ws + WS_ACT, F.ws + WS_WDENSE + (L >> 1) * WDENSE_SLOT + (size_t)2 * DFF * DM * 2, OUT8 ? DFF : 2 * DFF, E8_2M7, E8_2M7, E8_2M3};
            pg8::Order<0> S; S.init(NROWS / 256, 4, F.G, (int)blockIdx.x);
            pg8::EpiResid<false> E{F.xl16, F.xc16, F.xl16, F.xc16, modl + 5 * DM, 1.0f};
            pg8::gemm_phase<OUT8 ? 1 : 0>(F.lds, F.tid, g, S, E);
            if (L == 0) { REFRESH_(); tail_convert<1>(F, (NROWS / 256) * 4, CV1_2, 1 << 30, 0, CVW_O); }
            if (L == 2) { REFRESH_(); tail_convert<3>(F, (NROWS / 256) * 4, CV3_3, 1 << 30, 0, CVW_ALL - CV3_W); } }
    }
    SEAM_(P + 6);
}

constexpr int N_PHASES = 30;
__global__ void __launch_bounds__(512, 2) mk_fwd(Args args) {
    extern __shared__ __attribute__((aligned(16))) unsigned char lds_raw[];
    Frame F;
    F.lds = (LAS unsigned char*)lds_raw;
    F.wave = __builtin_amdgcn_readfirstlane((int)threadIdx.x >> 6); F.lane = lane_now(); F.tid = F.wave * 64 + F.lane;
    F.G = gridDim.x; { const int bx = blockIdx.x; F.vcu = (F.G % 8 == 0) ? (bx % 8) * (F.G / 8) + bx / 8 : bx; }
    F.gw = F.vcu * 8 + F.wave; F.NGW = F.G * 8;
    F.a = &args; F.ws = args.ws; F.out = args.out; F.xl16 = (bf16_t*)(args.ws + WS_XBL); F.xc16 = (bf16_t*)(args.ws + WS_XC); F.mod = (const float*)(args.ws + WS_MOD);
    volatile LAS unsigned* MISC = (volatile LAS unsigned*)(F.lds + MISC_OFF);
    for (int u = F.tid; u < (PARK_OFF - MOE_OFF) / 4; u += 512) ((LAS unsigned*)(F.lds + MOE_OFF))[u] = 0u;
    __syncthreads();
    const int lo = args.ph_lo, hi = args.ph_hi;
    XcdBarrier bar; bar.bar = (unsigned*)(F.ws + WS_CTL) + CW_BAR; bar.x = 0; bar.st = nullptr; bar.wave = F.wave;
    if (hi - lo > 1) bar = xcd_barrier_post((unsigned*)(F.ws + WS_CTL) + CW_BAR, MISC + 8, F.wave);

    if (IN_(0)) { REFRESH_(); phase_prologue(F); }
    SEAM_(0);
    run_layer<0>(F, bar, lo, hi);
    run_layer<1>(F, bar, lo, hi);
    run_layer<2>(F, bar, lo, hi);
    run_layer<3>(F, bar, lo, hi);
    if (IN_(29)) { REFRESH_(); phase_norm<true, false, 0, false>(F, F.mod + (size_t)3 * NCOND * MODW + 5 * DM, nullptr, nullptr, 0, 0, TL, nullptr, nullptr, 0); }
}

extern "C" void kernel_launch(void* const* d_in, const int* in_sizes, int n_in, void* d_out, int out_size, void* d_ws, size_t ws_size, hipStream_t stream) {
    static int grid = 0;
    if (grid == 0) {
        if (n_in != N_IN || out_size != TL * DM || ws_size < WS_END) { fprintf(stderr, "kernel_launch: unexpected shapes: n_in %d out %d ws %zu (need %zu)\n", n_in, out_size, ws_size, (size_t)WS_END); grid = -1; return; }
        int dev = 0, cus = 0, per_cu = 0;
        if (hipGetDevice(&dev) != hipSuccess || hipDeviceGetAttribute(&cus, hipDeviceAttributeMultiprocessorCount, dev) != hipSuccess) { grid = -1; return; }
        if (hipFuncSetAttribute((const void*)mk_fwd, hipFuncAttributeMaxDynamicSharedMemorySize, LDS_BYTES) != hipSuccess) { fprintf(stderr, "kernel_launch: hipFuncSetAttribute failed\n"); grid = -1; return; }
        if (hipOccupancyMaxActiveBlocksPerMultiprocessor(&per_cu, (const void*)mk_fwd, 512, LDS_BYTES) != hipSuccess || per_cu < 1) fprintf(stderr, "kernel_launch: occupancy query says %d\n", per_cu);
        (void)hipGetLastError();
        grid = cus;
        if (grid != 256) fprintf(stderr, "kernel_launch: built for 256 CUs, device has %d\n", cus);
    }
    if (grid < 0) return;
    (void)hipMemsetAsync((char*)d_ws + WS_CTL, 0, CTL_ZERO_BYTES, stream);
    Args a{};
    for (int i = 0; i < N_IN; ++i) a.in[i] = (const float*)d_in[i];
    a.out = (float*)d_out; a.ws = (unsigned char*)d_ws;
#if MK_PER_PHASE
    for (int p = 0; p < N_PHASES; ++p) { a.ph_lo = p; a.ph_hi = p + 1; hipLaunchKernelGGL(mk_fwd, dim3(grid), dim3(512), LDS_BYTES, stream, a); }
#else
    a.ph_lo = 0; a.ph_hi = N_PHASES;
    hipLaunchKernelGGL(mk_fwd, dim3(grid), dim3(512), LDS_BYTES, stream, a);
#endif
}
```

```cpp
#include <hip/hip_runtime.h>
#include <cstdio>
#include <cstdint>

#ifndef MK_PER_PHASE
#define MK_PER_PHASE 0
#endif

#define LAS __attribute__((address_space(3)))
#define GAS __attribute__((address_space(1)))
typedef unsigned short bf16_t;
typedef short bf16x8 __attribute__((ext_vector_type(8)));
typedef short s16x4 __attribute__((ext_vector_type(4)));
typedef float f32x4 __attribute__((ext_vector_type(4)));
typedef float f32x2 __attribute__((ext_vector_type(2)));
typedef float f32x16 __attribute__((ext_vector_type(16)));
typedef unsigned u32x4 __attribute__((ext_vector_type(4)));
typedef unsigned u32x2 __attribute__((ext_vector_type(2)));
typedef __bf16 bf16x2_t __attribute__((ext_vector_type(2)));
typedef GAS unsigned gu32;

__device__ __forceinline__ int lane_now0() { int l; asm volatile("v_mbcnt_lo_u32_b32 %0, -1, 0\n\tv_mbcnt_hi_u32_b32 %0, -1, %0" : "=v"(l)); return l; }
#ifndef WT_STORES
#define WT_STORES 0
#endif
__device__ __forceinline__ void st16(void* p, u32x4 v) { if (WT_STORES) asm volatile("global_store_dwordx4 %0, %1, off sc1\n\ts_nop 1" :: "v"(p), "v"(v) : "memory"); else *(u32x4*)p = v; }
__device__ __forceinline__ void st8(void* p, u32x2 v) { if (WT_STORES) asm volatile("global_store_dwordx2 %0, %1, off sc1" :: "v"(p), "v"(v) : "memory"); else *(u32x2*)p = v; }
__device__ __forceinline__ void st4(void* p, unsigned v) { if (WT_STORES) asm volatile("global_store_dword %0, %1, off sc1" :: "v"(p), "v"(v) : "memory"); else *(unsigned*)p = v; }
__device__ __forceinline__ void st16f(void* p, f32x4 v) { st16(p, __builtin_bit_cast(u32x4, v)); }
__device__ __forceinline__ unsigned cvtpk(float lo, float hi) { f32x2 v = {lo, hi}; bf16x2_t b = __builtin_convertvector(v, bf16x2_t); return __builtin_bit_cast(unsigned, b); }
__device__ __forceinline__ unsigned pk4_fp8(float a, float b, float c, float d) {
    a = __builtin_amdgcn_fmed3f(a, -448.f, 448.f); b = __builtin_amdgcn_fmed3f(b, -448.f, 448.f); c = __builtin_amdgcn_fmed3f(c, -448.f, 448.f); d = __builtin_amdgcn_fmed3f(d, -448.f, 448.f);
    int w = 0; w = __builtin_amdgcn_cvt_pk_fp8_f32(a, b, w, false); w = __builtin_amdgcn_cvt_pk_fp8_f32(c, d, w, true); return (unsigned)w; }
__device__ __forceinline__ float bf_lo(unsigned w) { return __builtin_bit_cast(float, w << 16); }
__device__ __forceinline__ float bf_hi(unsigned w) { return __builtin_bit_cast(float, w & 0xffff0000u); }

constexpr int NB = 16, SEQ = 2048, DM = 1024, CTXL = 256;
constexpr int TL = NB * SEQ, TC = NB * CTXL, TT = TL + TC;
constexpr int DFF = 3584, NEXP = 8, MODW = 6 * DM, NCOND = 17;
constexpr float NORM_EPS = 1e-6f;
constexpr float LOG2E = 1.4426950408889634f, LN2 = 0.6931471805599453f;
#ifndef FP8_MOE_IN
#define FP8_MOE_IN 1
#endif
#ifndef FP8_MOE_OUT
#define FP8_MOE_OUT 1
#endif
#ifndef FP8_QKV
#define FP8_QKV 1
#endif
#ifndef FP8_WO
#define FP8_WO 1
#endif
#ifndef FP8_DENSE_IN
#define FP8_DENSE_IN 0
#endif
#ifndef FP8_DENSE_OUT
#define FP8_DENSE_OUT 1
#endif
#ifndef I8_QKV
#define I8_QKV 1
#endif
#ifndef I8_DENSE_IN
#define I8_DENSE_IN 1
#endif
#ifndef I8_MOE_IN
#define I8_MOE_IN 1
#endif
__host__ __device__ constexpr int qkv_dt() { return I8_QKV ? 2 : (FP8_QKV ? 1 : 0); }
__host__ __device__ constexpr int ffn_in_dt(int L) { return (L & 1) ? (I8_MOE_IN ? 2 : (FP8_MOE_IN ? 1 : 0)) : (I8_DENSE_IN ? 2 : (FP8_DENSE_IN ? 1 : 0)); }
__host__ __device__ constexpr bool ffn_out8(int L) { return (L & 1) ? (FP8_MOE_OUT != 0) : (FP8_DENSE_OUT != 0); }
constexpr float H8_SCALE = 4.0f, WIN8_SCALE = 64.0f, ACT8_SCALE = 8.0f, WOUT8_SCALE = 128.0f;
constexpr float WQKV8_SCALE = 64.0f, Y8_SCALE = 64.0f, WO8_SCALE = 64.0f;
constexpr float QKV_DESCALE = 1.0f / (H8_SCALE * WQKV8_SCALE), WO_DESCALE = 1.0f / (Y8_SCALE * WO8_SCALE);
constexpr int E8_1 = 0x7f7f7f7f, E8_2M2 = 0x7d7d7d7d, E8_2M3 = 0x7c7c7c7c, E8_2M6 = 0x79797979, E8_2M7 = 0x78787878;
constexpr float FFN_IN_DESCALE = 1.0f / (H8_SCALE * WIN8_SCALE), FFN_OUT_DESCALE = 1.0f / (ACT8_SCALE * WOUT8_SCALE);

namespace pg8 {
constexpr int BM = 256, BK = 64, HALF = 128, HTB = HALF * BK * 2, STAGE_BYTES = 8 * HTB, NXCD = 8, WGM = 8;
constexpr int XL_OFF_ = 131072;
constexpr int PARK_OFF_ = 140288;
__host__ __device__ __forceinline__ int lds_byte(int r, int c) { const int st = (r >> 4) * 2 + (c >> 5), rr = r & 15, cc = c & 31, ob = rr * 64 + cc * 2; return st * 1024 + (ob ^ (((ob >> 9) & 1) << 5)); }
__host__ __device__ __forceinline__ void stage_rc(int b, int& R, int& C) { const int st = b / 1024, sb = b % 1024, swz = sb ^ (((sb >> 9) & 1) << 5); R = (st >> 1) * 16 + swz / 64; C = (st & 1) * 32 + (swz % 64) / 2; }

struct Unit { int pm, pn, pb, e, r0; };
struct Gemm { const void* A; const void* Bt; int Kb; int sw0, sw1, sa; };

template <int MODE> struct Order {
    static constexpr bool GATHER = (MODE == 1);
    int nM, nN, nwg, G, c; const LAS int* moe; const int* listTok; int cap;
    __device__ __forceinline__ void init(int nM_, int nN_, int G_, int c_) { nM = nM_; nN = nN_; nwg = nM * nN; G = G_; c = c_; }
    __device__ __forceinline__ bool next(int i, Unit& u) const {
        const long L = (long)i * G + c; if (L >= nwg) return false;
        int wgid = (int)L; { const int q = nwg / NXCD, r = nwg % NXCD, xcd = wgid % NXCD, off = wgid / NXCD; wgid = (xcd < r ? xcd * (q + 1) : r * (q + 1) + (xcd - r) * q) + off; }
        if (MODE == 2) wgid = nwg - 1 - wgid;
        const int nig = WGM * nN, gid = wgid / nig, fm = gid * WGM, gsz = (nM - fm) < WGM ? (nM - fm) : WGM;
        u.pm = fm + ((wgid % nig) % gsz); u.pn = (wgid % nig) / gsz; if (gid & 1) u.pn = nN - 1 - u.pn;
        u.pb = u.pn; u.e = 0; u.r0 = 0;
        if (MODE != 0) { int e = 0;
#pragma unroll
            for (int k = 1; k < 8; ++k) e += (u.pm >= moe[8 + k]) ? 1 : 0;
            e = __builtin_amdgcn_readfirstlane(e);
            u.e = e; u.r0 = __builtin_amdgcn_readfirstlane((u.pm - moe[8 + e]) * 256); u.pb = e * nN + u.pn; }
        return true;
    }
    __device__ __forceinline__ void a_offsets(const Unit& u, int Kb, const int (&R)[2], const int (&C)[2], unsigned (&va)[2][2]) const {
#pragma unroll
        for (int h = 0; h < 2; ++h)
#pragma unroll
            for (int i = 0; i < 2; ++i) {
                int row;
                if (MODE == 1) { const int pos = u.r0 + h * 128 + R[i]; const int idx = pos < moe[u.e] ? pos : 0; row = listTok[u.e * cap + idx] >> 1; }
                else row = u.pm * 256 + h * 128 + R[i];
                va[h][i] = (unsigned)row * (unsigned)Kb + (unsigned)C[i] * 2u;
            }
    }
};

typedef int v8i __attribute__((ext_vector_type(8)));
typedef int v4i_t __attribute__((ext_vector_type(4)));
__device__ __forceinline__ void glds_s(const void* sbase, unsigned voff, unsigned lds_dst) { unsigned keep;
    asm volatile("s_mov_b32 %0, m0\n\ts_mov_b32 m0, %3\n\ts_nop 0\n\tglobal_load_lds_dwordx4 %1, %2\n\ts_mov_b32 m0, %0" : "=&s"(keep) : "v"(voff), "s"(sbase), "s"(lds_dst) : "memory"); }
template <int DT, class Epi, class Sched>
__device__ __forceinline__ void gemm_phase(LAS unsigned char* lds, const int tid, const Gemm g, const Sched& S, const Epi& E) {
    const int wid = __builtin_amdgcn_readfirstlane(tid >> 6), lane = tid & 63, wr = wid >> 2, wc = wid & 3, fr = lane & 15, fq = lane >> 4;
    const int K = g.Kb, nt = K / 128;
    int R[2], C[2]; unsigned voffB[2];
#pragma unroll
    for (int i = 0; i < 2; ++i) { stage_rc(tid * 16 + i * 8192, R[i], C[i]); voffB[i] = (unsigned)(R[i] * K + C[i] * 2); }
    const size_t kstep = 128;
    const size_t hstep = (size_t)HALF * K;
    const size_t tstep = 2 * hstep;
    const unsigned ldsb = (unsigned)(uintptr_t)lds + (unsigned)wid * 1024u;
    const int aoff = lds_byte(wr * 64 + fr, fq * 8), boff = lds_byte(wc * 32 + fr, fq * 8);
#define PG8_SA(b, h) (((b) * 2 + (h)) * HTB)
#define PG8_SB(b, h) ((4 + (b) * 2 + (h)) * HTB)
#ifndef STAGE_BUILTIN_NONFP8
#define STAGE_BUILTIN_NONFP8 1
#endif
#define PG8_STAGE(bufoff, gbase, voff) do { _Pragma("unroll") for (int _i = 0; _i < 2; ++_i) { \
        if constexpr (DT != 1 && STAGE_BUILTIN_NONFP8) __builtin_amdgcn_global_load_lds((const unsigned*)((const char*)(gbase) + (voff)[_i]), (LAS unsigned*)(lds + (bufoff) + wid * 1024 + _i * 8192), 16, 0, 0); \
        else glds_s((const void*)(gbase), (voff)[_i], ldsb + (unsigned)((bufoff) + _i * 8192)); } } while (0)
#define PG8_LDA(dst, b, h) do { _Pragma("unroll") for (int m = 0; m < 4; ++m) _Pragma("unroll") for (int k = 0; k < 2; ++k) dst[m][k] = *(const LAS bf16x8*)(lds + PG8_SA(b, h) + aoff + m * 2048 + k * 1024); } while (0)
#define PG8_LDB(dst, b, h) do { _Pragma("unroll") for (int n = 0; n < 2; ++n) _Pragma("unroll") for (int k = 0; k < 2; ++k) dst[n][k] = *(const LAS bf16x8*)(lds + PG8_SB(b, h) + boff + n * 2048 + k * 1024); } while (0)
#define PG8_CAT(x) __builtin_bit_cast(v8i, __builtin_shufflevector((x)[0], (x)[1], 0, 1, 2, 3, 4, 5, 6, 7, 8, 9, 10, 11, 12, 13, 14, 15))
#define PG8_MMA(ai, bj, At, Bt) do { __builtin_amdgcn_s_setprio(1); _Pragma("unroll") for (int m = 0; m < 4; ++m) _Pragma("unroll") for (int n = 0; n < 2; ++n) { \
        if constexpr (DT == 1) acc[ai][bj][m][n] = __builtin_amdgcn_mfma_scale_f32_16x16x128_f8f6f4(PG8_CAT(Bt[n]), PG8_CAT(At[m]), acc[ai][bj][m][n], 0, 0, 0, (bj) ? g.sw1 : g.sw0, 0, g.sa); \
        else if constexpr (DT == 2) { _Pragma("unroll") for (int k = 0; k < 2; ++k) acc[ai][bj][m][n] = __builtin_bit_cast(f32x4, __builtin_amdgcn_mfma_i32_16x16x64_i8(__builtin_bit_cast(v4i_t, Bt[n][k]), __builtin_bit_cast(v4i_t, At[m][k]), __builtin_bit_cast(v4i_t, acc[ai][bj][m][n]), 0, 0, 0)); } \
        else { _Pragma("unroll") for (int k = 0; k < 2; ++k) acc[ai][bj][m][n] = __builtin_amdgcn_mfma_f32_16x16x32_bf16(Bt[n][k], At[m][k], acc[ai][bj][m][n], 0, 0, 0); } } \
        __builtin_amdgcn_s_setprio(0); } while (0)
#define PG8_WAIT_V(n) asm volatile("s_waitcnt vmcnt(" #n ")" ::: "memory")
#define PG8_WAIT_L(n) asm volatile("s_waitcnt lgkmcnt(" #n ")" ::: "memory")
#define PG8_BAR __builtin_amdgcn_s_barrier()
#define PG8_SCHED __builtin_amdgcn_sched_barrier(0)
    Unit cur, nxt; int ui = 0;
    if (!S.next(0, cur)) return;
    f32x4 acc[2][2][4][2];
#pragma unroll
    for (int a = 0; a < 2; ++a)
#pragma unroll
        for (int b = 0; b < 2; ++b)
#pragma unroll
            for (int m = 0; m < 4; ++m)
#pragma unroll
                for (int n = 0; n < 2; ++n) acc[a][b][m][n] = (f32x4){0.f, 0.f, 0.f, 0.f};
    bf16x8 At[4][2], B0[2][2], B1[2][2];
    constexpr bool GATHER = Sched::GATHER;
    unsigned vc[2][2];
    LAS unsigned* park = (LAS unsigned*)(lds + PARK_OFF_) + tid * 4;
    const char* cA = (const char*)g.A;
    if constexpr (GATHER) S.a_offsets(cur, K, R, C, vc);
    else {
#pragma unroll
        for (int h = 0; h < 2; ++h)
#pragma unroll
            for (int i = 0; i < 2; ++i) vc[h][i] = (unsigned)((h * HALF + R[i]) * K + C[i] * 2);
        cA += (size_t)cur.pm * tstep; }
    const char* cB = (const char*)g.Bt + (size_t)cur.pb * tstep;
    PG8_STAGE(PG8_SB(0, 0), cB, voffB); PG8_STAGE(PG8_SB(0, 1), cB + hstep, voffB); PG8_STAGE(PG8_SA(0, 0), cA, vc[0]); PG8_STAGE(PG8_SA(0, 1), cA, vc[1]);
    if (wr == 1) PG8_BAR;
    PG8_WAIT_V(2); PG8_BAR;
    PG8_STAGE(PG8_SB(1, 0), cB + kstep, voffB); PG8_STAGE(PG8_SA(1, 0), cA + kstep, vc[0]); PG8_STAGE(PG8_SB(1, 1), cB + hstep + kstep, voffB);
    PG8_WAIT_V(6); PG8_BAR;
    for (;;) {
        const bool has_next = S.next(ui + 1, nxt);
        if constexpr (!GATHER) { *(LAS u32x4*)park = (u32x4){vc[0][0], vc[0][1], vc[1][0], vc[1][1]}; }
        if constexpr (GATHER) { unsigned vn[2][2];
            if (has_next) S.a_offsets(nxt, K, R, C, vn);
            else {
#pragma unroll
                for (int h = 0; h < 2; ++h)
#pragma unroll
                    for (int i = 0; i < 2; ++i) vn[h][i] = vc[h][i]; }
            *(LAS u32x4*)park = (u32x4){vn[0][0], vn[0][1], vn[1][0], vn[1][1]}; }
        const char* nA = GATHER ? (const char*)g.A : (has_next ? (const char*)g.A + (size_t)nxt.pm * tstep : cA);
        const char* nB = has_next ? (const char*)g.Bt + (size_t)nxt.pb * tstep : cB;
        for (int t = 0; t < nt; t += 2) {
            const bool last = (t == nt - 2);
            const char* a1 = cA + (size_t)(t + 1) * kstep;
            const char* a2 = last ? nA : cA + (size_t)(t + 2) * kstep; const char* b2 = last ? nB : cB + (size_t)(t + 2) * kstep;
            const char* a3 = a2 + kstep; const char* b3 = b2 + kstep;
            PG8_LDB(B0, 0, 0); PG8_LDB(B1, 0, 1); PG8_SCHED; PG8_LDA(At, 0, 0); PG8_STAGE(PG8_SA(1, 1), a1, vc[1]);
            { if (last) { const u32x4 pv = *(const LAS u32x4*)park; vc[0][0] = pv.x; vc[0][1] = pv.y; vc[1][0] = pv.z; vc[1][1] = pv.w; } }
            PG8_WAIT_V(8); PG8_WAIT_L(0); PG8_BAR; PG8_SCHED; PG8_MMA(0, 0, At, B0); PG8_MMA(0, 1, At, B1); PG8_SCHED; PG8_BAR; PG8_SCHED;
            PG8_LDA(At, 0, 1); PG8_STAGE(PG8_SB(0, 0), b2, voffB); PG8_STAGE(PG8_SB(0, 1), b2 + hstep, voffB); PG8_STAGE(PG8_SA(0, 0), a2, vc[0]);
            PG8_WAIT_V(8); PG8_WAIT_L(0); PG8_BAR; PG8_SCHED; PG8_MMA(1, 0, At, B0); PG8_MMA(1, 1, At, B1); PG8_SCHED; PG8_BAR; PG8_SCHED;
            PG8_LDB(B0, 1, 0); PG8_LDB(B1, 1, 1); PG8_SCHED; PG8_LDA(At, 1, 0); PG8_STAGE(PG8_SA(0, 1), a2, vc[1]);
            PG8_WAIT_V(8); PG8_WAIT_L(0); PG8_BAR; PG8_SCHED; PG8_MMA(0, 0, At, B0); PG8_MMA(0, 1, At, B1); PG8_SCHED; PG8_BAR; PG8_SCHED;
            PG8_LDA(At, 1, 1); PG8_STAGE(PG8_SB(1, 0), b3, voffB); PG8_STAGE(PG8_SB(1, 1), b3 + hstep, voffB); PG8_STAGE(PG8_SA(1, 0), a3, vc[0]);
            PG8_WAIT_V(8); PG8_WAIT_L(0); PG8_BAR; PG8_SCHED; PG8_MMA(1, 0, At, B0); PG8_MMA(1, 1, At, B1); PG8_SCHED; PG8_BAR; PG8_SCHED;
        }
        if (wr == 0) PG8_BAR;
        E(acc, cur, wr, wc, fr, fq);
        if (!has_next) break;
#pragma unroll
        for (int a = 0; a < 2; ++a)
#pragma unroll
            for (int b = 0; b < 2; ++b)
#pragma unroll
                for (int m = 0; m < 4; ++m)
#pragma unroll
                    for (int n = 0; n < 2; ++n) acc[a][b][m][n] = (f32x4){0.f, 0.f, 0.f, 0.f};
        cur = nxt; cA = nA; cB = nB; ++ui;
        if (wr == 1) PG8_BAR;
    }
    PG8_WAIT_V(0);
    PG8_BAR;
#undef PG8_SA
#undef PG8_SB
#undef PG8_STAGE
#undef PG8_LDA
#undef PG8_LDB
#undef PG8_MMA
#undef PG8_CAT
#undef PG8_WAIT_V
#undef PG8_WAIT_L
#undef PG8_BAR
#undef PG8_SCHED
}

__device__ __forceinline__ int opq(int x) { asm volatile("" : "+v"(x)); return x; }
template <bool BASEF32> struct EpiResid {
    const void* bl; const void* bc; bf16_t* ol; bf16_t* oc; const float* gate; float sc;
    __device__ __forceinline__ void operator()(f32x4 (&acc)[2][2][4][2], const Unit& u, int wr, int wc, int fr_, int fq_) const {
        const int ln_ = lane_now0(); const int fr = ln_ & 15, fq = ln_ >> 4; (void)fr_; (void)fq_;
        const bool lat = u.pm < 128; const int rb = (lat ? u.pm : u.pm - 128) * 256 + wr * 64 + fr;
        const void* b = lat ? bl : bc; bf16_t* o = lat ? ol : oc; const int ci = lat ? (u.pm >> 3) : 16;
        const int col0 = u.pn * 256 + wc * 32 + 4 * fq; const float* gp = gate + (size_t)ci * MODW + col0;
        f32x4 gv[2][2];
#pragma unroll
        for (int bj = 0; bj < 2; ++bj)
#pragma unroll
            for (int n = 0; n < 2; ++n) gv[bj][n] = *(const f32x4*)(gp + bj * 128 + n * 16) * sc;
#pragma unroll
        for (int ai = 0; ai < 2; ++ai) {
            f32x4 bs[4][2][2];
#pragma unroll
            for (int m = 0; m < 4; ++m) { const size_t off = (size_t)(rb + ai * 128 + m * 16) * DM + col0;
#pragma unroll
                for (int bj = 0; bj < 2; ++bj)
#pragma unroll
                    for (int n = 0; n < 2; ++n) {
                        if (BASEF32) bs[m][bj][n] = __builtin_nontemporal_load((const f32x4*)((const float*)b + off + bj * 128 + n * 16));
                        else { const u32x2 w = *(const u32x2*)((const bf16_t*)b + off + bj * 128 + n * 16); bs[m][bj][n] = (f32x4){bf_lo(w.x), bf_hi(w.x), bf_lo(w.y), bf_hi(w.y)}; } } }
#pragma unroll
            for (int m = 0; m < 4; ++m) { const size_t off = (size_t)(rb + ai * 128 + m * 16) * DM + col0;
#pragma unroll
                for (int bj = 0; bj < 2; ++bj)
#pragma unroll
                    for (int n = 0; n < 2; ++n) { const f32x4 v = bs[m][bj][n] + gv[bj][n] * acc[ai][bj][m][n]; u32x2 w; w.x = cvtpk(v[0], v[1]); w.y = cvtpk(v[2], v[3]); st8(o + off + bj * 128 + n * 16, w); } }
            asm volatile("" ::: "memory"); }
    }
};
__device__ __forceinline__ f32x4 i2f(const f32x4& a) { const v4i_t q = __builtin_bit_cast(v4i_t, a); return (f32x4){(float)q[0], (float)q[1], (float)q[2], (float)q[3]}; }
template <bool OUT8, bool INT, bool MOEROWS, bool UPX8> struct EpiSwiGLU {
    unsigned char* act; const float* sa; const float* sw; const int* listTok; const LAS int* moe; int cap;
    static constexpr float usc = UPX8 ? ACT8_SCALE : 1.0f;
    __device__ __forceinline__ void operator()(f32x4 (&acc)[2][2][4][2], const Unit& u, int wr, int wc, int fr_, int fq_) const {
        const int ln_ = lane_now0(); const int fr = ln_ & 15, fq = ln_ >> 4; (void)fr_; (void)fq_;
        const int row0 = u.pm * 256 + wr * 64 + fr, col0 = u.pn * 128 + wc * 32 + 8 * fq;
        f32x4 swg[2], swu[2];
        if (INT) { const float* sp = sw + (size_t)u.pb * 256 + 32 * wc + 4 * fq;
#pragma unroll
            for (int n = 0; n < 2; ++n) { swg[n] = *(const f32x4*)(sp + 16 * n); swu[n] = *(const f32x4*)(sp + 128 + 16 * n) * usc; } }
        float rsv[2][4];
        if (INT) { int arow[2][4];
#pragma unroll
            for (int ai = 0; ai < 2; ++ai)
#pragma unroll
                for (int m = 0; m < 4; ++m) { arow[ai][m] = row0 + ai * 128 + m * 16;
                    if (MOEROWS) { const int pos = u.r0 + ai * 128 + wr * 64 + m * 16 + fr; const int idx = pos < moe[u.e] ? pos : 0; arow[ai][m] = listTok[u.e * cap + idx] >> 1; } }
#pragma unroll
            for (int ai = 0; ai < 2; ++ai)
#pragma unroll
                for (int m = 0; m < 4; ++m) rsv[ai][m] = sa[arow[ai][m]]; }
#pragma unroll
        for (int ai = 0; ai < 2; ++ai)
#pragma unroll
            for (int m = 0; m < 4; ++m) { float v[8]; const float rs = INT ? rsv[ai][m] : 1.0f;
#pragma unroll
                for (int n = 0; n < 2; ++n) { f32x4 g4, u4;
                    if (INT) { g4 = i2f(acc[ai][0][m][n]) * (swg[n] * rs); u4 = i2f(acc[ai][1][m][n]) * (swu[n] * rs); }
                    else { g4 = acc[ai][0][m][n]; u4 = acc[ai][1][m][n] * usc; }
#pragma unroll
                    for (int i = 0; i < 4; ++i) v[4 * n + i] = (g4[i] * __builtin_amdgcn_rcpf(1.0f + __builtin_amdgcn_exp2f(-g4[i]))) * u4[i]; }
                if (OUT8) { u32x2 w; w.x = pk4_fp8(v[0], v[1], v[2], v[3]); w.y = pk4_fp8(v[4], v[5], v[6], v[7]);
                    st8(act + (size_t)(row0 + ai * 128 + m * 16) * DFF + col0, w); }
                else { u32x4 w; w.x = cvtpk(v[0], v[1]); w.y = cvtpk(v[2], v[3]); w.z = cvtpk(v[4], v[5]); w.w = cvtpk(v[6], v[7]);
                    st16(act + ((size_t)(row0 + ai * 128 + m * 16) * DFF + col0) * 2, w); } }
    }
};
struct EpiMoeOut {
    bf16_t* slots; const int* listTok; const float* listW; const LAS int* moe; int cap; float sc;
    __device__ __forceinline__ void operator()(f32x4 (&acc)[2][2][4][2], const Unit& u, int wr, int wc, int fr_, int fq_) const {
        const int ln_ = lane_now0(); const int fr = ln_ & 15, fq = ln_ >> 4; (void)fr_; (void)fq_;
        const int cnt = moe[u.e]; const int col0 = u.pn * 256 + wc * 32 + 4 * fq;
        int ents[2][4]; float ws_[2][4];
#pragma unroll
        for (int ai = 0; ai < 2; ++ai)
#pragma unroll
            for (int m = 0; m < 4; ++m) { const int pos = u.r0 + ai * 128 + wr * 64 + m * 16 + fr; const int idx = pos < cnt ? pos : 0;
                ents[ai][m] = listTok[u.e * cap + idx]; ws_[ai][m] = listW[u.e * cap + idx]; }
#pragma unroll
        for (int ai = 0; ai < 2; ++ai)
#pragma unroll
            for (int m = 0; m < 4; ++m) { const int pos = u.r0 + ai * 128 + wr * 64 + m * 16 + fr;
                if (pos < cnt) { const int ent = ents[ai][m]; const float w = ws_[ai][m] * sc; bf16_t* rp = slots + (size_t)ent * DM + col0;
#pragma unroll
                    for (int bj = 0; bj < 2; ++bj)
#pragma unroll
                        for (int n = 0; n < 2; ++n) { const f32x4 v = acc[ai][bj][m][n] * w; u32x2 o; o.x = cvtpk(v[0], v[1]); o.y = cvtpk(v[2], v[3]); st8(rp + bj * 128 + n * 16, o); } } }
    }
};
template <bool INT> struct EpiQKV64 {
    bf16_t *Q, *K, *V; int nkvt, ldk; const float *qg, *kg; const float *rcos, *rsin; bool dorope; float vsc;
    const float* sa; const float* sw;
    __device__ __forceinline__ void operator()(f32x4 (&acc)[2][2][4][2], const Unit& u, int wr, int wc, int fr_, int fq_) const {
        const int ln_ = lane_now0(); const int fr = ln_ & 15, fq = ln_ >> 4; (void)fr_; (void)fq_;
        if (INT) { const float* sp = sw + (size_t)u.pn * 256 + 32 * wc + 4 * fq;
#pragma unroll
            for (int bj = 0; bj < 2; ++bj)
#pragma unroll
                for (int n = 0; n < 2; ++n) { const f32x4 cs = *(const f32x4*)(sp + 128 * bj + 16 * n);
#pragma unroll
                    for (int ai = 0; ai < 2; ++ai)
#pragma unroll
                        for (int m = 0; m < 4; ++m) acc[ai][bj][m][n] = i2f(acc[ai][bj][m][n]) * cs; } }
        const int type = u.pn < 4 ? 0 : (u.pn < 4 + nkvt ? 1 : 2);
        bf16_t* O; int ld, head;
        if (type == 0) { O = Q; ld = DM; head = 4 * u.pn + wc; } else if (type == 1) { O = K; ld = ldk; head = 4 * (u.pn - 4) + wc; } else { O = V; ld = ldk; head = 4 * (u.pn - 4 - nkvt) + wc; }
        const bool lat = u.pm < 128; const int row0 = u.pm * 256 + wr * 64 + fr;
        bf16_t* ob = O + (size_t)row0 * ld + head * 64 + 8 * fq;
        float sar[2][4];
#pragma unroll
        for (int ai = 0; ai < 2; ++ai)
#pragma unroll
            for (int m = 0; m < 4; ++m) sar[ai][m] = INT ? sa[row0 + ai * 128 + m * 16] : vsc;
        if (type == 2) {
#pragma unroll
            for (int ai = 0; ai < 2; ++ai)
#pragma unroll
                for (int m = 0; m < 4; ++m) { bf16_t* rp = ob + (size_t)(ai * 128 + m * 16) * ld; const float rsv = sar[ai][m];
#pragma unroll
                    for (int bj = 0; bj < 2; ++bj) { const f32x4 v0 = acc[ai][bj][m][0] * rsv, v1 = acc[ai][bj][m][1] * rsv;
                        u32x4 w; w.x = cvtpk(v0[0], v0[1]); w.y = cvtpk(v0[2], v0[3]); w.z = cvtpk(v1[0], v1[1]); w.w = cvtpk(v1[2], v1[3]);
                        st16(rp + 32 * bj, w); } }
            return;
        }
        const float* gp = (type == 0 ? qg : kg) + 8 * fq;
        f32x4 gv[2][2];
#pragma unroll
        for (int bj = 0; bj < 2; ++bj)
#pragma unroll
            for (int n = 0; n < 2; ++n) gv[bj][n] = *(const f32x4*)(gp + 32 * bj + 4 * n) * (type == 0 ? 0.125f * LOG2E : 1.0f);
        const bool rope = dorope && lat; const float epsv = NORM_EPS / (vsc * vsc);
        const int f0 = (fq & 1) * 8;
        f32x4 rc[2], rsn[2];
#define QKV64_ROPE_LOAD(G_) do { const int _ai = (G_) >> 2, _m = (G_) & 3; const int _grow = (4 * u.pm + 2 * _ai + wr) & 31, _gcol = 16 * _m + fr; const int _pos = rope ? (fq < 2 ? _grow : _gcol) : 64; \
        _Pragma("unroll") for (int n = 0; n < 2; ++n) { rc[n] = *(const f32x4*)(rcos + _pos * 16 + f0 + 4 * n); rsn[n] = *(const f32x4*)(rsin + _pos * 16 + f0 + 4 * n); } } while (0)
        if (dorope) QKV64_ROPE_LOAD(0);
#pragma unroll
        for (int gi = 0; gi < 8; ++gi) { const int ai = gi >> 2, m = gi & 3;
            float ss = 0.f;
#pragma unroll
            for (int bj = 0; bj < 2; ++bj)
#pragma unroll
                for (int n = 0; n < 2; ++n) { const f32x4 x = acc[ai][bj][m][n]; ss += (x[0] * x[0] + x[1] * x[1]) + (x[2] * x[2] + x[3] * x[3]); }
            ss += __shfl_xor(ss, 16); ss += __shfl_xor(ss, 32);
            float epsr = epsv; if (INT) { const float rs = sar[ai][m]; epsr = NORM_EPS / (rs * rs); }
            const float rstd = __builtin_amdgcn_rsqf(ss * (1.0f / 64.0f) + epsr);
            f32x4 y[2][2];
            if (dorope) { f32x4 c0[2], s0[2];
#pragma unroll
                for (int n = 0; n < 2; ++n) { c0[n] = rc[n]; s0[n] = rsn[n]; }
                if (gi < 7) QKV64_ROPE_LOAD(gi + 1);
#pragma unroll
                for (int n = 0; n < 2; ++n) { const f32x4 x1 = acc[ai][0][m][n] * rstd * gv[0][n], x2 = acc[ai][1][m][n] * rstd * gv[1][n];
                    y[0][n] = x1 * c0[n] - x2 * s0[n]; y[1][n] = x1 * s0[n] + x2 * c0[n]; } }
            else {
#pragma unroll
                for (int n = 0; n < 2; ++n) { y[0][n] = acc[ai][0][m][n] * rstd * gv[0][n]; y[1][n] = acc[ai][1][m][n] * rstd * gv[1][n]; } }
            bf16_t* rp = ob + (size_t)(ai * 128 + m * 16) * ld;
#pragma unroll
            for (int bj = 0; bj < 2; ++bj) { u32x4 w; w.x = cvtpk(y[bj][0][0], y[bj][0][1]); w.y = cvtpk(y[bj][0][2], y[bj][0][3]); w.z = cvtpk(y[bj][1][0], y[bj][1][1]); w.w = cvtpk(y[bj][1][2], y[bj][1][3]);
                st16(rp + 32 * bj, w); }
        }
#undef QKV64_ROPE_LOAD
    }
};
template <bool INT> struct EpiQKV128 {
    bf16_t *Q, *K, *V; const float *qg, *kg; const float *rcos, *rsin; LAS float* xl; float vsc;
    const float* sa; const float* sw;
    __device__ __forceinline__ void operator()(f32x4 (&acc)[2][2][4][2], const Unit& u, int wr, int wc, int fr_, int fq_) const {
        const int ln_ = lane_now0(); const int fr = ln_ & 15, fq = ln_ >> 4; (void)fr_; (void)fq_;
        if (INT) { const float* sp = sw + (size_t)u.pn * 256 + 32 * wc + 4 * fq;
#pragma unroll
            for (int bj = 0; bj < 2; ++bj)
#pragma unroll
                for (int n = 0; n < 2; ++n) { const f32x4 cs = *(const f32x4*)(sp + 128 * bj + 16 * n);
#pragma unroll
                    for (int ai = 0; ai < 2; ++ai)
#pragma unroll
                        for (int m = 0; m < 4; ++m) acc[ai][bj][m][n] = i2f(acc[ai][bj][m][n]) * cs; } }
        const int type = u.pn < 4 ? 0 : (u.pn < 6 ? 1 : 2);
        bf16_t* O; int ld, head0;
        if (type == 0) { O = Q; ld = DM; head0 = 2 * u.pn; } else if (type == 1) { O = K; ld = 512; head0 = 2 * (u.pn - 4); } else { O = V; ld = 512; head0 = 2 * (u.pn - 6); }
        const bool lat = u.pm < 128; const int row0 = u.pm * 256 + wr * 64 + fr;
        bf16_t* ob = O + (size_t)row0 * ld + head0 * 128 + 16 * wc + 4 * fq;
        float sar[2][4];
#pragma unroll
        for (int ai = 0; ai < 2; ++ai)
#pragma unroll
            for (int m = 0; m < 4; ++m) sar[ai][m] = INT ? sa[row0 + ai * 128 + m * 16] : vsc;
        if (type == 2) {
#pragma unroll
            for (int ai = 0; ai < 2; ++ai)
#pragma unroll
                for (int m = 0; m < 4; ++m) { const float rsv = sar[ai][m];
#pragma unroll
                    for (int bj = 0; bj < 2; ++bj) { bf16_t* rp = ob + (size_t)(ai * 128 + m * 16) * ld + bj * 128;
#pragma unroll
                        for (int n = 0; n < 2; ++n) { const f32x4 v = acc[ai][bj][m][n] * rsv; u32x2 o; o.x = cvtpk(v[0], v[1]); o.y = cvtpk(v[2], v[3]); st8(rp + 64 * n, o); } } }
            return;
        }
        const float* gp = (type == 0 ? qg : kg) + 16 * wc + 4 * fq;
        const float qsc = type == 0 ? 0.08838834764831845f * LOG2E : 1.0f;
        const f32x4 g0 = *(const f32x4*)(gp) * qsc, g1 = *(const f32x4*)(gp + 64) * qsc;
#pragma unroll
        for (int ai = 0; ai < 2; ++ai)
#pragma unroll
            for (int m = 0; m < 4; ++m)
#pragma unroll
                for (int bj = 0; bj < 2; ++bj) { const f32x4 x = acc[ai][bj][m][0], y = acc[ai][bj][m][1];
                    float ss = ((x[0] * x[0] + x[1] * x[1]) + (x[2] * x[2] + x[3] * x[3])) + ((y[0] * y[0] + y[1] * y[1]) + (y[2] * y[2] + y[3] * y[3]));
                    ss += __shfl_xor(ss, 16); ss += __shfl_xor(ss, 32);
                    if (fq == 0) xl[((ai * 128 + wr * 64 + m * 16 + fr) * 2 + bj) * 4 + wc] = ss; }
        asm volatile("s_waitcnt lgkmcnt(0)" ::: "memory"); __builtin_amdgcn_s_barrier(); asm volatile("" ::: "memory");
        const float epsv = NORM_EPS / (vsc * vsc);
        const int f0 = (wc & 1) * 16 + 4 * fq;
        f32x4 rc, rsn;
#define QKV128_ROPE_LOAD(G_) do { const int _ai = (G_) >> 2, _m = (G_) & 3; const int _grow = (4 * u.pm + 2 * _ai + wr) & 31, _gcol = 16 * _m + fr; const int _pos = lat ? (wc < 2 ? _grow : _gcol) : 64; \
        rc = *(const f32x4*)(rcos + _pos * 32 + f0); rsn = *(const f32x4*)(rsin + _pos * 32 + f0); } while (0)
        QKV128_ROPE_LOAD(0);
#pragma unroll
        for (int gi = 0; gi < 8; ++gi) { const int ai = gi >> 2, m = gi & 3;
            const f32x4 cs = rc, sn = rsn;
            if (gi < 7) QKV128_ROPE_LOAD(gi + 1);
            float epsr = epsv; if (INT) { const float rs = sar[ai][m]; epsr = NORM_EPS / (rs * rs); }
#pragma unroll
            for (int bj = 0; bj < 2; ++bj) { const f32x4 p = *(const LAS f32x4*)(xl + ((ai * 128 + wr * 64 + m * 16 + fr) * 2 + bj) * 4);
                const float rstd = __builtin_amdgcn_rsqf(((p[0] + p[1]) + (p[2] + p[3])) * (1.0f / 128.0f) + epsr);
                const f32x4 x1 = acc[ai][bj][m][0] * rstd * g0, x2 = acc[ai][bj][m][1] * rstd * g1;
                const f32x4 y1 = x1 * cs - x2 * sn, y2 = x1 * sn + x2 * cs;
                bf16_t* rp = ob + (size_t)(ai * 128 + m * 16) * ld + bj * 128;
                u32x2 o1, o2; o1.x = cvtpk(y1[0], y1[1]); o1.y = cvtpk(y1[2], y1[3]); o2.x = cvtpk(y2[0], y2[1]); o2.y = cvtpk(y2[2], y2[3]);
                st8(rp, o1); st8(rp + 64, o2); }
        }
#undef QKV128_ROPE_LOAD
    }
};
}

namespace att {
struct AUnit { int qrow0, qcol, kvcol, klat0, nlat, kctx0, a0, a1; };
#ifndef ATT_PFK64
#define ATT_PFK64 1
#endif
#ifndef ATT_PFV64
#define ATT_PFV64 1
#endif
#ifndef ATT_PFK128
#define ATT_PFK128 2
#endif
#ifndef ATT_PFV128
#define ATT_PFV128 3
#endif
#ifndef ATT_NSLOT64
#define ATT_NSLOT64 8
#endif
#ifndef ATT_GRP64
#define ATT_GRP64 4
#endif
#ifndef ATT_GRP128
#define ATT_GRP128 2
#endif
#ifndef ATT_PAIR64
#define ATT_PAIR64 1
#endif
template <int DH> struct Geo { static constexpr int RB = DH * 2, KB = 64 * RB, SLOT = 2 * KB, NSLOT = DH == 64 ? ATT_NSLOT64 : 4, GRP = DH == 64 ? (ATT_PAIR64 ? ATT_GRP64 : 0) : ATT_GRP128, PD = GRP > 0 ? NSLOT - GRP : NSLOT - 1, NQ = DH / 16, ND = DH / 32, CPR = RB / 16, RPPC = 1024 / RB, NPW = KB / 8192, NI = 2 * NPW;
                              static constexpr int TAB_OFF = 131072 + 512; };
__device__ __forceinline__ s16x4 trd(const LAS unsigned char* p) { return __builtin_bit_cast(s16x4, __builtin_amdgcn_ds_read_tr16_b64_v4i16((LAS s16x4*)p)); }
__device__ __forceinline__ float max3f(float a, float b, float c) { float r; asm("v_max3_f32 %0, %1, %2, %3" : "=v"(r) : "v"(a), "v"(b), "v"(c)); return r; }
__device__ __forceinline__ float swapmax(float v) { auto rr = __builtin_amdgcn_permlane32_swap(__float_as_uint(v), __float_as_uint(v), false, false); return fmaxf(__uint_as_float(rr[0]), __uint_as_float(rr[1])); }
__device__ __forceinline__ float swapsum(float v) { auto rr = __builtin_amdgcn_permlane32_swap(__float_as_uint(v), __float_as_uint(v), false, false); return __uint_as_float(rr[0]) + __uint_as_float(rr[1]); }

template <int DH, int MODE, bool Y8>
__device__ __forceinline__ void attn_unit(LAS unsigned char* lds, const int tid, const bf16_t* Q, const bf16_t* K, const bf16_t* V, bf16_t* Y, int ldk, const AUnit& u, const float* bias_h, float sink_l2, bool has_sink) {
    typedef Geo<DH> G;
    const int wid = __builtin_amdgcn_readfirstlane(tid >> 6), lane = tid & 63, r32 = lane & 31, hi = lane >> 5;
    constexpr float THR = 8.0f;
    constexpr int PFK = DH == 64 ? ATT_PFK64 : ATT_PFK128, PFV = DH == 64 ? ATT_PFV64 : ATT_PFV128;
    const int NT = u.nlat + 4;
    const unsigned ldsa = (unsigned)(uintptr_t)lds;
    __builtin_amdgcn_s_barrier(); asm volatile("" ::: "memory");
    const int qoff = (MODE == 1) ? (2 * (wid >> 2) + (r32 >> 4)) * 64 + 16 * (wid & 3) + (r32 & 15) : wid * 32 + r32;
    bf16x8 qr[G::NQ];
    { const bf16_t* Qw = Q + (size_t)(u.qrow0 + qoff) * DM + u.qcol + hi * 8;
#pragma unroll
      for (int d0 = 0; d0 < G::NQ; ++d0) qr[d0] = *(const bf16x8*)(Qw + d0 * 16); }
    unsigned voffK[G::NPW], voffV[G::NPW];
#pragma unroll
    for (int i = 0; i < G::NPW; ++i) { const int pc = wid * G::NPW + i, row = pc * G::RPPC + lane / G::CPR, cp = lane % G::CPR;
        const int kf = DH == 64 ? ((row >> 1) & 7) : (row & 15), vf = DH == 64 ? (((row >> 1) & 1) << 2) : ((row & 3) << 2);
        voffK[i] = (unsigned)((row * ldk + u.kvcol) * 2 + ((cp ^ kf) << 4)); voffV[i] = (unsigned)((row * ldk + u.kvcol) * 2 + ((cp ^ vf) << 4)); }
#define ATT_T0(j) (((j) < u.nlat) ? u.klat0 + 64 * (j) : u.kctx0 + 64 * ((j) - u.nlat))
#define ATT_DMA(j) do { const size_t _tb = (size_t)ATT_T0(j) * ldk * 2; const unsigned _sl = ldsa + ((j) & (G::NSLOT - 1)) * G::SLOT + wid * G::NPW * 1024; \
        _Pragma("unroll") for (int i = 0; i < G::NPW; ++i) { pg8::glds_s((const char*)K + _tb, voffK[i], _sl + i * 1024); pg8::glds_s((const char*)V + _tb, voffV[i], _sl + G::KB + i * 1024); } } while (0)
    LAS float* tab = (LAS float*)(lds + G::TAB_OFF);
    if (MODE == 1) {
        for (int i = tid; i < 608; i += 512) { const int t = i - 64; float v = 0.f; if (t >= 0 && t < 480) { const int ri = t >> 5, ci = t & 31; if (ci < 31) v = bias_h[ri * 31 + ci] * LOG2E; } tab[t] = v; } }
#pragma unroll
    for (int t = 0; t < G::PD; ++t) if (t < NT) ATT_DMA(t);
    float m_run = -1e30f, l_run = 0.f;
    f32x16 o[G::ND];
#pragma unroll
    for (int d = 0; d < G::ND; ++d)
#pragma unroll
        for (int r = 0; r < 16; ++r) o[d][r] = 0.f;
    int w_lo = 0, w_hi = 0, l_lo = 0, l_hi = 0, tb_off = 0, m_lo = 0, m_hi = 0;
    f32x16 nms, initL; float msc = 3.0e38f, mscL = 3.0e38f;
#pragma unroll
    for (int r = 0; r < 16; ++r) { nms[r] = 0.f; initL[r] = 0.f; }
    float maddL[16];
    int cw = 0, jl_lo = 0, jl_hi = 0;
    if (MODE == 1) { const int R0 = 4 * u.a0 + 2 * (wid >> 2), cg = wid & 3, rq = R0 + (r32 >> 4), c = 16 * cg + (r32 & 15);
        int ra = R0 - 4; ra = ra < 0 ? 0 : (ra > 24 ? 24 : ra); int rb = R0 - 3; rb = rb < 0 ? 0 : (rb > 24 ? 24 : rb);
        w_lo = ra - u.a1; w_hi = rb - u.a1 + 8;
        const int r0l = (r32 >> 4) ? rb : ra; jl_lo = r0l - u.a1; jl_hi = jl_lo + 8;
        int c0 = c - 8; c0 = c0 < 0 ? 0 : (c0 > 48 ? 48 : c0);
        cw = 16 * cg - 8; cw = cw < 0 ? 0 : (cw > 32 ? 32 : cw);
        tb_off = (u.a1 - rq + 7) * 32 + cw + 4 * hi - c + 15;
#pragma unroll
        for (int r = 0; r < 16; ++r) { const int kc = cw + (r & 3) + 8 * (r >> 2) + 4 * hi; maddL[r] = (kc >= c0 && kc < c0 + 16) ? 0.f : -INFINITY; } }
    if (MODE == 2) { const int qw = u.a0 + 32 * wid;
        const int lo_pos = qw - 128 - u.a1 - 63, hi_pos = qw + 159 - u.a1;
        w_lo = lo_pos <= 0 ? 0 : (lo_pos + 63) >> 6; w_hi = hi_pos < 0 ? 0 : (hi_pos >> 6) + 1;
        const int f_lo = qw - 97 - u.a1, f_hi = qw + 65 - u.a1;
        m_lo = f_lo <= 0 ? 0 : (f_lo + 63) >> 6; m_hi = f_hi < 0 ? 0 : (f_hi >> 6) + 1;
        const int base = u.a1 - (qw + r32) + 4 * hi; l_lo = -128 - base; l_hi = 128 - base; }
    const int i16 = lane & 15, tq = i16 >> 2, tp4 = i16 & 3, blk = (lane >> 4) & 1;
    const int kfr = DH == 64 ? ((r32 >> 1) & 7) : (r32 & 15), xv = DH == 64 ? (tq >> 1) : tq;
    int koff[G::NQ], vo[G::ND];
#pragma unroll
    for (int d0 = 0; d0 < G::NQ; ++d0) koff[d0] = r32 * G::RB + (((2 * d0 + hi) ^ kfr) << 4);
#pragma unroll
    for (int d0 = 0; d0 < G::ND; ++d0) vo[d0] = G::KB + (4 * hi + tq) * G::RB + 64 * (d0 ^ xv) + 32 * blk + 8 * tp4;
    int koffL[G::NQ], voL[G::ND];
#pragma unroll
    for (int d0 = 0; d0 < G::NQ; ++d0) { const int row = cw + r32; koffL[d0] = row * G::RB + (((2 * d0 + hi) ^ ((row >> 1) & 7)) << 4); }
#pragma unroll
    for (int d0 = 0; d0 < G::ND; ++d0) voL[d0] = vo[d0] + cw * G::RB;
#define ATT_ACTIVE(j) ((MODE == 0) || (j) >= u.nlat || ((j) >= w_lo && (j) < w_hi))
#define ATT_MSUB() (m_run < -1e29f ? 0.f : m_run)
#define ATT_QKL(P0, MS, sl) do { const LAS unsigned char* _Kb = lds + (sl) * G::SLOT; MS = ATT_MSUB(); \
        if (__any(MS != mscL)) { mscL = MS; _Pragma("unroll") for (int r = 0; r < 16; ++r) initL[r] = maddL[r] - MS; } \
        bf16x8 _a0 = *(const LAS bf16x8*)(_Kb + koffL[0]); \
        _Pragma("unroll") for (int d0 = 0; d0 < G::NQ; ++d0) { bf16x8 _n0 = _a0; if (d0 + 1 < G::NQ) _n0 = *(const LAS bf16x8*)(_Kb + koffL[d0 + 1]); \
            __builtin_amdgcn_sched_barrier(0); \
            if (d0 == 0) P0 = __builtin_amdgcn_mfma_f32_32x32x16_bf16(_a0, qr[d0], initL, 0, 0, 0); else P0 = __builtin_amdgcn_mfma_f32_32x32x16_bf16(_a0, qr[d0], P0, 0, 0, 0); \
            __builtin_amdgcn_sched_barrier(0); _a0 = _n0; } } while (0)
#define ATT_SMPVL(P0, MS, j, sl) do { const LAS float* tp = tab + tb_off + 32 * (j); \
        const LAS unsigned char* _Vb = lds + (sl) * G::SLOT; s16x4 _vl[2 * G::ND][2];        \
        _Pragma("unroll") for (int i_ = 0; i_ < 2 * G::ND; ++i_) { const int s = i_ / G::ND, d0 = i_ % G::ND; _vl[i_][0] = trd(_Vb + voL[d0] + (16 * s) * G::RB); _vl[i_][1] = trd(_Vb + voL[d0] + (16 * s + 8) * G::RB); } \
        _Pragma("unroll") for (int r = 0; r < 16; ++r) P0[r] += tp[(r & 3) + 8 * (r >> 2)]; \
        if ((j) == w_lo || (j) == w_hi - 1) { const bool rowok = (j) >= jl_lo && (j) < jl_hi;          \
            _Pragma("unroll") for (int r = 0; r < 16; ++r) P0[r] = rowok ? P0[r] : -INFINITY; } \
        float pm = P0[0]; \
        _Pragma("unroll") for (int r = 1; r < 15; r += 2) pm = max3f(pm, P0[r], P0[r + 1]); \
        pm = fmaxf(pm, P0[15]); pm = swapmax(pm); \
        if (__any(pm > (m_run - MS) + THR)) { const float mn = fmaxf(m_run, pm + MS); const float alpha = __builtin_amdgcn_exp2f(m_run - mn); m_run = mn; l_run *= alpha; \
            _Pragma("unroll") for (int d = 0; d < G::ND; ++d) _Pragma("unroll") for (int r = 0; r < 16; ++r) o[d][r] *= alpha; } \
        { const float dl = m_run - MS; if (__any(dl != 0.f)) { _Pragma("unroll") for (int r = 0; r < 16; ++r) P0[r] -= dl; } }        \
        float ps = 0.f; \
        _Pragma("unroll") for (int r = 0; r < 16; ++r) { P0[r] = __builtin_amdgcn_exp2f(P0[r]); ps += P0[r]; } \
        l_run += swapsum(ps); \
        bf16x8 pbl[2]; \
        _Pragma("unroll") for (int s = 0; s < 2; ++s) { u32x4 w0; \
            w0.x = cvtpk(P0[8 * s + 0], P0[8 * s + 1]); w0.y = cvtpk(P0[8 * s + 2], P0[8 * s + 3]); w0.z = cvtpk(P0[8 * s + 4], P0[8 * s + 5]); w0.w = cvtpk(P0[8 * s + 6], P0[8 * s + 7]); \
            pbl[s] = __builtin_bit_cast(bf16x8, w0); } \
        _Pragma("unroll") for (int i_ = 0; i_ < 2 * G::ND; ++i_) { const int s = i_ / G::ND, d0 = i_ % G::ND; \
            const bf16x8 va = __builtin_shufflevector(_vl[i_][0], _vl[i_][1], 0, 1, 2, 3, 4, 5, 6, 7); \
            o[d0] = __builtin_amdgcn_mfma_f32_32x32x16_bf16(va, pbl[s], o[d0], 0, 0, 0); } } while (0)
#define ATT_QK(P0, P1, MS, sl) do { const LAS unsigned char* _Kb = lds + (sl) * G::SLOT; MS = ATT_MSUB(); \
        if (__any(MS != msc)) { msc = MS; _Pragma("unroll") for (int r = 0; r < 16; ++r) nms[r] = -MS; } \
        __builtin_amdgcn_s_setprio(1); \
        bf16x8 _ka[PFK + 1][2];        \
        _Pragma("unroll") for (int d0 = 0; d0 < PFK; ++d0) { _ka[d0][0] = *(const LAS bf16x8*)(_Kb + koff[d0]); _ka[d0][1] = *(const LAS bf16x8*)(_Kb + koff[d0] + 32 * G::RB); } \
        _Pragma("unroll") for (int d0 = 0; d0 < G::NQ; ++d0) { \
            if (d0 + PFK < G::NQ) { _ka[(d0 + PFK) % (PFK + 1)][0] = *(const LAS bf16x8*)(_Kb + koff[d0 + PFK]); _ka[(d0 + PFK) % (PFK + 1)][1] = *(const LAS bf16x8*)(_Kb + koff[d0 + PFK] + 32 * G::RB); } \
            __builtin_amdgcn_sched_barrier(0); \
            if (d0 == 0) { P0 = __builtin_amdgcn_mfma_f32_32x32x16_bf16(_ka[0][0], qr[d0], nms, 0, 0, 0); P1 = __builtin_amdgcn_mfma_f32_32x32x16_bf16(_ka[0][1], qr[d0], nms, 0, 0, 0); } \
            else { P0 = __builtin_amdgcn_mfma_f32_32x32x16_bf16(_ka[d0 % (PFK + 1)][0], qr[d0], P0, 0, 0, 0); P1 = __builtin_amdgcn_mfma_f32_32x32x16_bf16(_ka[d0 % (PFK + 1)][1], qr[d0], P1, 0, 0, 0); } \
            __builtin_amdgcn_sched_barrier(0); } \
        __builtin_amdgcn_s_setprio(0); } while (0)
#define ATT_SMPV(P0, P1, MS, j, sl) do { \
        const bool _lat = (j) < u.nlat; float pm; \
        if (MODE == 2 && _lat && !((j) >= m_lo && (j) < m_hi)) { const int lo = l_lo - 64 * (j), hh = l_hi - 64 * (j); \
            _Pragma("unroll") for (int r = 0; r < 16; ++r) { const int e0 = (r & 3) + 8 * (r >> 2), e1 = e0 + 32; \
                P0[r] = (e0 >= lo && e0 <= hh) ? P0[r] : -INFINITY; P1[r] = (e1 >= lo && e1 <= hh) ? P1[r] : -INFINITY; } } \
        pm = fmaxf(P0[0], P1[0]); \
        _Pragma("unroll") for (int r = 1; r < 16; ++r) pm = max3f(pm, P0[r], P1[r]); \
        pm = swapmax(pm); \
        if (__any(pm > (m_run - MS) + THR)) { const float mn = fmaxf(m_run, pm + MS); const float alpha = __builtin_amdgcn_exp2f(m_run - mn); m_run = mn; l_run *= alpha; \
            _Pragma("unroll") for (int d = 0; d < G::ND; ++d) _Pragma("unroll") for (int r = 0; r < 16; ++r) o[d][r] *= alpha; } \
        { const float dl = m_run - MS; if (__any(dl != 0.f)) { _Pragma("unroll") for (int r = 0; r < 16; ++r) { P0[r] -= dl; P1[r] -= dl; } } }        \
        float ps = 0.f; \
        _Pragma("unroll") for (int r = 0; r < 16; ++r) { P0[r] = __builtin_amdgcn_exp2f(P0[r]); P1[r] = __builtin_amdgcn_exp2f(P1[r]); ps += P0[r] + P1[r]; } \
        l_run += swapsum(ps); \
        bf16x8 pb[2][2]; \
        _Pragma("unroll") for (int s = 0; s < 2; ++s) { u32x4 w0, w1; \
            w0.x = cvtpk(P0[8 * s + 0], P0[8 * s + 1]); w0.y = cvtpk(P0[8 * s + 2], P0[8 * s + 3]); w0.z = cvtpk(P0[8 * s + 4], P0[8 * s + 5]); w0.w = cvtpk(P0[8 * s + 6], P0[8 * s + 7]); \
            w1.x = cvtpk(P1[8 * s + 0], P1[8 * s + 1]); w1.y = cvtpk(P1[8 * s + 2], P1[8 * s + 3]); w1.z = cvtpk(P1[8 * s + 4], P1[8 * s + 5]); w1.w = cvtpk(P1[8 * s + 6], P1[8 * s + 7]); \
            pb[0][s] = __builtin_bit_cast(bf16x8, w0); pb[1][s] = __builtin_bit_cast(bf16x8, w1); } \
        const LAS unsigned char* _Vb = lds + (sl) * G::SLOT; \
        __builtin_amdgcn_s_setprio(1); \
        { s16x4 _vf[PFV + 1][2];        \
        _Pragma("unroll") for (int i_ = 0; i_ < PFV; ++i_) { const int kt = i_ / (2 * G::ND), s = (i_ / G::ND) & 1, d0 = i_ % G::ND; \
            _vf[i_][0] = trd(_Vb + vo[d0] + (32 * kt + 16 * s) * G::RB); _vf[i_][1] = trd(_Vb + vo[d0] + (32 * kt + 16 * s + 8) * G::RB); } \
        _Pragma("unroll") for (int i_ = 0; i_ < 4 * G::ND; ++i_) { const int kt = i_ / (2 * G::ND), s = (i_ / G::ND) & 1, d0 = i_ % G::ND; \
            if (i_ + PFV < 4 * G::ND) { const int i1 = i_ + PFV, kt1 = i1 / (2 * G::ND), s1 = (i1 / G::ND) & 1, d1 = i1 % G::ND; \
                _vf[i1 % (PFV + 1)][0] = trd(_Vb + vo[d1] + (32 * kt1 + 16 * s1) * G::RB); _vf[i1 % (PFV + 1)][1] = trd(_Vb + vo[d1] + (32 * kt1 + 16 * s1 + 8) * G::RB); } \
            __builtin_amdgcn_sched_barrier(0); \
            const bf16x8 va = __builtin_shufflevector(_vf[i_ % (PFV + 1)][0], _vf[i_ % (PFV + 1)][1], 0, 1, 2, 3, 4, 5, 6, 7); \
            o[d0] = __builtin_amdgcn_mfma_f32_32x32x16_bf16(va, pb[kt][s], o[d0], 0, 0, 0); \
            __builtin_amdgcn_sched_barrier(0); } } \
        __builtin_amdgcn_s_setprio(0); } while (0)
#define ATT_WAIT(c) do { const int _c = (c); if (_c <= 0) asm volatile("s_waitcnt vmcnt(0)" ::: "memory"); else if (_c == 1) asm volatile("s_waitcnt vmcnt(%0)" :: "n"(G::NI) : "memory"); \
        else if (_c == 2) asm volatile("s_waitcnt vmcnt(%0)" :: "n"(2 * G::NI) : "memory"); else if (_c == 3) asm volatile("s_waitcnt vmcnt(%0)" :: "n"(3 * G::NI) : "memory"); \
        else if (_c == 4) asm volatile("s_waitcnt vmcnt(%0)" :: "n"(4 * G::NI) : "memory"); else asm volatile("s_waitcnt vmcnt(%0)" :: "n"(5 * G::NI) : "memory"); } while (0)
#define ATT_STEP(C0, C1, CM, N0, N1, NM, j) do { \
        { const int _last = ((j) + G::PD - 1 < NT - 1) ? (j) + G::PD - 1 : NT - 1; ATT_WAIT(_last - ((j) + 1)); } \
        __builtin_amdgcn_s_barrier(); asm volatile("" ::: "memory"); \
        if ((j) + G::PD < NT) ATT_DMA((j) + G::PD); \
        if ((j) + 1 < NT && ATT_ACTIVE((j) + 1)) ATT_QK(N0, N1, NM, ((j) + 1) & (G::NSLOT - 1)); \
        if (ATT_ACTIVE(j)) ATT_SMPV(C0, C1, CM, j, (j) & (G::NSLOT - 1)); } while (0)
    if constexpr (DH == 128 && G::GRP == 0) {
    f32x16 sA0, sA1, sB0, sB1; float msA = 0.f, msB = 0.f;
    { const int _iss = G::PD < NT ? G::PD : NT; ATT_WAIT(_iss - 2); }
    asm volatile("s_waitcnt lgkmcnt(0)" ::: "memory");
    __builtin_amdgcn_s_barrier(); asm volatile("" ::: "memory");
    if (ATT_ACTIVE(0)) ATT_QK(sA0, sA1, msA, 0);
    for (int j = 0; j < NT; j += 2) {
        ATT_STEP(sA0, sA1, msA, sB0, sB1, msB, j);
        if (j + 1 < NT) ATT_STEP(sB0, sB1, msB, sA0, sA1, msA, j + 1);
    }
    } else {
#define ATT_STEP1(C0, C1, j) do { \
        { const int _last = ((j) + G::PD - 1 < NT - 1) ? (j) + G::PD - 1 : NT - 1; ATT_WAIT(_last - (j)); } \
        __builtin_amdgcn_s_barrier(); asm volatile("" ::: "memory"); \
        if ((j) + G::PD < NT) ATT_DMA((j) + G::PD); \
        if (ATT_ACTIVE(j)) { if (MODE == 1 && (j) < u.nlat) { ATT_QKL(C0, msA, (j) & (G::NSLOT - 1)); ATT_SMPVL(C0, msA, j, (j) & (G::NSLOT - 1)); } \
                             else { ATT_QK(C0, C1, msA, (j) & (G::NSLOT - 1)); ATT_SMPV(C0, C1, msA, j, (j) & (G::NSLOT - 1)); } } } while (0)
    f32x16 sA0, sA1; float msA = 0.f;
    asm volatile("s_waitcnt lgkmcnt(0)" ::: "memory");
    if constexpr (G::GRP > 0) {
#define ATT_TILE1(C0, C1, j) do { if (ATT_ACTIVE(j)) { if (MODE == 1 && (j) < u.nlat) { ATT_QKL(C0, msA, (j) & (G::NSLOT - 1)); ATT_SMPVL(C0, msA, j, (j) & (G::NSLOT - 1)); } \
                                                     else { ATT_QK(C0, C1, msA, (j) & (G::NSLOT - 1)); ATT_SMPV(C0, C1, msA, j, (j) & (G::NSLOT - 1)); } } } while (0)
        for (int j = 0; j < NT; j += G::GRP) {
            { const int _iss = (j + G::PD - 1 < NT - 1) ? j + G::PD - 1 : NT - 1; const int _need = (j + G::GRP - 1 < NT - 1) ? j + G::GRP - 1 : NT - 1; ATT_WAIT(_iss - _need); }
            __builtin_amdgcn_s_barrier(); asm volatile("" ::: "memory");
#pragma unroll
            for (int g = 0; g < G::GRP; ++g) if (j + G::PD + g < NT) ATT_DMA(j + G::PD + g);
#pragma unroll
            for (int g = 0; g < G::GRP; ++g) if (j + g < NT) ATT_TILE1(sA0, sA1, j + g);
        }
#undef ATT_TILE1
    } else {
    for (int j = 0; j < NT; ++j) ATT_STEP1(sA0, sA1, j);
    }
#undef ATT_STEP1
    }
    if (has_sink) l_run += __builtin_amdgcn_exp2f(sink_l2 - m_run);
    const float inv = 1.0f / l_run;
    if (Y8) { unsigned char* Yb = (unsigned char*)Y + (size_t)(u.qrow0 + qoff) * DM + u.qcol + 4 * hi; const float sc8 = inv * Y8_SCALE;
#pragma unroll
        for (int d0 = 0; d0 < G::ND; ++d0)
#pragma unroll
            for (int g4 = 0; g4 < 4; ++g4) st4(Yb + 32 * d0 + 8 * g4, pk4_fp8(o[d0][4 * g4] * sc8, o[d0][4 * g4 + 1] * sc8, o[d0][4 * g4 + 2] * sc8, o[d0][4 * g4 + 3] * sc8));
    } else {
    bf16_t* Yw = Y + (size_t)(u.qrow0 + qoff) * DM + u.qcol + 4 * hi;
#pragma unroll
    for (int d0 = 0; d0 < G::ND; ++d0)
#pragma unroll
        for (int g4 = 0; g4 < 4; ++g4) { u32x2 w; w.x = cvtpk(o[d0][4 * g4] * inv, o[d0][4 * g4 + 1] * inv); w.y = cvtpk(o[d0][4 * g4 + 2] * inv, o[d0][4 * g4 + 3] * inv);
            st8(Yw + 32 * d0 + 8 * g4, w); } }
#undef ATT_T0
#undef ATT_DMA
#undef ATT_ACTIVE
#undef ATT_QK
#undef ATT_QKL
#undef ATT_MSUB
#undef ATT_SMPVL
#undef ATT_SMPV
#undef ATT_STEP
#undef ATT_WAIT
}
}

constexpr size_t MiB = 1u << 20;
constexpr size_t WS_CTL = 0, CTL_ZERO_BYTES = 1 * MiB;
constexpr size_t WS_MOD = 1 * MiB;
constexpr size_t WS_ROPE = 3 * MiB - 64 * 1024;
constexpr size_t WS_LIST = 3 * MiB;
constexpr size_t WS_SA = 5 * MiB + 256 * 1024;
constexpr size_t WS_SWQKV = WS_SA + 160 * 1024;
constexpr size_t WS_SWD = WS_SWQKV + 40 * 1024;
constexpr size_t WS_SWM = WS_SWD + 56 * 1024;
static_assert(WS_SWM + 8 * 7168 * 4 <= 6 * MiB, "scale arrays");
constexpr size_t WS_XC = 6 * MiB;
constexpr size_t WS_H = 22 * MiB;
constexpr size_t WS_SLOTS = 94 * MiB;
constexpr size_t WS_WQKV = 238 * MiB;
constexpr size_t WS_WO = 257 * MiB;
constexpr size_t WS_WDENSE = 265 * MiB;
constexpr size_t WS_WMOE = 307 * MiB;
constexpr size_t WS_ARENA = 475 * MiB;
constexpr size_t WS_Q = WS_ARENA, WS_K = WS_ARENA + 72 * MiB, WS_V = WS_ARENA + 144 * MiB, WS_ACT = WS_ARENA;
constexpr int MOE_ROWS_MAX = 2 * TT + 2048;
constexpr size_t ACT_MOE_BYTES = (size_t)MOE_ROWS_MAX * DFF * (FP8_MOE_OUT ? 1 : 2), ACT_DENSE_BYTES = (size_t)TT * DFF * (FP8_DENSE_OUT ? 1 : 2);
constexpr size_t ARENA_BYTES = ((ACT_MOE_BYTES > ACT_DENSE_BYTES ? (ACT_MOE_BYTES > 216 * MiB ? ACT_MOE_BYTES : 216 * MiB) : (ACT_DENSE_BYTES > 216 * MiB ? ACT_DENSE_BYTES : 216 * MiB)) + MiB - 1) / MiB * MiB;
constexpr size_t WS_XBL = WS_ARENA + ARENA_BYTES;
constexpr size_t WS_END = WS_XBL + (size_t)TL * DM * 2;
static_assert(WS_END <= 1040 * MiB, "ws map: d_ws is >= sum of the inputs = 1050 MiB");
constexpr size_t WDENSE_SLOT = (size_t)(2 * DFF * DM + DM * DFF) * 2;
constexpr size_t WMOE_IN_BYTES = (size_t)NEXP * 2 * DFF * DM * 2;
constexpr int CW_TMO = 0, CW_BAR = 4096, CW_MOECNT = 8192;

constexpr int RING_BYTES = 131072, XL_OFF = RING_BYTES, MOE_OFF = XL_OFF + 8192, MISC_OFF = MOE_OFF + 256, PARK_OFF = 140288, LDS_BYTES = PARK_OFF + 8192;
static_assert(XL_OFF == pg8::XL_OFF_ && PARK_OFF == pg8::PARK_OFF_ && MISC_OFF + 256 <= PARK_OFF && LDS_BYTES <= 160 * 1024, "LDS map");

#define XB_TMO      128
#define XB_XCNT(j)  (256  + 64 * (j))
#define XB_XSUB(j)  (1280 + 64 * (j))
#define XB_XGEN(j)  (2304 + 64 * (j))
#define XB_TOP      3328
#define XB_TOPGEN   3392
#define XCD_BAR_WORDS 3456
#define XB_SPIN_CAP (1u << 18)
__device__ __forceinline__ unsigned xb_ld(unsigned* p)              { return __hip_atomic_load(p, __ATOMIC_RELAXED, __HIP_MEMORY_SCOPE_AGENT); }
__device__ __forceinline__ unsigned xb_add(unsigned* p, unsigned v) { return __hip_atomic_fetch_add(p, v, __ATOMIC_RELAXED, __HIP_MEMORY_SCOPE_AGENT); }
__device__ __forceinline__ unsigned xb_xcc_id() { return (unsigned)__builtin_amdgcn_s_getreg((3 << 11) | 20) & 0xFu; }
#define XB_SPIN(cond, bar) do { unsigned _sp = 0; while (cond) { __builtin_amdgcn_s_sleep(1); \
    if ((++_sp & 255u) == 0u) { if (xb_ld(&(bar)[XB_TMO])) break; if (_sp > XB_SPIN_CAP) { atomicAdd(&(bar)[XB_TMO], 1u); break; } } } } while (0)
struct XcdBarrier { unsigned* bar; unsigned x; volatile LAS unsigned* st; int wave; };
__device__ __forceinline__ XcdBarrier xcd_barrier_post(unsigned* bar, volatile LAS unsigned* st, int wave) {
    XcdBarrier b; b.bar = bar; b.x = xb_xcc_id(); b.st = st; b.wave = wave;
    if (wave == 0 && lane_now0() == 0) (void)xb_add(&bar[XB_XCNT(b.x)], 1u);
    return b;
}
__device__ __forceinline__ void xcd_barrier_complete(unsigned* bar, unsigned x, unsigned& nloc, unsigned& nx) {
    const unsigned G = gridDim.x * gridDim.y * gridDim.z;
    unsigned sum, cnt, mine, sp = 0u;
    for (;;) {
        sum = 0u; cnt = 0u; mine = 0u;
#pragma unroll
        for (unsigned j = 0; j < 16; ++j) { const unsigned c = xb_ld(&bar[XB_XCNT(j)]); sum += c; cnt += (c > 0u) ? 1u : 0u; mine = (j == x) ? c : mine; }
        if (sum == G) break;
        __builtin_amdgcn_s_sleep(1);
        if ((++sp & 255u) == 0u) { if (xb_ld(&bar[XB_TMO])) break; if (sp > XB_SPIN_CAP) { atomicAdd(&bar[XB_TMO], 1u); break; } }
    }
    nloc = mine > 0u ? mine : 1u; nx = cnt > 0u ? cnt : 1u;
}
__device__ __forceinline__ void xcd_barrier(const XcdBarrier& b) {
    asm volatile("s_waitcnt vmcnt(0)" ::: "memory");
    __syncthreads();
    if (b.wave == 0 && lane_now0() == 0) {
        unsigned* bar = b.bar;
        __builtin_amdgcn_s_waitcnt(0);
        unsigned nloc = b.st[0], nx = b.st[1];
        if (nloc == 0u) { xcd_barrier_complete(bar, b.x, nloc, nx); b.st[0] = nloc; b.st[1] = nx; }
        const unsigned old = xb_add(&bar[XB_XSUB(b.x)], 1u);
        const unsigned gen = old / nloc;
        if (old + 1u == (gen + 1u) * nloc) {
            __builtin_amdgcn_fence(__ATOMIC_RELEASE, "agent");
            asm volatile("s_waitcnt vmcnt(0)" ::: "memory");
            const unsigned og = xb_add(&bar[XB_TOP], 1u);
            const unsigned tg = og / nx;
            if (og + 1u == (tg + 1u) * nx) xb_add(&bar[XB_TOPGEN], 1u);
            else XB_SPIN(xb_ld(&bar[XB_TOPGEN]) == tg, bar);
            __builtin_amdgcn_fence(__ATOMIC_ACQUIRE, "agent");
            xb_add(&bar[XB_XGEN(b.x)], 1u);
            asm volatile("s_waitcnt vmcnt(0)" ::: "memory");
        } else {
            XB_SPIN(xb_ld(&bar[XB_XGEN(b.x)]) == gen, bar);
            __builtin_amdgcn_fence(__ATOMIC_ACQUIRE, "agent");
            asm volatile("s_waitcnt vmcnt(0)" ::: "memory");
        }
    }
    __syncthreads();
}

constexpr int N_IN = 51;
struct Args { const float* in[N_IN]; float* out; unsigned char* ws; int ph_lo, ph_hi; };
struct Frame { LAS unsigned char* lds; int tid, lane, wave, vcu, G, gw, NGW; const Args* a; unsigned char* ws; float* out; bf16_t* xl16; bf16_t* xc16; const float* mod; };

#define LDS_WAIT() asm volatile("s_waitcnt lgkmcnt(0)" ::: "memory")
__device__ __forceinline__ int lane_now() { int l; asm volatile("v_mbcnt_lo_u32_b32 %0, -1, 0\n\tv_mbcnt_hi_u32_b32 %0, -1, %0" : "=v"(l)); return l; }
__device__ __forceinline__ float wave_sum(float v) {
#pragma unroll
    for (int o = 1; o < 64; o <<= 1) v += __shfl_xor(v, o);
    return v;
}
__host__ __device__ constexpr int layer_base(int L) { return L == 0 ? 4 : (L == 1 ? 15 : (L == 2 ? 28 : 38)); }
__host__ __device__ constexpr int layer_mixer(int L) { return L % 3; }
__host__ __device__ constexpr bool layer_moe(int L) { return (L & 1) != 0; }
__host__ __device__ constexpr int layer_nqkv(int L) { return L == 1 ? 1536 : (L == 2 ? 2048 : 3072); }
__host__ __device__ constexpr int layer_wqkv_row(int L) { return L == 0 ? 0 : (L == 1 ? 3072 : (L == 2 ? 4608 : 6656)); }
__host__ __device__ constexpr int layer_wo_idx(int L) { return layer_base(L) + (L == 2 ? 7 : 8); }
__host__ __device__ constexpr int layer_ffn_idx(int L) { return layer_base(L) + (L == 2 ? 8 : 9); }

__device__ __forceinline__ int conv_map(int mt, int rd) {
    if (mt == 0) return rd;
    const int pn = rd >> 8, s = rd & 255, bj = s >> 7, wc = (s >> 5) & 3, n = (s >> 4) & 1, fq = (s >> 2) & 3, i = s & 3;
    if (mt == 1) return (4 * pn + wc) * 64 + 32 * bj + 8 * fq + 4 * n + i;
    if (mt == 2) return (2 * pn + bj) * 128 + 64 * n + 16 * wc + 4 * fq + i;
    return bj * DFF + 128 * pn + 32 * wc + 8 * fq + 4 * n + i;
}
__device__ __forceinline__ void conv_item8(const float* W, int K, int N, unsigned char* WT, int mt, float scale, int item, int lane, LAS float* scr) {
    const int nblk = N / 32, kb = item / nblk, nb = item % nblk, k0 = 64 * kb, rd0 = 32 * nb;
    const float sc2 = mt == 3 ? scale * (((rd0 >> 7) & 1) ? LN2 : LOG2E) : scale;
    const int kq = lane >> 3, gq = lane & 7;
    const float* wp = W + (size_t)(k0 + kq) * N + conv_map(mt, rd0 + 4 * gq);
#pragma unroll
    for (int i = 0; i < 8; ++i) { const f32x4 v = __builtin_nontemporal_load((const f32x4*)(wp + (size_t)(8 * i) * N));        LAS float* d = scr + (8 * i + kq) * 33 + 4 * gq; d[0] = v[0]; d[1] = v[1]; d[2] = v[2]; d[3] = v[3]; }
    LDS_WAIT(); asm volatile("" ::: "memory");
    const int c = lane & 7;
#pragma unroll
    for (int j = 0; j < 4; ++j) { const int n = (lane >> 3) + 8 * j; const LAS float* s = scr + (8 * c) * 33 + n;
        u32x2 o; o.x = pk4_fp8(s[0 * 33] * sc2, s[1 * 33] * sc2, s[2 * 33] * sc2, s[3 * 33] * sc2); o.y = pk4_fp8(s[4 * 33] * sc2, s[5 * 33] * sc2, s[6 * 33] * sc2, s[7 * 33] * sc2);
        __builtin_nontemporal_store(o, (u32x2*)(WT + (size_t)(rd0 + n) * K + k0 + 8 * c)); }
    LDS_WAIT(); asm volatile("" ::: "memory");
}
__device__ __forceinline__ unsigned pk4_i8(float a, float b, float c, float d) {
    const unsigned ya = __float_as_uint(a + 12582912.0f), yb = __float_as_uint(b + 12582912.0f), yc = __float_as_uint(c + 12582912.0f), yd = __float_as_uint(d + 12582912.0f);
    return __builtin_amdgcn_perm(yb, ya, 0x0c0c0400u) | __builtin_amdgcn_perm(yd, yc, 0x04000c0cu); }
__device__ __forceinline__ void conv_cols_i8(const float* W, int K, int N, unsigned char* WT, int mt, float* swout, int nb, int lane, LAS float* scr) {
    const int rd0 = 32 * nb, kq = lane >> 3, gq = lane & 7;
    const float fac = mt == 3 ? (((rd0 >> 7) & 1) ? LN2 : LOG2E) : 1.0f;
    const float* wp = W + (size_t)kq * N + conv_map(mt, rd0 + 4 * gq);
    f32x4 mx = {0.f, 0.f, 0.f, 0.f};
    for (int kb = 0; kb < K / 64; ++kb) {
#pragma unroll
        for (int i = 0; i < 8; ++i) { const f32x4 v = *(const f32x4*)(wp + (size_t)(64 * kb + 8 * i) * N);
            mx[0] = fmaxf(mx[0], fabsf(v[0])); mx[1] = fmaxf(mx[1], fabsf(v[1])); mx[2] = fmaxf(mx[2], fabsf(v[2])); mx[3] = fmaxf(mx[3], fabsf(v[3])); } }
#pragma unroll
    for (int c = 0; c < 4; ++c) { mx[c] = fmaxf(mx[c], __shfl_xor(mx[c], 8)); mx[c] = fmaxf(mx[c], __shfl_xor(mx[c], 16)); mx[c] = fmaxf(mx[c], __shfl_xor(mx[c], 32)); }
    LAS float* invs = scr + 64 * 33;
    if (kq == 0) {
#pragma unroll
        for (int c = 0; c < 4; ++c) { const float m = mx[c]; invs[4 * gq + c] = m > 0.f ? 127.0f / m : 0.f; swout[rd0 + 4 * gq + c] = m > 0.f ? m * fac * (1.0f / 127.0f) : 1.0f; } }
    LDS_WAIT(); asm volatile("" ::: "memory");
    const int c4 = lane & 3, nn = lane >> 2;
    for (int kb = 0; kb < K / 64; ++kb) {
#pragma unroll
        for (int i = 0; i < 8; ++i) { const f32x4 v = *(const f32x4*)(wp + (size_t)(64 * kb + 8 * i) * N); LAS float* d = scr + (8 * i + kq) * 33 + 4 * gq; d[0] = v[0]; d[1] = v[1]; d[2] = v[2]; d[3] = v[3]; }
        LDS_WAIT(); asm volatile("" ::: "memory");
#pragma unroll
        for (int j = 0; j < 2; ++j) { const int n = nn + 16 * j; const float inv = invs[n]; const LAS float* sp = scr + (16 * c4) * 33 + n;
            u32x4 o; o.x = pk4_i8(sp[0 * 33] * inv, sp[1 * 33] * inv, sp[2 * 33] * inv, sp[3 * 33] * inv); o.y = pk4_i8(sp[4 * 33] * inv, sp[5 * 33] * inv, sp[6 * 33] * inv, sp[7 * 33] * inv);
            o.z = pk4_i8(sp[8 * 33] * inv, sp[9 * 33] * inv, sp[10 * 33] * inv, sp[11 * 33] * inv); o.w = pk4_i8(sp[12 * 33] * inv, sp[13 * 33] * inv, sp[14 * 33] * inv, sp[15 * 33] * inv);
            *(u32x4*)(WT + (size_t)(rd0 + n) * K + 64 * kb + 16 * c4) = o; }
        LDS_WAIT(); asm volatile("" ::: "memory");
    }
}
__device__ __forceinline__ void conv_block_i8(Frame& F, const float* W, int N, unsigned char* WT, int mt, float* swout, int nb) {
    constexpr int K = DM;
    const int lane = F.lane, w = F.wave, rd0 = 32 * nb, kq = lane >> 3, gq = lane & 7;
    const float fac = mt == 3 ? (((rd0 >> 7) & 1) ? LN2 : LOG2E) : 1.0f;
    LAS float* T = (LAS float*)F.lds; LAS float* xm = (LAS float*)(F.lds + pg8::XL_OFF_);
    const float* wp = W + (size_t)(128 * w + kq) * N + conv_map(mt, rd0 + 4 * gq);
    f32x4 mx = {0.f, 0.f, 0.f, 0.f};
#pragma unroll
    for (int i = 0; i < 16; ++i) { const f32x4 v = __builtin_nontemporal_load((const f32x4*)(wp + (size_t)(8 * i) * N));        const int k = 128 * w + 8 * i + kq, rot = 8 * ((k >> 4) & 3);
        LAS float* d = T + k * 32;
        d[(4 * gq + 0 + rot) & 31] = v[0]; d[(4 * gq + 1 + rot) & 31] = v[1]; d[(4 * gq + 2 + rot) & 31] = v[2]; d[(4 * gq + 3 + rot) & 31] = v[3];
        mx[0] = fmaxf(mx[0], fabsf(v[0])); mx[1] = fmaxf(mx[1], fabsf(v[1])); mx[2] = fmaxf(mx[2], fabsf(v[2])); mx[3] = fmaxf(mx[3], fabsf(v[3])); }
#pragma unroll
    for (int c = 0; c < 4; ++c) { mx[c] = fmaxf(mx[c], __shfl_xor(mx[c], 8)); mx[c] = fmaxf(mx[c], __shfl_xor(mx[c], 16)); mx[c] = fmaxf(mx[c], __shfl_xor(mx[c], 32)); }
    if (kq == 0) {
#pragma unroll
        for (int c = 0; c < 4; ++c) xm[w * 32 + 4 * gq + c] = mx[c]; }
    __syncthreads();
    const int c8 = lane & 7, n8 = lane >> 3;
#pragma unroll
    for (int j = 0; j < 4; ++j) { const int n = n8 + 8 * j;
        float m = xm[n];
#pragma unroll
        for (int ww = 1; ww < 8; ++ww) m = fmaxf(m, xm[ww * 32 + n]);
        const float inv = m > 0.f ? 127.0f / m : 0.f;
        if (w == 0 && c8 == 0) swout[rd0 + n] = m > 0.f ? m * fac * (1.0f / 127.0f) : 1.0f;
        const int k0 = 128 * w + 16 * c8, rot = 8 * ((k0 >> 4) & 3); const LAS float* sp = T + k0 * 32 + ((n + rot) & 31);
        u32x4 o; o.x = pk4_i8(sp[0 * 32] * inv, sp[1 * 32] * inv, sp[2 * 32] * inv, sp[3 * 32] * inv); o.y = pk4_i8(sp[4 * 32] * inv, sp[5 * 32] * inv, sp[6 * 32] * inv, sp[7 * 32] * inv);
        o.z = pk4_i8(sp[8 * 32] * inv, sp[9 * 32] * inv, sp[10 * 32] * inv, sp[11 * 32] * inv); o.w = pk4_i8(sp[12 * 32] * inv, sp[13 * 32] * inv, sp[14 * 32] * inv, sp[15 * 32] * inv);
        __builtin_nontemporal_store(o, (u32x4*)(WT + (size_t)(rd0 + n) * K + k0)); }
    __syncthreads();
}
__device__ __forceinline__ void conv_item(const float* W, int K, int N, bf16_t* WT, int mt, int item, int lane, LAS float* scr) {
    const int nblk = N / 32, kb = item / nblk, nb = item % nblk, k0 = 64 * kb, rd0 = 32 * nb;
    const float sc2 = mt == 3 ? (((rd0 >> 7) & 1) ? LN2 : LOG2E) : 1.0f;
    const int kq = lane >> 3, gq = lane & 7;
    const float* wp = W + (size_t)(k0 + kq) * N + conv_map(mt, rd0 + 4 * gq);
#pragma unroll
    for (int i = 0; i < 8; ++i) { const f32x4 v = __builtin_nontemporal_load((const f32x4*)(wp + (size_t)(8 * i) * N));        LAS float* d = scr + (8 * i + kq) * 33 + 4 * gq; d[0] = v[0]; d[1] = v[1]; d[2] = v[2]; d[3] = v[3]; }
    LDS_WAIT(); asm volatile("" ::: "memory");
    const int c = lane & 7;
#pragma unroll
    for (int j = 0; j < 4; ++j) { const int n = (lane >> 3) + 8 * j; const LAS float* s = scr + (8 * c) * 33 + n;
        u32x4 o; o.x = cvtpk(s[0 * 33] * sc2, s[1 * 33] * sc2); o.y = cvtpk(s[2 * 33] * sc2, s[3 * 33] * sc2); o.z = cvtpk(s[4 * 33] * sc2, s[5 * 33] * sc2); o.w = cvtpk(s[6 * 33] * sc2, s[7 * 33] * sc2);
        __builtin_nontemporal_store(o, (u32x4*)(WT + (size_t)(rd0 + n) * K + k0 + 8 * c)); }
    LDS_WAIT(); asm volatile("" ::: "memory");
}
template <int L>
__device__ __forceinline__ void conv_layer(Frame& F, int bi, int nb, int b0 = 0, int b1 = 1 << 30, int w0 = 0, int w1 = 1 << 30) {
    constexpr int NQ = layer_nqkv(L), MTQ = (layer_mixer(L) == 2) ? 2 : 1;
    constexpr int QDT = qkv_dt(), IDT = ffn_in_dt(L); constexpr bool OUT8 = ffn_out8(L), MOE = layer_moe(L);
    const float* wq = F.a->in[layer_base(L) + 4]; const float* wo = F.a->in[layer_wo_idx(L)];
    const float* win = F.a->in[layer_ffn_idx(L) + (MOE ? 2 : 0)]; const float* wout = F.a->in[layer_ffn_idx(L) + (MOE ? 3 : 1)];
    unsigned char* dq = F.ws + WS_WQKV + (size_t)layer_wqkv_row(L) * DM * (QDT ? 1 : 2);
    unsigned char* din = MOE ? F.ws + WS_WMOE : F.ws + WS_WDENSE + (L >> 1) * WDENSE_SLOT;
    unsigned char* dout = MOE ? F.ws + WS_WMOE + WMOE_IN_BYTES : din + (size_t)2 * DFF * DM * 2;
    constexpr int NEX = MOE ? NEXP : 1;
    constexpr size_t EB_IN = (size_t)2 * DFF * DM * (IDT ? 1 : 2), EB_OUT = (size_t)DM * DFF * (OUT8 ? 1 : 2);
    float* swin = MOE ? (float*)(F.ws + WS_SWM) : (float*)(F.ws + WS_SWD) + (L >> 1) * 2 * DFF;
    constexpr int B_Q = QDT == 2 ? NQ / 32 : 0, B_I = IDT == 2 ? NEX * (2 * DFF / 32) : 0;
    for (int g = b0 + bi; g < (b1 < B_Q + B_I ? b1 : B_Q + B_I); g += nb) {
        if (g < B_Q) conv_block_i8(F, wq, NQ, dq, MTQ, (float*)(F.ws + WS_SWQKV) + layer_wqkv_row(L), g);
        else { const int r = g - B_Q, e = r / (2 * DFF / 32), rr = r % (2 * DFF / 32); conv_block_i8(F, win + (size_t)e * DM * 2 * DFF, 2 * DFF, din + e * EB_IN, 3, swin + e * 2 * DFF, rr); }
    }
    LAS float* scr = (LAS float*)(F.lds + F.wave * 16384);
    constexpr int I_Q = QDT == 2 ? 0 : 16 * (NQ / 32), I_O = 16 * 32, I_DI = IDT == 2 ? 0 : 16 * (2 * DFF / 32), I_DO = (DFF / 64) * 32;
    constexpr int NIT = I_Q + I_O + NEX * (I_DI + I_DO);
    for (int g = w0 + bi * 8 + F.wave; g < (w1 < NIT ? w1 : NIT); g += nb * 8) {
        int r = g;
        if (r < I_Q) { if (QDT == 1) conv_item8(wq, DM, NQ, dq, MTQ, WQKV8_SCALE, r, F.lane, scr); else conv_item(wq, DM, NQ, (bf16_t*)dq, MTQ, r, F.lane, scr); continue; } r -= I_Q;
        if (r < I_O) { if (FP8_WO) conv_item8(wo, DM, DM, F.ws + WS_WO + (size_t)L * DM * DM, 0, WO8_SCALE, r, F.lane, scr);
                       else conv_item(wo, DM, DM, (bf16_t*)(F.ws + WS_WO) + (size_t)L * DM * DM, 0, r, F.lane, scr); continue; } r -= I_O;
        if (r < NEX * I_DI) { const int e = r / (I_DI > 0 ? I_DI : 1), rr = r % (I_DI > 0 ? I_DI : 1); const float* we = win + (size_t)e * DM * 2 * DFF;
            if (IDT == 1) conv_item8(we, DM, 2 * DFF, din + e * EB_IN, 3, WIN8_SCALE, rr, F.lane, scr); else conv_item(we, DM, 2 * DFF, (bf16_t*)(din + e * EB_IN), 3, rr, F.lane, scr); continue; } r -= NEX * I_DI;
        { const int e = r / I_DO, rr = r % I_DO; const float* we = wout + (size_t)e * DFF * DM;
            if (OUT8) conv_item8(we, DFF, DM, dout + e * EB_OUT, 0, WOUT8_SCALE, rr, F.lane, scr); else conv_item(we, DFF, DM, (bf16_t*)(dout + e * EB_OUT), 0, rr, F.lane, scr); }
    }
}
template <int LN>
__device__ __forceinline__ void tail_convert(Frame& F, int nunits, int b0 = 0, int b1 = 1 << 30, int w0 = 0, int w1 = 1 << 30) {
    const int rem = nunits % F.G; const int c = (int)blockIdx.x;
    if (rem == 0) conv_layer<LN>(F, c, F.G, b0, b1, w0, w1);
    else if (c >= rem) conv_layer<LN>(F, c - rem, F.G - rem, b0, b1, w0, w1);
}
#ifndef CV1_Q
#define CV1_Q 0
#endif
#ifndef CV1_A
#define CV1_A 370
#endif
#ifndef CV1_D
#define CV1_D 0
#endif
#ifndef CV3_M
#define CV3_M 250
#endif
#ifndef CV3_A
#define CV3_A 250
#endif
#ifndef CV3_B
#define CV3_B 370
#endif
#ifndef CV3_C
#define CV3_C 150
#endif
#ifndef CV3_W
#define CV3_W 0
#endif
constexpr int CVQ1 = 1536 / 32, CVQ3 = 3072 / 32, CVW_O = 512, CVW_HALF = 512 + 4 * 1792, CVW_ALL = 512 + 8 * 1792;
constexpr int CV1_0 = CVQ1 + CV1_Q, CV1_1 = CV1_0 + CV1_A, CV1_2 = CV1_1 + CV1_D;
constexpr int CV3_0 = CVQ3 + CV3_M, CV3_1 = CV3_0 + CV3_A, CV3_2 = CV3_1 + CV3_B, CV3_3 = CV3_2 + CV3_C;

__device__ __forceinline__ void phase_prologue(Frame& F) {
    LAS float* scond = (LAS float*)F.lds;
    LAS float* part = (LAS float*)(F.lds + 17 * 1024 * 4);
    for (int i = F.tid; i < NCOND * DM; i += 512) { const int ci = i >> 10, k = i & 1023; const float v = ci < 16 ? F.a->in[1][ci * DM + k] : F.a->in[3][k];
        scond[i] = v / (1.0f + __expf(-v)); }
    __syncthreads();
    for (int item = blockIdx.x; item < 4 * 96; item += F.G) {
        const int l = item / 96, nc = item % 96;
        const float* wm = F.a->in[layer_base(0)]; if (l == 1) wm = F.a->in[layer_base(1)]; if (l == 2) wm = F.a->in[layer_base(2)]; if (l == 3) wm = F.a->in[layer_base(3)];
        const float* bm = F.a->in[layer_base(0) + 1]; if (l == 1) bm = F.a->in[layer_base(1) + 1]; if (l == 2) bm = F.a->in[layer_base(2) + 1]; if (l == 3) bm = F.a->in[layer_base(3) + 1];
        f32x4 acc[NCOND];
#pragma unroll
        for (int ci = 0; ci < NCOND; ++ci) acc[ci] = (f32x4){0.f, 0.f, 0.f, 0.f};
        const int kq = F.lane >> 4, cq = F.lane & 15;
        const float* wp = wm + (size_t)(128 * F.wave + kq) * MODW + 64 * nc + 4 * cq;
        for (int i0 = 0; i0 < 32; i0 += 8) { f32x4 wv[8];
#pragma unroll
            for (int j = 0; j < 8; ++j) wv[j] = __builtin_nontemporal_load((const f32x4*)(wp + (size_t)(4 * (i0 + j)) * MODW));
#pragma unroll
            for (int j = 0; j < 8; ++j) { const LAS float* sc = scond + 128 * F.wave + 4 * (i0 + j) + kq;
#pragma unroll
                for (int ci = 0; ci < NCOND; ++ci) acc[ci] += wv[j] * sc[ci * DM];
                __builtin_amdgcn_sched_barrier(0); } }
#pragma unroll
        for (int ci = 0; ci < NCOND; ++ci)
#pragma unroll
            for (int c = 0; c < 4; ++c) { float v = acc[ci][c]; v += __shfl_xor(v, 16); v += __shfl_xor(v, 32); acc[ci][c] = v; }
        if (kq == 0) {
#pragma unroll
            for (int ci = 0; ci < NCOND; ++ci) *(LAS f32x4*)(part + (F.wave * NCOND + ci) * 64 + 4 * cq) = acc[ci]; }
        __syncthreads();
        for (int i = F.tid; i < NCOND * 64; i += 512) { const int ci = i >> 6, n = i & 63; float s = 0.f;
#pragma unroll
            for (int w = 0; w < 8; ++w) s += part[(w * NCOND + ci) * 64 + n];
            ((float*)(F.ws + WS_MOD))[(size_t)(l * NCOND + ci) * MODW + 64 * nc + n] = s + bm[64 * nc + n]; }
        __syncthreads();
    }
    { float* rt = (float*)(F.ws + WS_ROPE); const int gt = blockIdx.x * 512 + F.tid;
      if (gt < 65 * 16) { const int pos = gt >> 4, f = gt & 15; const float ang = (float)pos * powf(10000.0f, -(float)f / 16.0f); rt[gt] = pos < 64 ? cosf(ang) : 1.0f; rt[1040 + gt] = pos < 64 ? sinf(ang) : 0.0f; }
      else if (gt < 65 * 16 + 65 * 32) { const int g2 = gt - 1040, pos = g2 >> 5, f = g2 & 31; const float ang = (float)pos * powf(10000.0f, -(float)f / 32.0f); rt[2080 + g2] = pos < 64 ? cosf(ang) : 1.0f; rt[4160 + g2] = pos < 64 ? sinf(ang) : 0.0f; } }
    __syncthreads();
    conv_layer<0>(F, F.vcu, F.G);
}

__device__ __forceinline__ void reduce8(float (&lg)[8], int lane) {
    const bool o1 = lane & 1; float a[4];
#pragma unroll
    for (int i = 0; i < 4; ++i) { const float mine = o1 ? lg[4 + i] : lg[i], give = o1 ? lg[i] : lg[4 + i]; a[i] = mine + __shfl_xor(give, 1); }
    const bool o2 = lane & 2; float b2[2];
#pragma unroll
    for (int i = 0; i < 2; ++i) { const float mine = o2 ? a[2 + i] : a[i], give = o2 ? a[i] : a[2 + i]; b2[i] = mine + __shfl_xor(give, 2); }
    const bool o4 = lane & 4; float c1;
    { const float mine = o4 ? b2[1] : b2[0], give = o4 ? b2[0] : b2[1]; c1 = mine + __shfl_xor(give, 4); }
    c1 += __shfl_xor(c1, 8); c1 += __shfl_xor(c1, 16); c1 += __shfl_xor(c1, 32);
#pragma unroll
    for (int e = 0; e < 8; ++e) { const int src = ((e >> 2) & 1) | (((e >> 1) & 1) << 1) | ((e & 1) << 2); lg[e] = __shfl(c1, src); }
}
template <bool COMBINE, bool ROUTE, int OUTF, bool XIN32>
__device__ __forceinline__ void phase_norm(Frame& F, const float* g2prev, const float* gain, const float* modl, int psh, int psc, int nrows,
                                           const float* wrt, const float* brt, int moe_slot) {
    bf16_t* H = (bf16_t*)(F.ws + WS_H); const bf16_t* slots = (const bf16_t*)(F.ws + WS_SLOTS);
    LAS float* wr_l = (LAS float*)F.lds;
    LAS int* lcnt = (LAS int*)(F.lds + 32768);
    LAS int* ent_i = (LAS int*)(F.lds + 32768 + 64);
    LAS float* ent_w = (LAS float*)(F.lds + 32768 + 64 + 8 * 24 * 16);
    if (ROUTE) {
        for (int t = F.tid; t < DM * 8 / 4; t += 512) { const int d = t >> 1, half = t & 1, ln = (d & 255) >> 2, ii = d & 3, jj = d >> 8; ((LAS f32x4*)wr_l)[half * 1024 + (jj * 4 + ii) * 64 + ln] = ((const f32x4*)wrt)[t]; }
        if (F.tid < 16) lcnt[F.tid] = 0;
        __syncthreads();
    }
    const int rpw = nrows / F.NGW;
    const int row_b = F.gw * rpw;
    int ci_cur = -1; f32x4 ma[4], mb[4], mg[4];
#pragma unroll
    for (int j = 0; j < 4; ++j) { ma[j] = (f32x4){0.f, 0.f, 0.f, 0.f}; mb[j] = ma[j]; mg[j] = ma[j]; }
    f32x4 vnxA[2][4], vnxB[2][4]; u32x2 vnhA[2][4], vnhB[2][4]; u32x2 nsA[2][2][4], nsB[2][2][4];
    const float* xl32 = F.a->in[0]; const float* xc32 = F.a->in[2];
#define NORM_LOAD(NX, NH, NS, R0) do { _Pragma("unroll") for (int q = 0; q < 2; ++q) { const int _row = (R0) + q; const bool _lat = _row < TL; const size_t _ro = _lat ? (size_t)_row * DM : (size_t)(_row - TL) * DM; \
        if (XIN32) { const float* _x = (_lat ? xl32 : xc32) + _ro; _Pragma("unroll") for (int j = 0; j < 4; ++j) NX[q][j] = __builtin_nontemporal_load((const f32x4*)(_x + 4 * F.lane + 256 * j)); } \
        else { const bf16_t* _x = (_lat ? F.xl16 : F.xc16) + _ro; _Pragma("unroll") for (int j = 0; j < 4; ++j) NH[q][j] = *(const u32x2*)(_x + 4 * F.lane + 256 * j); } \
        if (COMBINE) { _Pragma("unroll") for (int k = 0; k < 2; ++k) _Pragma("unroll") for (int j = 0; j < 4; ++j) NS[q][k][j] = __builtin_nontemporal_load((const u32x2*)(slots + (size_t)(2 * _row + k) * DM + 4 * F.lane + 256 * j)); } } } while (0)
    auto pair = [&](f32x4 (&NX)[2][4], u32x2 (&NH)[2][4], u32x2 (&NS)[2][2][4], const int it, const int nxt) __attribute__((always_inline)) {
        const int row0 = row_b + it;
        f32x4 v[2][4]; u32x2 sl[2][2][4];
        bool lat[2]; size_t ro[2];
#pragma unroll
        for (int q = 0; q < 2; ++q) { const int row = row0 + q; lat[q] = row < TL; ro[q] = lat[q] ? (size_t)row * DM : (size_t)(row - TL) * DM;
#pragma unroll
            for (int j = 0; j < 4; ++j) { if (XIN32) v[q][j] = NX[q][j]; else v[q][j] = (f32x4){bf_lo(NH[q][j].x), bf_hi(NH[q][j].x), bf_lo(NH[q][j].y), bf_hi(NH[q][j].y)};
                if (COMBINE) { sl[q][0][j] = NS[q][0][j]; sl[q][1][j] = NS[q][1][j]; } } }
        if (nxt < rpw) NORM_LOAD(NX, NH, NS, row_b + nxt);
#pragma unroll
        for (int q = 0; q < 2; ++q) {
            const int row = row0 + q; const int ci = lat[q] ? (row >> 11) : 16;
            if (ci != ci_cur) { ci_cur = ci;
                if (gain != nullptr) { const float* mp = modl + (size_t)ci * MODW;
#pragma unroll
                    for (int j = 0; j < 4; ++j) { const int c0 = 4 * F.lane + 256 * j; const f32x4 gn = *(const f32x4*)(gain + c0), sc = *(const f32x4*)(mp + psc * DM + c0); ma[j] = gn * (1.0f + sc); mb[j] = *(const f32x4*)(mp + psh * DM + c0); } }
                if (COMBINE) {
#pragma unroll
                    for (int j = 0; j < 4; ++j) mg[j] = *(const f32x4*)(g2prev + (size_t)ci * MODW + 4 * F.lane + 256 * j); } }
            if (COMBINE) {
#pragma unroll
                for (int j = 0; j < 4; ++j) { const u32x2 s0 = sl[q][0][j], s1 = sl[q][1][j];
                    f32x4 sv; sv[0] = bf_lo(s0.x) + bf_lo(s1.x); sv[1] = bf_hi(s0.x) + bf_hi(s1.x); sv[2] = bf_lo(s0.y) + bf_lo(s1.y); sv[3] = bf_hi(s0.y) + bf_hi(s1.y);
                    v[q][j] = v[q][j] + mg[j] * sv;
                    if (gain == nullptr) __builtin_nontemporal_store(v[q][j], (f32x4*)(F.out + ro[q] + 4 * F.lane + 256 * j));
                    else { u32x2 o; o.x = cvtpk(v[q][j][0], v[q][j][1]); o.y = cvtpk(v[q][j][2], v[q][j][3]); st8((lat[q] ? F.xl16 : F.xc16) + ro[q] + 4 * F.lane + 256 * j, o); } }
            }
            if (gain == nullptr) continue;
            float ss = 0.f;
#pragma unroll
            for (int j = 0; j < 4; ++j) ss += (v[q][j][0] * v[q][j][0] + v[q][j][1] * v[q][j][1]) + (v[q][j][2] * v[q][j][2] + v[q][j][3] * v[q][j][3]);
            const float rstd = __builtin_amdgcn_rsqf(wave_sum(ss) * (1.0f / DM) + NORM_EPS);
#pragma unroll
            for (int j = 0; j < 4; ++j) v[q][j] = (v[q][j] * rstd) * ma[j] + mb[j];
            if (OUTF == 2) {
                float am = 0.f;
#pragma unroll
                for (int j = 0; j < 4; ++j) am = fmaxf(fmaxf(am, fmaxf(fabsf(v[q][j][0]), fabsf(v[q][j][1]))), fmaxf(fabsf(v[q][j][2]), fabsf(v[q][j][3])));
#pragma unroll
                for (int o = 1; o < 64; o <<= 1) am = fmaxf(am, __shfl_xor(am, o));
                const float inv = am > 0.f ? 127.0f / am : 0.f;
                if (F.lane == 0) ((float*)(F.ws + WS_SA))[row] = am > 0.f ? am * (1.0f / 127.0f) : 1.0f;
#pragma unroll
                for (int j = 0; j < 4; ++j) st4((unsigned char*)H + (size_t)row * DM + 4 * F.lane + 256 * j, pk4_i8(v[q][j][0] * inv, v[q][j][1] * inv, v[q][j][2] * inv, v[q][j][3] * inv));
            } else {
#pragma unroll
            for (int j = 0; j < 4; ++j) { const int c0 = 4 * F.lane + 256 * j;
                if (OUTF == 1) st4((unsigned char*)H + (size_t)row * DM + c0, pk4_fp8(v[q][j][0] * H8_SCALE, v[q][j][1] * H8_SCALE, v[q][j][2] * H8_SCALE, v[q][j][3] * H8_SCALE));
                else { u32x2 o; o.x = cvtpk(v[q][j][0], v[q][j][1]); o.y = cvtpk(v[q][j][2], v[q][j][3]); st8(H + (size_t)row * DM + c0, o); } } }
            if (ROUTE) {
                float lg[8];
#pragma unroll
                for (int e = 0; e < 8; ++e) lg[e] = 0.f;
#pragma unroll
                for (int j = 0; j < 4; ++j) { f32x4 rw[4][2];
#pragma unroll
                    for (int i = 0; i < 4; ++i) { rw[i][0] = ((const LAS f32x4*)wr_l)[(j * 4 + i) * 64 + F.lane]; rw[i][1] = ((const LAS f32x4*)wr_l)[1024 + (j * 4 + i) * 64 + F.lane]; }
                    __builtin_amdgcn_sched_barrier(0);
#pragma unroll
                    for (int i = 0; i < 4; ++i) { const f32x4 w0 = rw[i][0], w1 = rw[i][1]; const float hv = v[q][j][i];
                        lg[0] += hv * w0[0]; lg[1] += hv * w0[1]; lg[2] += hv * w0[2]; lg[3] += hv * w0[3]; lg[4] += hv * w1[0]; lg[5] += hv * w1[1]; lg[6] += hv * w1[2]; lg[7] += hv * w1[3]; }
                    __builtin_amdgcn_sched_barrier(0); }
                reduce8(lg, F.lane);
#pragma unroll
                for (int e = 0; e < 8; ++e) lg[e] += brt[e];
                int e0 = 0; float v0 = lg[0];
#pragma unroll
                for (int e = 1; e < 8; ++e) if (lg[e] > v0) { v0 = lg[e]; e0 = e; }
                int e1 = -1; float v1 = -INFINITY;
#pragma unroll
                for (int e = 0; e < 8; ++e) if (e != e0 && lg[e] > v1) { v1 = lg[e]; e1 = e; }
                if (e1 < 0) { e1 = (e0 + 1) & 7; v1 = v0; }
                const float w0 = 1.0f / (1.0f + __expf(v1 - v0)), w1 = 1.0f - w0;
                if (F.lane == 0) { const int p0 = atomicAdd((int*)&lcnt[e0], 1), p1 = atomicAdd((int*)&lcnt[e1], 1);
                    LAS int* ei = ent_i + (F.wave * 24 + it + q) * 4; ei[0] = e0; ei[1] = e1; ei[2] = p0; ei[3] = p1;
                    LAS float* ew = ent_w + (F.wave * 24 + it + q) * 2; ew[0] = w0; ew[1] = w1; }
            }
        }
    };
    NORM_LOAD(vnxA, vnhA, nsA, row_b);
    if (rpw > 2) NORM_LOAD(vnxB, vnhB, nsB, row_b + 2);
    for (int it = 0; it < rpw; it += 4) {
        pair(vnxA, vnhA, nsA, it, it + 4);
        if (it + 2 < rpw) pair(vnxB, vnhB, nsB, it + 2, it + 6);
    }
#undef NORM_LOAD
    if (ROUTE) {
        __syncthreads();
        unsigned* gcnt = (unsigned*)(F.ws + WS_CTL) + CW_MOECNT + moe_slot * 64;
        if (F.tid < 8) lcnt[8 + F.tid] = (int)__hip_atomic_fetch_add(gcnt + F.tid, (unsigned)lcnt[F.tid], __ATOMIC_RELAXED, __HIP_MEMORY_SCOPE_AGENT);
        __syncthreads();
        int* listTok = (int*)(F.ws + WS_LIST); float* listW = (float*)(F.ws + WS_LIST + (size_t)NEXP * TT * 4);
        for (int i = F.tid; i < 8 * 24 * 2; i += 512) { const int w = i / 48, r = (i % 48) >> 1, k = i & 1; const int row = (F.vcu * 8 + w) * rpw + r;
            if (r < rpw) { const int e = ent_i[(w * 24 + r) * 4 + k], p = ent_i[(w * 24 + r) * 4 + 2 + k] + lcnt[8 + e];
                listTok[e * TT + p] = row * 2 + k; listW[e * TT + p] = ent_w[(w * 24 + r) * 2 + k]; } }
    }
}

template <int MIXER, bool LAST>
__device__ __forceinline__ void phase_attention(Frame& F, const float* mparam) {
    constexpr int DH = MIXER == 2 ? 128 : 64, NQH = MIXER == 2 ? 8 : 16, NKV = MIXER == 0 ? 16 : 4, GQ = NQH / NKV, LDK = NKV * DH;
    const bf16_t* Q = (const bf16_t*)(F.ws + WS_Q); const bf16_t* K = (const bf16_t*)(F.ws + WS_K); const bf16_t* V = (const bf16_t*)(F.ws + WS_V); bf16_t* Y = (bf16_t*)(F.ws + WS_H);
    constexpr int UL = NB * NQH * 8;
    for (int ui = F.vcu; ui < UL; ui += F.G) {
        const int qblk = (ui + ui / F.G) & 7, h = (ui >> 3) % NQH, b = ui / (8 * NQH);
        att::AUnit u; u.qrow0 = b * SEQ + 256 * qblk; u.qcol = h * DH; u.kvcol = (h / GQ) * DH; u.kctx0 = TL + b * CTXL;
        if (MIXER == 0) { int lo = 4 * qblk - 4; lo = lo < 0 ? 0 : lo; int hi = 4 * qblk + 3 - 4; hi = hi < 0 ? 0 : (hi > 24 ? 24 : hi); hi += 8; if (lo > 24) lo = 24;
            u.klat0 = b * SEQ + 64 * lo; u.nlat = hi - lo; u.a0 = qblk; u.a1 = lo;
            att::attn_unit<64, 1, FP8_WO != 0>(F.lds, F.tid, Q, K, V, Y, LDK, u, mparam + h * 465, 0.f, false); }
        else if (MIXER == 1) { int tlo = 4 * qblk - 2; tlo = tlo < 0 ? 0 : tlo; int thi = 4 * qblk + 6; thi = thi > 32 ? 32 : thi;
            u.klat0 = b * SEQ + 64 * tlo; u.nlat = thi - tlo; u.a0 = 256 * qblk; u.a1 = 64 * tlo;
            att::attn_unit<64, 2, FP8_WO != 0>(F.lds, F.tid, Q, K, V, Y, LDK, u, nullptr, mparam[h] * LOG2E, true); }
        else { u.klat0 = b * SEQ; u.nlat = 32; u.a0 = 0; u.a1 = 0;
            att::attn_unit<128, 0, FP8_WO != 0>(F.lds, F.tid, Q, K, V, Y, LDK, u, nullptr, 0.f, false); }
    }
    if (!LAST) {
        constexpr int UC = NB * NQH;
        for (int ui = F.vcu; ui < UC; ui += F.G) {
            const int h = ui % NQH, b = ui / NQH;
            att::AUnit u; u.qrow0 = TL + b * CTXL; u.qcol = h * DH; u.kvcol = (h / GQ) * DH; u.kctx0 = TL + b * CTXL; u.klat0 = 0; u.nlat = 0; u.a0 = 0; u.a1 = 0;
            if (MIXER == 1) att::attn_unit<64, 0, FP8_WO != 0>(F.lds, F.tid, Q, K, V, Y, LDK, u, nullptr, mparam[h] * LOG2E, true);
            else if (MIXER == 0) att::attn_unit<64, 0, FP8_WO != 0>(F.lds, F.tid, Q, K, V, Y, LDK, u, nullptr, 0.f, false);
            else att::attn_unit<128, 0, FP8_WO != 0>(F.lds, F.tid, Q, K, V, Y, LDK, u, nullptr, 0.f, false);
        }
    }
}

__device__ __forceinline__ int moe_table(Frame& F, int moe_slot) {
    LAS int* mt = (LAS int*)(F.lds + MOE_OFF);
    unsigned* gcnt = (unsigned*)(F.ws + WS_CTL) + CW_MOECNT + moe_slot * 64;
    __syncthreads();
    if (F.tid == 0) { int tb = 0;
        for (int e = 0; e < 8; ++e) { const int c = (int)__hip_atomic_load(gcnt + e, __ATOMIC_RELAXED, __HIP_MEMORY_SCOPE_AGENT); mt[e] = c; mt[8 + e] = tb; tb += (c + 255) >> 8; }
        mt[16] = tb; }
    __syncthreads();
    return mt[16];
}

#define IN_(k) (lo <= (k) && (k) < hi)
#define REFRESH_() do { F.lane = lane_now(); F.tid = F.wave * 64 + F.lane; } while (0)
#define SEAM_(k) do { if (IN_(k) && IN_((k) + 1)) xcd_barrier(bar); } while (0)
template <int L>
__device__ __forceinline__ void run_layer(Frame& F, const XcdBarrier& bar, int lo, int hi) {
    constexpr int LB = layer_base(L), MIX = layer_mixer(L); constexpr bool MOE = layer_moe(L), LAST = (L == 3), PREV_MOE = (L > 0) && layer_moe(L - 1);
    constexpr int P = 1 + 7 * L;
    constexpr int NROWS = LAST ? TL : TT;
    constexpr int QDT = qkv_dt(), IDT = ffn_in_dt(L); constexpr bool OUT8 = ffn_out8(L);
    const float* modl = F.mod + (size_t)L * NCOND * MODW;
    bf16_t* H = (bf16_t*)(F.ws + WS_H);
    const float* SA = (const float*)(F.ws + WS_SA);
    if (IN_(P + 0)) { REFRESH_();
        phase_norm<PREV_MOE, false, QDT, L == 0>(F, F.mod + (size_t)(L > 0 ? L - 1 : 0) * NCOND * MODW + 5 * DM, F.a->in[LB + 2], modl, 0, 1, TT, nullptr, nullptr, 0);
    }
    SEAM_(P + 0);
    if (IN_(P + 1)) { REFRESH_();
        pg8::Gemm g{H, F.ws + WS_WQKV + (size_t)layer_wqkv_row(L) * DM * (QDT ? 1 : 2), QDT ? DM : 2 * DM, E8_2M6, E8_2M6, E8_2M2};
        pg8::Order<0> S; S.init(TT / 256, layer_nqkv(L) / 256, F.G, (int)blockIdx.x);
        const float* rt = (const float*)(F.ws + WS_ROPE); const float* swq = (const float*)(F.ws + WS_SWQKV) + layer_wqkv_row(L);
        if (MIX == 2) { pg8::EpiQKV128<QDT == 2> E{(bf16_t*)(F.ws + WS_Q), (bf16_t*)(F.ws + WS_K), (bf16_t*)(F.ws + WS_V), F.a->in[LB + 5], F.a->in[LB + 6], rt + 2080, rt + 4160, (LAS float*)(F.lds + XL_OFF), 1.0f, SA, swq};
            pg8::gemm_phase<QDT>(F.lds, F.tid, g, S, E); }
        else { pg8::EpiQKV64<QDT == 2> E{(bf16_t*)(F.ws + WS_Q), (bf16_t*)(F.ws + WS_K), (bf16_t*)(F.ws + WS_V), MIX == 0 ? 4 : 1, MIX == 0 ? 1024 : 256, F.a->in[LB + 5], F.a->in[LB + 6], rt, rt + 1040, MIX == 1, 1.0f, SA, swq};
            pg8::gemm_phase<QDT>(F.lds, F.tid, g, S, E); }
        if (L == 0) { REFRESH_(); tail_convert<1>(F, (TT / 256) * (layer_nqkv(L) / 256), 0, CV1_0, 0, 0); }
        if (L == 1) { REFRESH_(); tail_convert<1>(F, (TT / 256) * (layer_nqkv(L) / 256), 0, 0, CVW_O, CVW_HALF); }
        if (L == 2) { REFRESH_(); tail_convert<3>(F, (TT / 256) * (layer_nqkv(L) / 256), CV3_0, CV3_1, 0, 0); }
        if (L == 3) { REFRESH_(); tail_convert<3>(F, (TT / 256) * (layer_nqkv(L) / 256), 0, 0, CVW_ALL - CV3_W, CVW_ALL); }
    }
    SEAM_(P + 1);
    if (IN_(P + 2)) { REFRESH_(); phase_attention<MIX, LAST>(F, MIX == 2 ? nullptr : F.a->in[LB + 7]); }
    SEAM_(P + 2);
    if (IN_(P + 3)) { REFRESH_();
        pg8::Gemm g{F.ws + WS_H, F.ws + WS_WO + (size_t)L * DM * DM * (FP8_WO ? 1 : 2), FP8_WO ? DM : 2 * DM, E8_2M6, E8_2M6, E8_2M6};
        pg8::Order<0> S; S.init(NROWS / 256, 4, F.G, (int)blockIdx.x);
        pg8::EpiResid<L == 0> E{L == 0 ? (const void*)F.a->in[0] : (const void*)F.xl16, L == 0 ? (const void*)F.a->in[2] : (const void*)F.xc16, F.xl16, F.xc16, modl + 2 * DM, 1.0f};
        pg8::gemm_phase<FP8_WO ? 1 : 0>(F.lds, F.tid, g, S, E);
        if (L == 0) { REFRESH_(); tail_convert<1>(F, (NROWS / 256) * 4, CV1_0, CV1_1, 0, 0); }
        if (L == 1) { REFRESH_(); tail_convert<1>(F, (NROWS / 256) * 4, 0, 0, CVW_HALF, 1 << 30); }
        if (L == 2) { REFRESH_(); tail_convert<3>(F, (NROWS / 256) * 4, CV3_1, CV3_2, 0, 0); }
    }
    SEAM_(P + 3);
    if (IN_(P + 4)) { REFRESH_();
        if (MOE) phase_norm<false, true, IDT, false>(F, nullptr, F.a->in[LB + 3], modl, 3, 4, NROWS, F.a->in[layer_ffn_idx(L)], F.a->in[layer_ffn_idx(L) + 1], L >> 1);
        else phase_norm<false, false, IDT, false>(F, nullptr, F.a->in[LB + 3], modl, 3, 4, NROWS, nullptr, nullptr, 0);
    }
    SEAM_(P + 4);
    if (IN_(P + 5)) { REFRESH_();
        constexpr bool UPX8 = (IDT != 1 && OUT8);
        if (MOE) { const int ntile = moe_table(F, L >> 1);
            pg8::EpiSwiGLU<OUT8, IDT == 2, true, UPX8> E{F.ws + WS_ACT, SA, (const float*)(F.ws + WS_SWM), (const int*)(F.ws + WS_LIST), (const LAS int*)(F.lds + MOE_OFF), TT};
            pg8::Gemm g{H, F.ws + WS_WMOE, IDT ? DM : 2 * DM, E8_2M6, OUT8 ? E8_2M3 : E8_2M6, E8_2M2};
            pg8::Order<1> S; S.init(ntile, 2 * DFF / 256, F.G, (int)blockIdx.x); S.moe = (const LAS int*)(F.lds + MOE_OFF); S.listTok = (const int*)(F.ws + WS_LIST); S.cap = TT;
            pg8::gemm_phase<IDT>(F.lds, F.tid, g, S, E); }
        else { pg8::EpiSwiGLU<OUT8, IDT == 2, false, UPX8> E{F.ws + WS_ACT, SA, (const float*)(F.ws + WS_SWD) + (L >> 1) * 2 * DFF, nullptr, nullptr, 0};
            pg8::Gemm g{H, F.ws + WS_WDENSE + (L >> 1) * WDENSE_SLOT, IDT ? DM : 2 * DM, E8_2M6, OUT8 ? E8_2M3 : E8_2M6, E8_2M2};
            pg8::Order<0> S; S.init(NROWS / 256, 2 * DFF / 256, F.G, (int)blockIdx.x);
            pg8::gemm_phase<IDT>(F.lds, F.tid, g, S, E);
            if (L == 0) { REFRESH_(); tail_convert<1>(F, (NROWS / 256) * (2 * DFF / 256), CV1_1, CV1_2, 0, 0); }
            if (L == 2) { REFRESH_(); tail_convert<3>(F, (NROWS / 256) * (2 * DFF / 256), CV3_2, CV3_3, 0, 0); } }
    }
    SEAM_(P + 5);
    if (IN_(P + 6)) { REFRESH_();
        if (MOE) { const int ntile = moe_table(F, L >> 1);
            pg8::Gemm g{F.ws + WS_ACT, F.ws + WS_WMOE + WMOE_IN_BYTES, OUT8 ? DFF : 2 * DFF, E8_2M7, E8_2M7, E8_2M3};
            pg8::Order<2> S; S.init(ntile, 4, F.G, (int)blockIdx.x); S.moe = (const LAS int*)(F.lds + MOE_OFF); S.listTok = nullptr; S.cap = TT;
            pg8::EpiMoeOut E{(bf16_t*)(F.ws + WS_SLOTS), (const int*)(F.ws + WS_LIST), (const float*)(F.ws + WS_LIST + (size_t)NEXP * TT * 4), (const LAS int*)(F.lds + MOE_OFF), TT, 1.0f};
            pg8::gemm_phase<OUT8 ? 1 : 0>(F.lds, F.tid, g, S, E);
            if (L == 1) { REFRESH_(); tail_convert<2>(F, ntile * 4); REFRESH_(); tail_convert<3>(F, ntile * 4, 0, CV3_0, 0, 0); } }
        else { pg8::Gemm g{F.ws + WS_ACT, F.ws + WS_WDENSE + (L >> 1) * WDENSE_SLOT + (size_t)2 * DFF * DM * 2, OUT8 ? DFF : 2 * DFF, E8_2M7, E8_2M7, E8_2M3};
            pg8::Order<0> S; S.init(NROWS / 256, 4, F.G, (int)blockIdx.x);
            pg8::EpiResid<false> E{F.xl16, F.xc16, F.xl16, F.xc16, modl + 5 * DM, 1.0f};
            pg8::gemm_phase<OUT8 ? 1 : 0>(F.lds, F.tid, g, S, E);
            if (L == 0) { REFRESH_(); tail_convert<1>(F, (NROWS / 256) * 4, CV1_2, 1 << 30, 0, CVW_O); }
            if (L == 2) { REFRESH_(); tail_convert<3>(F, (NROWS / 256) * 4, CV3_3, 1 << 30, 0, CVW_ALL - CV3_W); } }
    }
    SEAM_(P + 6);
}

constexpr int N_PHASES = 30;
__global__ void __launch_bounds__(512, 2) mk_fwd(Args args) {
    extern __shared__ __attribute__((aligned(16))) unsigned char lds_raw[];
    Frame F;
    F.lds = (LAS unsigned char*)lds_raw;
    F.wave = __builtin_amdgcn_readfirstlane((int)threadIdx.x >> 6); F.lane = lane_now(); F.tid = F.wave * 64 + F.lane;
    F.G = gridDim.x; { const int bx = blockIdx.x; F.vcu = (F.G % 8 == 0) ? (bx % 8) * (F.G / 8) + bx / 8 : bx; }
    F.gw = F.vcu * 8 + F.wave; F.NGW = F.G * 8;
    F.a = &args; F.ws = args.ws; F.out = args.out; F.xl16 = (bf16_t*)(args.ws + WS_XBL); F.xc16 = (bf16_t*)(args.ws + WS_XC); F.mod = (const float*)(args.ws + WS_MOD);
    volatile LAS unsigned* MISC = (volatile LAS unsigned*)(F.lds + MISC_OFF);
    for (int u = F.tid; u < (PARK_OFF - MOE_OFF) / 4; u += 512) ((LAS unsigned*)(F.lds + MOE_OFF))[u] = 0u;
    __syncthreads();
    const int lo = args.ph_lo, hi = args.ph_hi;
    XcdBarrier bar; bar.bar = (unsigned*)(F.ws + WS_CTL) + CW_BAR; bar.x = 0; bar.st = nullptr; bar.wave = F.wave;
    if (hi - lo > 1) bar = xcd_barrier_post((unsigned*)(F.ws + WS_CTL) + CW_BAR, MISC + 8, F.wave);

    if (IN_(0)) { REFRESH_(); phase_prologue(F); }
    SEAM_(0);
    run_layer<0>(F, bar, lo, hi);
    run_layer<1>(F, bar, lo, hi);
    run_layer<2>(F, bar, lo, hi);
    run_layer<3>(F, bar, lo, hi);
    if (IN_(29)) { REFRESH_(); phase_norm<true, false, 0, false>(F, F.mod + (size_t)3 * NCOND * MODW + 5 * DM, nullptr, nullptr, 0, 0, TL, nullptr, nullptr, 0); }
}

extern "C" void kernel_launch(void* const* d_in, const int* in_sizes, int n_in, void* d_out, int out_size, void* d_ws, size_t ws_size, hipStream_t stream) {
    static int grid = 0;
    if (grid == 0) {
        if (n_in != N_IN || out_size != TL * DM || ws_size < WS_END) { fprintf(stderr, "kernel_launch: unexpected shapes: n_in %d out %d ws %zu (need %zu)\n", n_in, out_size, ws_size, (size_t)WS_END); grid = -1; return; }
        int dev = 0, cus = 0, per_cu = 0;
        if (hipGetDevice(&dev) != hipSuccess || hipDeviceGetAttribute(&cus, hipDeviceAttributeMultiprocessorCount, dev) != hipSuccess) { grid = -1; return; }
        if (hipFuncSetAttribute((const void*)mk_fwd, hipFuncAttributeMaxDynamicSharedMemorySize, LDS_BYTES) != hipSuccess) { fprintf(stderr, "kernel_launch: hipFuncSetAttribute failed\n"); grid = -1; return; }
        if (hipOccupancyMaxActiveBlocksPerMultiprocessor(&per_cu, (const void*)mk_fwd, 512, LDS_BYTES) != hipSuccess || per_cu < 1) fprintf(stderr, "kernel_launch: occupancy query says %d\n", per_cu);
        (void)hipGetLastError();
        grid = cus;
        if (grid != 256) fprintf(stderr, "kernel_launch: built for 256 CUs, device has %d\n", cus);
    }
    if (grid < 0) return;
    (void)hipMemsetAsync((char*)d_ws + WS_CTL, 0, CTL_ZERO_BYTES, stream);
    Args a{};
    for (int i = 0; i < N_IN; ++i) a.in[i] = (const float*)d_in[i];
    a.out = (float*)d_out; a.ws = (unsigned char*)d_ws;
#if MK_PER_PHASE
    for (int p = 0; p < N_PHASES; ++p) { a.ph_lo = p; a.ph_hi = p + 1; hipLaunchKernelGGL(mk_fwd, dim3(grid), dim3(512), LDS_BYTES, stream, a); }
#else
    a.ph_lo = 0; a.ph_hi = N_PHASES;
    hipLaunchKernelGGL(mk_fwd, dim3(grid), dim3(512), LDS_BYTES, stream, a);
#endif
}
```
